# Optimizing an MI355X kernel written in HIP

```python
import math
import jax, jax.numpy as jnp
from jax import lax
import numpy as np

D_MODEL = 2048
BATCH = 4
SEQ = 2048
DEPTH = 4

N_EVEN = (DEPTH + 1) // 2
N_ODD = DEPTH // 2

D_LRU = 1024
LRU_HEADS = 16
LRU_HEAD_DIM = D_LRU // LRU_HEADS
CONV_WIDTH = 4
LRU_C = 8.0

GLA_HEADS = 4
GLA_DK = 128
GLA_DV = 256
GLA_QK = GLA_HEADS * GLA_DK
GLA_V = GLA_HEADS * GLA_DV
GLA_RANK = 16
GLA_TAU = 16.0
GLA_CHUNK = 64

OFF_LRU_X = 0
OFF_LRU_G = OFF_LRU_X + D_LRU
OFF_Q = OFF_LRU_G + D_LRU
OFF_K = OFF_Q + GLA_QK
OFF_V = OFF_K + GLA_QK
OFF_OG = OFF_V + GLA_V
OFF_LR = OFF_OG + GLA_V
D_EVEN_IN = OFF_LR + GLA_RANK
D_EVEN_MIX = D_LRU + GLA_V

D_S5 = 1024
S5_GROUP = 16
S5_GROUPS = D_S5 // S5_GROUP
S5_STATE = 64
S5_MAX_RE = -1e-4

N_EXPERT_GROUPS = 4
EXPERTS_PER_GROUP = 8
N_EXPERTS = N_EXPERT_GROUPS * EXPERTS_PER_GROUP
D_EXPERT = 512
TOP_K_IN_GROUP = 2

D_PLE = 256

EPS = 1e-6

kernel_name = "hybrid_rglru_gla_s5_hmoe_trunk"


def rms_norm(x, g):
    xf = x.astype(jnp.float32)
    y = xf * lax.rsqrt(jnp.mean(xf * xf, axis=-1, keepdims=True) + EPS)
    return (y * g.astype(jnp.float32)).astype(x.dtype)


def causal_depthwise_conv(x, w, b):
    c = x.shape[-1]
    y = lax.conv_general_dilated(
        x, w[:, None, :].astype(x.dtype), window_strides=(1,),
        padding=[(CONV_WIDTH - 1, 0)], dimension_numbers=('NWC', 'WIO', 'NWC'),
        feature_group_count=c)
    return y + b


def linear_scan(a, b, axis):
    def combine(l, r):
        a_l, b_l = l
        a_r, b_r = r
        return a_r * a_l, a_r * b_l + b_r
    _, h = lax.associative_scan(combine, (a, b), axis=axis)
    return h


def rg_lru(x, w_a, b_a, w_x, b_x, lam):
    B, S, _ = x.shape
    xh = x.reshape(B, S, LRU_HEADS, LRU_HEAD_DIM)
    r = jax.nn.sigmoid(jnp.einsum('bshi,hij->bshj', xh, w_a).reshape(B, S, D_LRU) + b_a)
    i = jax.nn.sigmoid(jnp.einsum('bshi,hij->bshj', xh, w_x).reshape(B, S, D_LRU) + b_x)
    log_a = -LRU_C * r.astype(jnp.float32) * jax.nn.softplus(-lam.astype(jnp.float32))
    a = jnp.exp(log_a)
    mult = jnp.sqrt(-jnp.expm1(2.0 * log_a))
    u = mult * (i * x).astype(jnp.float32)
    h = linear_scan(a, u, axis=1)
    return h.astype(x.dtype)


def gla_chunked(q, k, v, gk):
    B, S, H, DK = q.shape
    DV = v.shape[-1]
    C = GLA_CHUNK
    n = S // C
    f32 = jnp.float32
    q = q.reshape(B, n, C, H, DK).astype(f32) * (DK ** -0.5)
    k = k.reshape(B, n, C, H, DK).astype(f32)
    v = v.reshape(B, n, C, H, DV).astype(f32)
    bcum = jnp.cumsum(gk.reshape(B, n, C, H, DK).astype(f32), axis=2)
    b_last = bcum[:, :, -1:]
    q_s = q * jnp.exp(bcum)
    k_s = k * jnp.exp(-bcum)
    k_end = k * jnp.exp(b_last - bcum)
    causal = jnp.tril(jnp.ones((C, C), dtype=bool))
    att = jnp.einsum('bnihk,bnjhk->bnhij', q_s, k_s)
    att = jnp.where(causal, att, 0.0)
    o = jnp.einsum('bnhij,bnjhv->bnihv', att, v)
    ds = jnp.einsum('bnjhk,bnjhv->bnhkv', k_end, v)
    decay = jnp.exp(b_last[:, :, 0])

    def step(s, inp):
        d, dsn = inp
        return d[..., None] * s + dsn, s

    s0 = jnp.zeros((B, H, DK, DV), f32)
    _, s_prev = lax.scan(step, s0, (jnp.moveaxis(decay, 1, 0), jnp.moveaxis(ds, 1, 0)))
    s_prev = jnp.moveaxis(s_prev, 0, 1)
    o = o + jnp.einsum('bnihk,bnhkv->bnihv', q_s, s_prev)
    return o.reshape(B, S, H, DV)


def even_mixer(xn, w_in, conv_w, conv_b, w_a, b_a, w_x, b_x, lam,
               w_gate_up, b_gate, head_norm, w_out):
    B, S, _ = xn.shape
    z = xn @ w_in
    x_lru = z[..., OFF_LRU_X:OFF_LRU_G]
    g_lru = z[..., OFF_LRU_G:OFF_Q]
    q = z[..., OFF_Q:OFF_K]
    k = z[..., OFF_K:OFF_V]
    v = z[..., OFF_V:OFF_OG]
    og = z[..., OFF_OG:OFF_LR]
    lr = z[..., OFF_LR:D_EVEN_IN]
    x_lru = causal_depthwise_conv(x_lru, conv_w, conv_b)
    y_lru = rg_lru(x_lru, w_a, b_a, w_x, b_x, lam) * jax.nn.gelu(g_lru)
    gk = jax.nn.log_sigmoid((lr @ w_gate_up + b_gate).astype(jnp.float32)) / GLA_TAU
    o = gla_chunked(q.reshape(B, S, GLA_HEADS, GLA_DK), k.reshape(B, S, GLA_HEADS, GLA_DK),
                    v.reshape(B, S, GLA_HEADS, GLA_DV), gk.reshape(B, S, GLA_HEADS, GLA_DK))
    o = o * lax.rsqrt(jnp.mean(o * o, axis=-1, keepdims=True) + EPS)
    y_gla = (o.reshape(B, S, GLA_V) * head_norm.astype(jnp.float32)).astype(xn.dtype) * jax.nn.silu(og)
    return jnp.concatenate([y_lru, y_gla], axis=-1) @ w_out


def s5_ssm(u, lam_re, lam_im, log_step, b_re, b_im, c_re, c_im, d_skip):
    B, S, _ = u.shape
    f32 = jnp.float32
    lr = jnp.minimum(lam_re.astype(f32), S5_MAX_RE)
    li = lam_im.astype(f32)
    dt = jnp.exp(log_step.astype(f32))[:, None]
    mag = jnp.exp(lr * dt)
    ab_re = mag * jnp.cos(li * dt)
    ab_im = mag * jnp.sin(li * dt)
    den = lr * lr + li * li
    coef_re = ((ab_re - 1.0) * lr + ab_im * li) / den
    coef_im = (ab_im * lr - (ab_re - 1.0) * li) / den
    bre = b_re.astype(f32)
    bim = b_im.astype(f32)
    bb_re = coef_re[..., None] * bre - coef_im[..., None] * bim
    bb_im = coef_re[..., None] * bim + coef_im[..., None] * bre
    ug = u.reshape(B, S, S5_GROUPS, S5_GROUP).astype(f32)
    bu_re = jnp.einsum('bsgh,gph->sbgp', ug, bb_re)
    bu_im = jnp.einsum('bsgh,gph->sbgp', ug, bb_im)
    a_re = jnp.broadcast_to(ab_re[None, None], (S, 1, S5_GROUPS, S5_STATE))
    a_im = jnp.broadcast_to(ab_im[None, None], (S, 1, S5_GROUPS, S5_STATE))

    def combine(l, r):
        ar_l, ai_l, br_l, bi_l = l
        ar_r, ai_r, br_r, bi_r = r
        return (ar_r * ar_l - ai_r * ai_l,
                ar_r * ai_l + ai_r * ar_l,
                ar_r * br_l - ai_r * bi_l + br_r,
                ar_r * bi_l + ai_r * br_l + bi_r)

    _, _, h_re, h_im = lax.associative_scan(combine, (a_re, a_im, bu_re, bu_im), axis=0)
    y = (jnp.einsum('sbgp,ghp->bsgh', h_re, c_re.astype(f32))
         - jnp.einsum('sbgp,ghp->bsgh', h_im, c_im.astype(f32)))
    y = y.reshape(B, S, D_S5) + d_skip.astype(f32) * u.astype(f32)
    return y.astype(u.dtype)


def odd_mixer(xn, w_in, lam_re, lam_im, log_step, b_re, b_im, c_re, c_im, d_skip, w_glu):
    u = xn @ w_in
    y = jax.nn.gelu(s5_ssm(u, lam_re, lam_im, log_step, b_re, b_im, c_re, c_im, d_skip))
    zz = y @ w_glu
    return zz[..., :D_MODEL] * jax.nn.sigmoid(zz[..., D_MODEL:])


def hier_moe(xn, w_rg, b_rg, w_re, b_re, w1, w3, w2):
    B, S, D = xn.shape
    f32 = jnp.float32
    t = xn.reshape(B * S, D)
    pg = jax.nn.softmax((t @ w_rg).astype(f32) + b_rg.astype(f32), axis=-1)
    gate_g, g_idx = lax.top_k(pg, 1)
    onehot_g = jax.nn.one_hot(g_idx[:, 0], N_EXPERT_GROUPS, dtype=f32)
    le = ((t @ w_re).astype(f32) + b_re.astype(f32)).reshape(-1, N_EXPERT_GROUPS, EXPERTS_PER_GROUP)
    le = jnp.einsum('tg,tge->te', onehot_g, le)
    pe = jax.nn.softmax(le, axis=-1)
    top_v, top_i = lax.top_k(pe, TOP_K_IN_GROUP)
    top_v = top_v / jnp.sum(top_v, axis=-1, keepdims=True)
    w_in_group = jnp.sum(jax.nn.one_hot(top_i, EXPERTS_PER_GROUP, dtype=f32) * top_v[..., None], axis=1)
    comb = (onehot_g[:, :, None] * (gate_g[:, :, None] * w_in_group[:, None, :])).astype(t.dtype)
    w1 = w1.reshape(N_EXPERT_GROUPS, EXPERTS_PER_GROUP, D, D_EXPERT)
    w3 = w3.reshape(N_EXPERT_GROUPS, EXPERTS_PER_GROUP, D, D_EXPERT)
    w2 = w2.reshape(N_EXPERT_GROUPS, EXPERTS_PER_GROUP, D_EXPERT, D)
    y = jnp.zeros_like(t)
    for g in range(N_EXPERT_GROUPS):
        h = jax.nn.silu(jnp.einsum('td,edf->tef', t, w1[g])) * jnp.einsum('td,edf->tef', t, w3[g])
        y = y + jnp.einsum('tef,efd->td', h * comb[:, g, :, None], w2[g])
    return y.reshape(B, S, D)


def setup_inputs(seed: int = 0) -> dict:
    key = jax.random.key(seed)
    ks = iter(jax.random.split(key, 48))
    f32 = jnp.float32

    def nrm(shape, scale):
        return jax.random.normal(next(ks), shape, f32) * scale

    def gain(shape):
        return 1.0 + nrm(shape, 0.01)

    inp = {}
    inp['x'] = nrm((BATCH, SEQ, D_MODEL), 1.0)
    inp['p'] = nrm((DEPTH, BATCH, SEQ, D_PLE), 1.0)
    inp['norm_mix'] = gain((DEPTH, D_MODEL))
    inp['norm_ffn'] = gain((DEPTH, D_MODEL))
    inp['norm_ple'] = gain((DEPTH, D_MODEL))
    inp['norm_final'] = gain((D_MODEL,))
    inp['ev_w_in'] = nrm((N_EVEN, D_MODEL, D_EVEN_IN), D_MODEL ** -0.5)
    inp['lru_conv_w'] = nrm((N_EVEN, CONV_WIDTH, D_LRU), CONV_WIDTH ** -0.5)
    inp['lru_conv_b'] = nrm((N_EVEN, D_LRU), 0.01)
    inp['lru_w_a'] = nrm((N_EVEN, LRU_HEADS, LRU_HEAD_DIM, LRU_HEAD_DIM), LRU_HEAD_DIM ** -0.5)
    inp['lru_b_a'] = nrm((N_EVEN, D_LRU), 0.01)
    inp['lru_w_x'] = nrm((N_EVEN, LRU_HEADS, LRU_HEAD_DIM, LRU_HEAD_DIM), LRU_HEAD_DIM ** -0.5)
    inp['lru_b_x'] = nrm((N_EVEN, D_LRU), 0.01)
    a8 = jax.random.uniform(next(ks), (N_EVEN, D_LRU), f32, minval=0.9, maxval=0.999)
    a = a8 ** (1.0 / LRU_C)
    inp['lru_lambda'] = jnp.log(a) - jnp.log1p(-a)
    inp['gla_w_gate'] = nrm((N_EVEN, GLA_RANK, GLA_QK), GLA_RANK ** -0.5)
    inp['gla_b_gate'] = nrm((N_EVEN, GLA_QK), 0.1)
    inp['gla_norm'] = gain((N_EVEN, GLA_V))
    inp['ev_w_out'] = nrm((N_EVEN, D_EVEN_MIX, D_MODEL), D_EVEN_MIX ** -0.5)
    inp['od_w_in'] = nrm((N_ODD, D_MODEL, D_S5), D_MODEL ** -0.5)
    inp['s5_lambda_re'] = -0.5 + nrm((N_ODD, S5_GROUPS, S5_STATE), 0.01)
    inp['s5_lambda_im'] = (jnp.pi * jnp.arange(S5_STATE, dtype=f32))[None, None, :] + nrm((N_ODD, S5_GROUPS, S5_STATE), 0.01)
    inp['s5_log_step'] = jax.random.uniform(next(ks), (N_ODD, S5_GROUPS), f32,
                                            minval=math.log(1e-3), maxval=math.log(1e-1))
    inp['s5_b_re'] = nrm((N_ODD, S5_GROUPS, S5_STATE, S5_GROUP), (2.0 * S5_GROUP) ** -0.5)
    inp['s5_b_im'] = nrm((N_ODD, S5_GROUPS, S5_STATE, S5_GROUP), (2.0 * S5_GROUP) ** -0.5)
    inp['s5_c_re'] = nrm((N_ODD, S5_GROUPS, S5_GROUP, S5_STATE), (2.0 * S5_STATE) ** -0.5)
    inp['s5_c_im'] = nrm((N_ODD, S5_GROUPS, S5_GROUP, S5_STATE), (2.0 * S5_STATE) ** -0.5)
    inp['s5_d'] = nrm((N_ODD, D_S5), 1.0)
    inp['od_w_glu'] = nrm((N_ODD, D_S5, 2 * D_MODEL), D_S5 ** -0.5)
    inp['moe_w_router_group'] = nrm((DEPTH, D_MODEL, N_EXPERT_GROUPS), D_MODEL ** -0.5)
    inp['moe_b_router_group'] = nrm((DEPTH, N_EXPERT_GROUPS), 0.01)
    inp['moe_w_router_expert'] = nrm((DEPTH, D_MODEL, N_EXPERTS), D_MODEL ** -0.5)
    inp['moe_b_router_expert'] = nrm((DEPTH, N_EXPERTS), 0.01)
    inp['moe_w1'] = nrm((DEPTH, N_EXPERTS, D_MODEL, D_EXPERT), D_MODEL ** -0.5)
    inp['moe_w3'] = nrm((DEPTH, N_EXPERTS, D_MODEL, D_EXPERT), D_MODEL ** -0.5)
    inp['moe_w2'] = nrm((DEPTH, N_EXPERTS, D_EXPERT, D_MODEL), D_EXPERT ** -0.5)
    inp['ple_w_gate'] = nrm((DEPTH, D_MODEL, D_MODEL), D_MODEL ** -0.5)
    inp['ple_b_gate'] = nrm((DEPTH, D_MODEL), 0.01)
    inp['ple_w_proj'] = nrm((DEPTH, D_PLE, D_MODEL), D_PLE ** -0.5)
    return inp


def reference(x, p, norm_mix, norm_ffn, norm_ple, norm_final,
              ev_w_in, lru_conv_w, lru_conv_b, lru_w_a, lru_b_a, lru_w_x, lru_b_x, lru_lambda,
              gla_w_gate, gla_b_gate, gla_norm, ev_w_out,
              od_w_in, s5_lambda_re, s5_lambda_im, s5_log_step, s5_b_re, s5_b_im,
              s5_c_re, s5_c_im, s5_d, od_w_glu,
              moe_w_router_group, moe_b_router_group, moe_w_router_expert, moe_b_router_expert,
              moe_w1, moe_w3, moe_w2,
              ple_w_gate, ple_b_gate, ple_w_proj):
    for l in range(DEPTH):
        xn = rms_norm(x, norm_mix[l])
        if l % 2 == 0:
            e = l // 2
            x = x + even_mixer(xn, ev_w_in[e], lru_conv_w[e], lru_conv_b[e], lru_w_a[e], lru_b_a[e],
                               lru_w_x[e], lru_b_x[e], lru_lambda[e], gla_w_gate[e], gla_b_gate[e],
                               gla_norm[e], ev_w_out[e])
        else:
            o = l // 2
            x = x + odd_mixer(xn, od_w_in[o], s5_lambda_re[o], s5_lambda_im[o], s5_log_step[o],
                              s5_b_re[o], s5_b_im[o], s5_c_re[o], s5_c_im[o], s5_d[o], od_w_glu[o])
        x = x + hier_moe(rms_norm(x, norm_ffn[l]), moe_w_router_group[l], moe_b_router_group[l],
                         moe_w_router_expert[l], moe_b_router_expert[l],
                         moe_w1[l], moe_w3[l], moe_w2[l])
        gate = jax.nn.sigmoid(rms_norm(x, norm_ple[l]) @ ple_w_gate[l] + ple_b_gate[l])
        x = x + gate * (p[l] @ ple_w_proj[l])
    return rms_norm(x, norm_final)
```

```cpp
#include <hip/hip_runtime.h>
#include <cstdio>
#include <cstdint>

#ifndef MK_PER_PHASE
#define MK_PER_PHASE 0
#endif

#define GAS __attribute__((address_space(1)))
#define LAS __attribute__((address_space(3)))
typedef unsigned short bf16;
typedef short bf16x8 __attribute__((ext_vector_type(8)));
typedef float f32x4 __attribute__((ext_vector_type(4)));
typedef float f32x2 __attribute__((ext_vector_type(2)));
typedef unsigned u32x4 __attribute__((ext_vector_type(4)));
typedef unsigned u32x2 __attribute__((ext_vector_type(2)));

constexpr int T = 8192, D = 2048, SEQ = 2048, NB = 4, DEPTH = 4;
constexpr int ZW = 5632;
constexpr int EV_IN = 5136;
constexpr float EPS = 1e-6f;
constexpr int NWAVES = 8, NTHR = 512;

constexpr size_t MiB = 1u << 20;
constexpr size_t WS_CTL = 0, CTL_BYTES = 1 * MiB;
constexpr size_t WS_WIN = 1 * MiB;
constexpr size_t SZ_WIN = (size_t)ZW * D * 2;
constexpr size_t WS_WOUT = WS_WIN + 2 * SZ_WIN;
constexpr size_t SZ_DD = (size_t)D * D * 2;
constexpr size_t WS_ODWIN = WS_WOUT + 2 * SZ_DD;
constexpr size_t SZ_ODWIN = (size_t)1024 * D * 2;
constexpr size_t WS_WGLU = WS_ODWIN + 2 * SZ_ODWIN;
constexpr size_t SZ_WGLU = (size_t)4096 * 1024 * 2;
constexpr size_t WS_PLEG = WS_WGLU + 2 * SZ_WGLU;
constexpr size_t WS_PLEP = WS_PLEG + 4 * SZ_DD;
constexpr size_t SZ_PLEP = (size_t)D * 256 * 2;
constexpr size_t WS_W13 = WS_PLEP + 4 * SZ_PLEP;
constexpr size_t WS_RTW = WS_W13;
constexpr int RTW_IMG = 2 * 4 * 48 * 40;
constexpr size_t SZ_W13 = (size_t)1024 * D * 2;
constexpr size_t WS_W2 = WS_W13 + 128 * SZ_W13;
constexpr size_t SZ_W2 = (size_t)D * 512 * 2;
constexpr size_t WS_XRES = WS_W2 + 128 * SZ_W2;
constexpr size_t WS_XN = WS_XRES + (size_t)T * D * 4;
constexpr size_t WS_Z = WS_XN + (size_t)T * D * 2;
constexpr size_t WS_YCAT = WS_Z + (size_t)T * ZW * 2;
constexpr size_t WS_DS = WS_YCAT + (size_t)T * D * 2;
constexpr size_t SZ_DS = (size_t)16 * 32 * 128 * 256 * 4;
constexpr size_t WS_SPREV = WS_DS + SZ_DS;
constexpr size_t WS_DECAY = WS_SPREV + SZ_DS;
constexpr size_t WS_U = WS_DECAY + (size_t)16 * 32 * 128 * 4;
constexpr size_t WS_YS5 = WS_U + (size_t)2 * T * 1024 * 2;
constexpr size_t WS_PB = WS_YS5 + (size_t)T * 1024 * 2;
constexpr size_t WS_PP = WS_PB + (size_t)4 * T * 256 * 2;
constexpr size_t WS_H = WS_PP + (size_t)4 * T * D * 2;
constexpr size_t WS_Y = WS_H + (size_t)2 * T * 512 * 2;
constexpr size_t WS_LIST = WS_Y + (size_t)2 * T * D * 2;
constexpr size_t WS_COMB = WS_LIST + (size_t)32 * 8192 * 4;
constexpr size_t WS_RS = WS_COMB + (size_t)2 * T * 4;
constexpr size_t WS_END = WS_RS + (size_t)T * 4;
constexpr int CW_BAR = 4096;
constexpr int CW_FLAG = 32768;
constexpr int CW_CNT = 16384;

constexpr int LDS_BYTES = 163840;
constexpr int EXTRA_OFF = 147456;
constexpr int MISC_OFF = LDS_BYTES - 256;

__device__ __forceinline__ float bf2f(unsigned b) { return __uint_as_float(b << 16); }
__device__ __forceinline__ unsigned f2bf(float f) { unsigned u = __float_as_uint(f); return (u + 0x7fffu + ((u >> 16) & 1u)) >> 16; }
typedef __bf16 bf16x2_t __attribute__((ext_vector_type(2)));
__device__ __forceinline__ unsigned pk2(float lo, float hi) { const bf16x2_t r = __builtin_convertvector((f32x2){lo, hi}, bf16x2_t); return __builtin_bit_cast(unsigned, r); }
__device__ __forceinline__ float lo16(unsigned w) { return __uint_as_float(w << 16); }
__device__ __forceinline__ float hi16(unsigned w) { return __uint_as_float(w & 0xffff0000u); }
__device__ __forceinline__ f32x4 up4(u32x2 w) { return (f32x4){lo16(w.x), hi16(w.x), lo16(w.y), hi16(w.y)}; }
__device__ __forceinline__ u32x2 dn4(f32x4 v) { u32x2 w; w.x = pk2(v[0], v[1]); w.y = pk2(v[2], v[3]); return w; }
__device__ __forceinline__ float sigmoidf_(float x) { return __builtin_amdgcn_rcpf(1.0f + __expf(-x)); }
__device__ __forceinline__ float one_minus_exp(float t) { const float ser = -t * (1.0f + 0.5f * t * (1.0f + (1.0f / 3.0f) * t * (1.0f + 0.25f * t))); return t > -0.03125f ? ser : 1.0f - __expf(t); }
__device__ __forceinline__ float siluf_(float x) { return x * sigmoidf_(x); }
__device__ __forceinline__ float gelu_tanh(float x) { return x * sigmoidf_(1.5957691216f * (x + 0.044715f * x * x * x)); }
__device__ __forceinline__ float softplusf_(float x) { return fmaxf(x, 0.f) + log1pf(__expf(-fabsf(x))); }
__device__ __forceinline__ float logsigmoidf_(float x) { return fminf(x, 0.f) - __logf(1.0f + __expf(-fabsf(x))); }
__device__ __forceinline__ float dpp_f(float v, const int ctrl_sel) {
    const int i = __builtin_bit_cast(int, v);
    int r;
    if (ctrl_sel == 0) r = __builtin_amdgcn_update_dpp(0, i, 0xB1, 0xF, 0xF, false);
    else if (ctrl_sel == 1) r = __builtin_amdgcn_update_dpp(0, i, 0x4E, 0xF, 0xF, false);
    else if (ctrl_sel == 2) r = __builtin_amdgcn_update_dpp(0, i, 0x141, 0xF, 0xF, false);
    else r = __builtin_amdgcn_update_dpp(0, i, 0x140, 0xF, 0xF, false);
    return __builtin_bit_cast(float, r);
}
__device__ __forceinline__ float shx(float v, int mask, int lane) { return __builtin_bit_cast(float, __builtin_amdgcn_ds_bpermute((lane ^ mask) << 2, __builtin_bit_cast(int, v))); }
__device__ __forceinline__ float wave_sum(float v) {
    v += dpp_f(v, 0); v += dpp_f(v, 1); v += dpp_f(v, 2); v += dpp_f(v, 3);
    const int i = __builtin_bit_cast(int, v);
    const float r0 = __builtin_bit_cast(float, __builtin_amdgcn_readlane(i, 0)), r1 = __builtin_bit_cast(float, __builtin_amdgcn_readlane(i, 16));
    const float r2 = __builtin_bit_cast(float, __builtin_amdgcn_readlane(i, 32)), r3 = __builtin_bit_cast(float, __builtin_amdgcn_readlane(i, 48));
    return (r0 + r1) + (r2 + r3);
}
__device__ __forceinline__ void st16_wt(void* p, u32x4 v) { asm volatile("global_store_dwordx4 %0, %1, off sc1\n\ts_nop 1" :: "v"(p), "v"(v) : "memory"); }
#define LDS_WAIT() asm volatile("s_waitcnt lgkmcnt(0)" ::: "memory")
#define LDS_BARRIER() do { asm volatile("s_waitcnt lgkmcnt(0)" ::: "memory"); __builtin_amdgcn_s_barrier(); asm volatile("" ::: "memory"); } while (0)
__device__ __forceinline__ int opaque_v(int v) { asm volatile("" : "+v"(v)); return v; }
__device__ __forceinline__ int lane_now() { int z = 0; asm volatile("" : "+s"(z)); return (int)__builtin_amdgcn_mbcnt_hi(~0u, __builtin_amdgcn_mbcnt_lo(~0u, (unsigned)z)); }
__device__ __forceinline__ int opaque_s(int v) { v = __builtin_amdgcn_readfirstlane(v); asm volatile("" : "+s"(v)); return v; }
__device__ __forceinline__ unsigned char* opaque_p(unsigned char* p) { __attribute__((address_space(1))) unsigned char* g = (__attribute__((address_space(1))) unsigned char*)p; asm volatile("" : "+s"(g)); return (unsigned char*)g; }

#define XB_TMO      128
#define XB_XCNT(j)  (256  + 64 * (j))
#define XB_XSUB(j)  (1280 + 64 * (j))
#define XB_XGEN(j)  (2304 + 64 * (j))
#define XB_TOP      3328
#define XB_TOPGEN   3392
#define XCD_BAR_WORDS 3456
#define XB_SPIN_CAP (1u << 18)
__device__ __forceinline__ unsigned xb_ld(unsigned* p)              { return __hip_atomic_load(p, __ATOMIC_RELAXED, __HIP_MEMORY_SCOPE_AGENT); }
__device__ __forceinline__ unsigned xb_add(unsigned* p, unsigned v) { return __hip_atomic_fetch_add(p, v, __ATOMIC_RELAXED, __HIP_MEMORY_SCOPE_AGENT); }
__device__ __forceinline__ unsigned xb_xcc_id() { return (unsigned)__builtin_amdgcn_s_getreg((3 << 11) | 20) & 0xFu; }
#define XB_SPIN(cond, bar) do { unsigned _sp = 0; while (cond) { __builtin_amdgcn_s_sleep(1); \
    if ((++_sp & 255u) == 0u) { if (xb_ld(&(bar)[XB_TMO])) break; if (_sp > XB_SPIN_CAP) { atomicAdd(&(bar)[XB_TMO], 1u); break; } } } } while (0)
struct XcdBarrier { unsigned* bar; unsigned x; volatile LAS unsigned* st; };
__device__ __forceinline__ XcdBarrier xcd_barrier_post(unsigned* bar, volatile LAS unsigned* st) {
    XcdBarrier b; b.bar = bar; b.x = xb_xcc_id(); b.st = st;
    if (threadIdx.x == 0) st[2] = xb_add(&bar[XB_XCNT(b.x)], 1u);
    return b;
}
__device__ __forceinline__ unsigned long long xcd_barrier_complete(unsigned* bar, unsigned x) {
    const unsigned G = gridDim.x * gridDim.y * gridDim.z;
    unsigned sum, cnt, mine, sp = 0u;
    for (;;) {
        sum = 0u; cnt = 0u; mine = 0u;
#pragma unroll 1
        for (unsigned j = 0; j < 16; ++j) { const unsigned c = xb_ld(&bar[XB_XCNT(j)]); sum += c; cnt += (c > 0u) ? 1u : 0u; mine = (j == x) ? c : mine; }
        if (sum == G) break;
        __builtin_amdgcn_s_sleep(1);
        if ((++sp & 255u) == 0u) { if (xb_ld(&bar[XB_TMO])) break; if (sp > XB_SPIN_CAP) { atomicAdd(&bar[XB_TMO], 1u); break; } }
    }
    const unsigned nloc = mine > 0u ? mine : 1u, nx = cnt > 0u ? cnt : 1u;
    return ((unsigned long long)nx << 32) | nloc;
}
__device__ __forceinline__ void xcd_barrier_leader(unsigned* bar, unsigned x, volatile LAS unsigned* st) {
    __builtin_amdgcn_s_waitcnt(0);
    unsigned nloc = st[0], nx = st[1];
    if (nloc == 0u) { const unsigned long long r = xcd_barrier_complete(bar, x); nloc = (unsigned)r; nx = (unsigned)(r >> 32); st[0] = nloc; st[1] = nx; }
    const unsigned old = xb_add(&bar[XB_XSUB(x)], 1u);
    const unsigned gen = old / nloc;
    if (old + 1u == (gen + 1u) * nloc) {
        __builtin_amdgcn_fence(__ATOMIC_RELEASE, "agent");
        asm volatile("s_waitcnt vmcnt(0)" ::: "memory");
        const unsigned og = xb_add(&bar[XB_TOP], 1u);
        const unsigned tg = og / nx;
        if (og + 1u == (tg + 1u) * nx) xb_add(&bar[XB_TOPGEN], 1u);
        else XB_SPIN(xb_ld(&bar[XB_TOPGEN]) == tg, bar);
        __builtin_amdgcn_fence(__ATOMIC_ACQUIRE, "agent");
        xb_add(&bar[XB_XGEN(x)], 1u);
        asm volatile("s_waitcnt vmcnt(0)" ::: "memory");
    } else {
        XB_SPIN(xb_ld(&bar[XB_XGEN(x)]) == gen, bar);
        __builtin_amdgcn_fence(__ATOMIC_ACQUIRE, "agent");
        asm volatile("s_waitcnt vmcnt(0)" ::: "memory");
    }
}
__device__ __forceinline__ void xcd_barrier(const XcdBarrier& b, const bool leader) {
    asm volatile("s_waitcnt vmcnt(0)" ::: "memory");
    __syncthreads();
    if (leader) xcd_barrier_leader(b.bar, b.x, b.st);
    __syncthreads();
}

struct Args { const float* in[38]; float* out; unsigned char* ws; int ph_lo, ph_hi; };
typedef const Args __attribute__((address_space(4))) KArgs;
__device__ __forceinline__ KArgs* opaque_k(KArgs* p) { asm volatile("" : "+s"(p)); return p; }
struct Frame {
    LAS unsigned char* lds;
    int tid, lane, wave, vcu, G;
    unsigned char* ws;
};

namespace pg8 {
constexpr int BM = 256, BK = 64, HALF = 128, HTB = HALF * BK * 2, STAGE_BYTES = 8 * HTB, NXCD = 8, WGM = 8;
__device__ __forceinline__ int lds_byte(int r, int c) { const int st = (r >> 4) * 2 + (c >> 5), rr = r & 15, cc = c & 31, ob = rr * 64 + cc * 2; return st * 1024 + (ob ^ (((ob >> 9) & 1) << 5)); }
__device__ __forceinline__ void stage_rc(int b, int& R, int& C) { const int st = b / 1024, sb = b % 1024, swz = sb ^ (((sb >> 9) & 1) << 5); R = (st >> 1) * 16 + swz / 64; C = (st & 1) * 32 + (swz % 64) / 2; }

struct Unit { int pm, pn; size_t a_off, b_off; int ui, e, nrows; };

struct StaticOrder {
    int nM, nN, nwg, G, c, K;
    __device__ void init(int M, int N, int K_, int G_, int c_) { nM = M / BM; nN = N / BM; nwg = nM * nN; G = G_; c = c_; K = K_; }
    __device__ __forceinline__ bool next(int i, Unit& u) const {
        const long L = (long)i * G + c; if (L >= nwg) return false;
        int wgid = (int)L; { const int q = nwg / NXCD, r = nwg % NXCD, xcd = wgid % NXCD, off = wgid / NXCD; wgid = (xcd < r ? xcd * (q + 1) : r * (q + 1) + (xcd - r) * q) + off; }
        const int nig = WGM * nN, gid = wgid / nig, fm = gid * WGM, gsz = (nM - fm) < WGM ? (nM - fm) : WGM;
        u.pm = fm + ((wgid % nig) % gsz); u.pn = (wgid % nig) / gsz;
        u.a_off = (size_t)u.pm * BM * K * 2; u.b_off = (size_t)u.pn * BM * K * 2; u.ui = i; u.e = 0; u.nrows = BM;
        return true;
    }
    __device__ __forceinline__ unsigned row_off(const Unit&, int) const { return 0u; }
};

struct SplitK2Order {
    StaticOrder base;
    __device__ void init(int M, int N, int K_, int G_, int c_) { base.init(M, N, K_, G_, c_); }
    __device__ __forceinline__ bool next(int i, Unit& u) const {
        const long L = (long)i * base.G + base.c; if (L >= 2 * base.nwg) return false;
        StaticOrder b2 = base; b2.G = 1; b2.c = 0;
        const int kh = (int)(L & 1); if (!b2.next((int)(L >> 1), u)) return false;
        u.a_off += (size_t)kh * base.K; u.b_off += (size_t)kh * base.K; u.ui = i; u.e = kh; return true;
    }
    __device__ __forceinline__ unsigned row_off(const Unit&, int) const { return 0u; }
};
struct PPOrder {
    StaticOrder base; size_t a_layer, b_layer;
    __device__ void init(int M, int N, int K_, int G_, int c_, size_t a_layer_, size_t b_layer_) { base.init(M, N, K_, G_, c_); a_layer = a_layer_; b_layer = b_layer_; }
    __device__ __forceinline__ bool next(int i, Unit& u) const {
        const long L = (long)i * base.G + base.c; if (L >= 4L * base.nwg) return false;
        const int ll = (int)(L / base.nwg); StaticOrder b2 = base; b2.G = 1; b2.c = 0;
        if (!b2.next((int)(L - (long)ll * base.nwg), u)) return false;
        u.a_off += (size_t)ll * a_layer; u.b_off += (size_t)ll * b_layer; u.ui = i; u.e = ll; return true;
    }
    __device__ __forceinline__ unsigned row_off(const Unit&, int) const { return 0u; }
};
constexpr int MOE_MAXU = 4;
struct MoeOrder {
    const LAS int* pre;
    const LAS int* cnt;
    const LAS int* ptab;
    int nct, G, c, K, brows;
    unsigned rshift_mask;
    unsigned rbytes;
    __device__ __forceinline__ bool decode(int i, int& e, int& rt, int& ct) const {
        if (i >= MOE_MAXU) return false;
        const int L = i * G + c, total = pre[32] * nct; if (L >= total) return false;
        const int rtg = L / nct; ct = L - rtg * nct; e = 0;
        for (int j = 1; j < 32; ++j) e = (pre[j] <= rtg) ? j : e;
        rt = rtg - pre[e]; return true;
    }
    __device__ __forceinline__ bool next(int i, Unit& u) const {
        int e, rt, ct; if (!decode(i, e, rt, ct)) return false;
        u.pm = rt; u.pn = ct; u.a_off = 0; u.b_off = ((size_t)e * brows + (size_t)ct * BM) * K * 2; u.ui = i; u.e = e;
        const int left = cnt[e] - rt * BM; u.nrows = left < BM ? left : BM; return true;
    }
    __device__ __forceinline__ unsigned row_off(const Unit& u, int r) const { const int p = ptab[u.ui * 256 + r]; return p < 0 ? 0u : ((unsigned)p & rshift_mask) * rbytes; }
};

template <class Epi, class Sched, bool GATHER>
__device__ __forceinline__ void gemm_phase(const int tid, LAS unsigned char* lds, const char* Abase, const char* Bbase, const int K, const Sched& S, const Epi& E, const int ntl = 0) {
    const int wid = __builtin_amdgcn_readfirstlane(tid >> 6), lane = tid & 63, wr = wid >> 2, wc = wid & 3, fr = lane & 15, fq = lane >> 4;
    const int nt = ntl ? ntl : K / BK;
    unsigned voff[2]; int RR[2]; unsigned CC2[2];
#pragma unroll
    for (int i = 0; i < 2; ++i) { int R, C; stage_rc(tid * 16 + i * 8192, R, C); voff[i] = (unsigned)(R * K + C) * 2u; RR[i] = R; CC2[i] = (unsigned)C * 2u; }
    const size_t kstep = (size_t)(BK * 2);
    const size_t hstep = (size_t)HALF * K * 2;
    const unsigned ldsw = (unsigned)wid * 1024u;
    const int aoff = lds_byte(wr * 64 + fr, fq * 8), boff = lds_byte(wc * 32 + fr, fq * 8);
#define PG8_SA(b, h) (((b) * 2 + (h)) * HTB)
#define PG8_SB(b, h) ((4 + (b) * 2 + (h)) * HTB)
#define PG8_STAGE_B(bufoff, gbase) do { _Pragma("unroll") for (int _i = 0; _i < 2; ++_i) \
        __builtin_amdgcn_global_load_lds((const unsigned*)((const char*)(gbase) + voff[_i]), (LAS unsigned*)(lds + (bufoff) + ldsw + _i * 8192), 16, 0, 0); } while (0)
#define PG8_STAGE_A(bufoff, gbase, ro, kb) do { _Pragma("unroll") for (int _i = 0; _i < 2; ++_i) { \
        if constexpr (GATHER) __builtin_amdgcn_global_load_lds((const unsigned*)(Abase + ((ro)[_i] + (unsigned)(kb))), (LAS unsigned*)(lds + (bufoff) + ldsw + _i * 8192), 16, 0, 0); \
        else __builtin_amdgcn_global_load_lds((const unsigned*)((const char*)(gbase) + voff[_i]), (LAS unsigned*)(lds + (bufoff) + ldsw + _i * 8192), 16, 0, 0); } } while (0)
#define PG8_LDA(dst, b, h) do { _Pragma("unroll") for (int m = 0; m < 4; ++m) _Pragma("unroll") for (int k = 0; k < 2; ++k) dst[m][k] = *(const LAS bf16x8*)(lds + PG8_SA(b, h) + aoff + m * 2048 + k * 1024); } while (0)
#define PG8_LDB(dst, b, h) do { _Pragma("unroll") for (int n = 0; n < 2; ++n) _Pragma("unroll") for (int k = 0; k < 2; ++k) dst[n][k] = *(const LAS bf16x8*)(lds + PG8_SB(b, h) + boff + n * 2048 + k * 1024); } while (0)
#define PG8_MMA(ai, bj, At, Bt) do { __builtin_amdgcn_s_setprio(1); _Pragma("unroll") for (int m = 0; m < 4; ++m) _Pragma("unroll") for (int n = 0; n < 2; ++n) _Pragma("unroll") for (int k = 0; k < 2; ++k) \
        acc[ai][bj][m][n] = __builtin_amdgcn_mfma_f32_16x16x32_bf16(Bt[n][k], At[m][k], acc[ai][bj][m][n], 0, 0, 0); __builtin_amdgcn_s_setprio(0); } while (0)
#define PG8_WAIT_V(n) asm volatile("s_waitcnt vmcnt(" #n ")" ::: "memory")
#define PG8_WAIT_L(n) asm volatile("s_waitcnt lgkmcnt(" #n ")" ::: "memory")
#define PG8_BAR __builtin_amdgcn_s_barrier()
#define PG8_SCHED __builtin_amdgcn_sched_barrier(0)
    Unit cur, nxt; int ui = 0;
    if (!S.next(0, cur)) return;
    f32x4 acc[2][2][4][2];
#pragma unroll
    for (int a = 0; a < 2; ++a)
#pragma unroll
        for (int b = 0; b < 2; ++b)
#pragma unroll
            for (int m = 0; m < 4; ++m)
#pragma unroll
                for (int n = 0; n < 2; ++n) acc[a][b][m][n] = (f32x4){0.f, 0.f, 0.f, 0.f};
    bf16x8 At[4][2], B0[2][2], B1[2][2];
    const char* cA = Abase + cur.a_off; const char* cB = Bbase + cur.b_off;
    unsigned cro0[2] = {0u, 0u}, cro1[2] = {0u, 0u}, nro0[2] = {0u, 0u}, nro1[2] = {0u, 0u};
    if constexpr (GATHER) {
#pragma unroll
        for (int i = 0; i < 2; ++i) { cro0[i] = S.row_off(cur, RR[i]) + CC2[i]; cro1[i] = S.row_off(cur, 128 + RR[i]) + CC2[i]; }
    }
    PG8_STAGE_B(PG8_SB(0, 0), cB); PG8_STAGE_A(PG8_SA(0, 0), cA, cro0, 0); PG8_STAGE_B(PG8_SB(0, 1), cB + hstep); PG8_STAGE_A(PG8_SA(0, 1), cA + hstep, cro1, 0);
    if (wr == 1) PG8_BAR;
    PG8_WAIT_V(4); PG8_BAR;
    PG8_STAGE_B(PG8_SB(1, 0), cB + kstep); PG8_STAGE_A(PG8_SA(1, 0), cA + kstep, cro0, kstep); PG8_STAGE_B(PG8_SB(1, 1), cB + hstep + kstep);
    PG8_WAIT_V(6); PG8_BAR;
    for (;;) {
        const bool has_next = S.next(ui + 1, nxt);
        const char* nA = has_next ? Abase + nxt.a_off : cA; const char* nB = has_next ? Bbase + nxt.b_off : cB;
        if constexpr (GATHER) {
#pragma unroll
            for (int i = 0; i < 2; ++i) { nro0[i] = has_next ? S.row_off(nxt, RR[i]) + CC2[i] : cro0[i]; nro1[i] = has_next ? S.row_off(nxt, 128 + RR[i]) + CC2[i] : cro1[i]; }
        }
        for (int t = 0; t < nt; t += 2) {
            const bool last = (t == nt - 2);
            const char* a1 = cA + (size_t)(t + 1) * kstep;
            const char* a2 = last ? nA : cA + (size_t)(t + 2) * kstep; const char* b2 = last ? nB : cB + (size_t)(t + 2) * kstep;
            const char* a3 = a2 + kstep; const char* b3 = b2 + kstep;
            unsigned r20[2], r21[2]; unsigned k1 = 0, k2 = 0, k3 = 0;
            if constexpr (GATHER) {
#pragma unroll
                for (int i = 0; i < 2; ++i) { r20[i] = last ? nro0[i] : cro0[i]; r21[i] = last ? nro1[i] : cro1[i]; }
                k1 = (unsigned)(t + 1) * 128u; k2 = last ? 0u : (unsigned)(t + 2) * 128u; k3 = k2 + 128u;
            } else { r20[0] = r20[1] = r21[0] = r21[1] = 0u; }
            PG8_LDB(B0, 0, 0); PG8_SCHED; PG8_LDA(At, 0, 0); PG8_STAGE_A(PG8_SA(1, 1), a1 + hstep, cro1, k1);
            PG8_WAIT_L(8); PG8_BAR; PG8_WAIT_L(0); PG8_MMA(0, 0, At, B0); PG8_BAR; PG8_SCHED;
            PG8_LDB(B1, 0, 1); PG8_STAGE_B(PG8_SB(0, 0), b2);
            PG8_BAR; PG8_WAIT_L(0); PG8_MMA(0, 1, At, B1); PG8_BAR;
            PG8_LDA(At, 0, 1); PG8_STAGE_A(PG8_SA(0, 0), a2, r20, k2);
            PG8_BAR; PG8_WAIT_L(0); PG8_MMA(1, 0, At, B0); PG8_BAR; PG8_SCHED;
            PG8_STAGE_B(PG8_SB(0, 1), b2 + hstep);
            PG8_WAIT_V(6); PG8_BAR; PG8_MMA(1, 1, At, B1); PG8_BAR;
            PG8_LDB(B0, 1, 0); PG8_SCHED; PG8_LDA(At, 1, 0); PG8_STAGE_A(PG8_SA(0, 1), a2 + hstep, r21, k2);
            PG8_WAIT_L(8); PG8_BAR; PG8_WAIT_L(0); PG8_MMA(0, 0, At, B0); PG8_BAR; PG8_SCHED;
            PG8_LDB(B1, 1, 1); PG8_STAGE_B(PG8_SB(1, 0), b3);
            PG8_BAR; PG8_WAIT_L(0); PG8_MMA(0, 1, At, B1); PG8_BAR;
            PG8_LDA(At, 1, 1); PG8_STAGE_A(PG8_SA(1, 0), a3, r20, k3);
            PG8_BAR; PG8_WAIT_L(0); PG8_MMA(1, 0, At, B0); PG8_BAR; PG8_SCHED;
            PG8_STAGE_B(PG8_SB(1, 1), b3 + hstep);
            PG8_WAIT_V(6); PG8_BAR; PG8_MMA(1, 1, At, B1); PG8_BAR;
        }
        E(acc, cur, wr, wc, fr, fq);
        if (!has_next) break;
#pragma unroll
        for (int a = 0; a < 2; ++a)
#pragma unroll
            for (int b = 0; b < 2; ++b)
#pragma unroll
                for (int m = 0; m < 4; ++m)
#pragma unroll
                    for (int n = 0; n < 2; ++n) acc[a][b][m][n] = (f32x4){0.f, 0.f, 0.f, 0.f};
        cur = nxt; cA = nA; cB = nB; ++ui;
        if constexpr (GATHER) {
#pragma unroll
            for (int i = 0; i < 2; ++i) { cro0[i] = nro0[i]; cro1[i] = nro1[i]; }
        }
    }
    PG8_WAIT_V(0);
    if (wr == 0) PG8_BAR;
    PG8_BAR;
#undef PG8_SA
#undef PG8_SB
#undef PG8_STAGE_A
#undef PG8_STAGE_B
#undef PG8_LDA
#undef PG8_LDB
#undef PG8_MMA
#undef PG8_WAIT_V
#undef PG8_WAIT_L
#undef PG8_BAR
#undef PG8_SCHED
}

#define EPI_ROWS_BEGIN _Pragma("unroll") for (int ai = 0; ai < 2; ++ai) _Pragma("unroll") for (int m = 0; m < 4; ++m) { const int rl = ai * HALF + wr * 64 + m * 16 + fr;
#define EPI_ROWS_END }
struct EpiStoreBf16 {
    bf16* O; int ldc; const float* rs;
    __device__ __forceinline__ void operator()(const f32x4 (&acc)[2][2][4][2], const Unit& u, int wr, int wc, int fr, int fq) const {
        EPI_ROWS_BEGIN bf16* rowp = O + (size_t)(u.pm * BM + rl) * ldc + u.pn * BM + wc * 32 + 4 * fq; const float sc = rs ? rs[u.pm * BM + rl] : 1.0f;
#pragma unroll
            for (int bj = 0; bj < 2; ++bj)
#pragma unroll
                for (int n = 0; n < 2; ++n) { const f32x4 v = acc[ai][bj][m][n] * sc; u32x2 w; w.x = pk2(v[0], v[1]); w.y = pk2(v[2], v[3]); *(u32x2*)(rowp + bj * HALF + n * 16) = w; } EPI_ROWS_END
    }
};
struct EpiStoreBf16Split {
    bf16* O; int ldc; size_t half_stride; const float* rs;
    __device__ __forceinline__ void operator()(const f32x4 (&acc)[2][2][4][2], const Unit& u, int wr, int wc, int fr, int fq) const {
        EPI_ROWS_BEGIN bf16* rowp = O + (size_t)u.e * half_stride + (size_t)(u.pm * BM + rl) * ldc + u.pn * BM + wc * 32 + 4 * fq; const float sc = rs ? rs[u.pm * BM + rl] : 1.0f;
#pragma unroll
            for (int bj = 0; bj < 2; ++bj)
#pragma unroll
                for (int n = 0; n < 2; ++n) { const f32x4 v = acc[ai][bj][m][n] * sc; u32x2 w; w.x = pk2(v[0], v[1]); w.y = pk2(v[2], v[3]); *(u32x2*)(rowp + bj * HALF + n * 16) = w; } EPI_ROWS_END
    }
};
struct EpiResid {
    bf16* X;
    __device__ __forceinline__ void operator()(const f32x4 (&acc)[2][2][4][2], const Unit& u, int wr, int wc, int fr, int fq) const {
#pragma unroll
        for (int ai = 0; ai < 2; ++ai)
#pragma unroll
            for (int mp = 0; mp < 2; ++mp) { bf16* base = X + (size_t)(u.pm * BM + ai * HALF + wr * 64 + mp * 32 + fr) * D + u.pn * BM + wc * 32 + 4 * fq; u32x2 xv[2][2][2];
#pragma unroll
                for (int m = 0; m < 2; ++m)
#pragma unroll
                    for (int bj = 0; bj < 2; ++bj)
#pragma unroll
                        for (int n = 0; n < 2; ++n) xv[m][bj][n] = *(const u32x2*)(base + (size_t)m * 16 * D + bj * HALF + n * 16);
#pragma unroll
                for (int m = 0; m < 2; ++m)
#pragma unroll
                    for (int bj = 0; bj < 2; ++bj)
#pragma unroll
                        for (int n = 0; n < 2; ++n) *(u32x2*)(base + (size_t)m * 16 * D + bj * HALF + n * 16) = dn4(up4(xv[m][bj][n]) + acc[ai][bj][mp * 2 + m][n]);
                asm volatile("" ::: "memory"); }
    }
};
struct EpiGlu {
    bf16* X;
    __device__ __forceinline__ void operator()(const f32x4 (&acc)[2][2][4][2], const Unit& u, int wr, int wc, int fr, int fq) const {
#pragma unroll
        for (int ai = 0; ai < 2; ++ai) { u32x2 xv[4][2];
#pragma unroll
            for (int m = 0; m < 4; ++m)
#pragma unroll
                for (int bj = 0; bj < 2; ++bj) xv[m][bj] = *(const u32x2*)(X + (size_t)(u.pm * BM + ai * HALF + wr * 64 + m * 16 + fr) * D + 4 * fq + 16 * (8 * u.pn + 4 * bj + wc));
#pragma unroll
            for (int m = 0; m < 4; ++m)
#pragma unroll
                for (int bj = 0; bj < 2; ++bj) { const f32x4 a = acc[ai][bj][m][0], g = acc[ai][bj][m][1]; f32x4 x = up4(xv[m][bj]);
#pragma unroll
                    for (int j = 0; j < 4; ++j) x[j] += a[j] * sigmoidf_(g[j]);
                    *(u32x2*)(X + (size_t)(u.pm * BM + ai * HALF + wr * 64 + m * 16 + fr) * D + 4 * fq + 16 * (8 * u.pn + 4 * bj + wc)) = dn4(x); }
            asm volatile("" ::: "memory"); }
    }
};
struct EpiPle {
    const bf16* X; bf16* Xo; const bf16* PP; const float* bias; const float* rs;
    __device__ __forceinline__ void operator()(const f32x4 (&acc)[2][2][4][2], const Unit& u, int wr, int wc, int fr, int fq) const {
        const int col0 = u.pn * BM + wc * 32 + 4 * fq;
        f32x4 bv[2][2];
#pragma unroll
        for (int bj = 0; bj < 2; ++bj)
#pragma unroll
            for (int n = 0; n < 2; ++n) bv[bj][n] = *(const f32x4*)(bias + col0 + bj * HALF + n * 16);
#pragma unroll
        for (int ai = 0; ai < 2; ++ai)
#pragma unroll
            for (int mp = 0; mp < 2; ++mp) { const size_t ro = (size_t)(u.pm * BM + ai * HALF + wr * 64 + mp * 32 + fr) * D + col0; u32x2 xv[2][2][2], pw[2][2][2];
                const float sc[2] = {rs[u.pm * BM + ai * HALF + wr * 64 + mp * 32 + fr], rs[u.pm * BM + ai * HALF + wr * 64 + mp * 32 + 16 + fr]};
#pragma unroll
                for (int m = 0; m < 2; ++m)
#pragma unroll
                    for (int bj = 0; bj < 2; ++bj)
#pragma unroll
                        for (int n = 0; n < 2; ++n) { const size_t o = ro + (size_t)m * 16 * D + bj * HALF + n * 16; xv[m][bj][n] = *(const u32x2*)(X + o); pw[m][bj][n] = *(const u32x2*)(PP + o); }
#pragma unroll
                for (int m = 0; m < 2; ++m)
#pragma unroll
                    for (int bj = 0; bj < 2; ++bj)
#pragma unroll
                        for (int n = 0; n < 2; ++n) { const size_t o = ro + (size_t)m * 16 * D + bj * HALF + n * 16; const f32x4 v = acc[ai][bj][mp * 2 + m][n] * sc[m] + bv[bj][n]; f32x4 x = up4(xv[m][bj][n]); const f32x4 p = up4(pw[m][bj][n]);
#pragma unroll
                            for (int j = 0; j < 4; ++j) x[j] += sigmoidf_(v[j]) * p[j];
                            *(u32x2*)(Xo + o) = dn4(x); }
                asm volatile("" ::: "memory"); }
    }
};
struct EpiMoeH {
    bf16* H; const float* comb; const LAS int* ptab;
    __device__ __forceinline__ void operator()(const f32x4 (&acc)[2][2][4][2], const Unit& u, int wr, int wc, int fr, int fq) const {
        EPI_ROWS_BEGIN const int pair = ptab[u.ui * 256 + rl];
            if (pair >= 0) { const float cb = comb[pair]; bf16* rowp = H + (size_t)pair * 512 + 4 * fq;
#pragma unroll
                for (int bj = 0; bj < 2; ++bj) { const f32x4 g = acc[ai][bj][m][0], up = acc[ai][bj][m][1]; u32x2 w;
                    w.x = pk2(siluf_(g[0]) * up[0] * cb, siluf_(g[1]) * up[1] * cb); w.y = pk2(siluf_(g[2]) * up[2] * cb, siluf_(g[3]) * up[3] * cb);
                    *(u32x2*)(rowp + 16 * (8 * u.pn + 4 * bj + wc)) = w; } } EPI_ROWS_END
    }
};
struct EpiMoeY {
    bf16* Y; const LAS int* ptab;
    __device__ __forceinline__ void operator()(const f32x4 (&acc)[2][2][4][2], const Unit& u, int wr, int wc, int fr, int fq) const {
        EPI_ROWS_BEGIN const int pair = ptab[u.ui * 256 + rl];
            if (pair >= 0) { bf16* rowp = Y + (size_t)pair * D + u.pn * BM + wc * 32 + 4 * fq;
#pragma unroll
                for (int bj = 0; bj < 2; ++bj)
#pragma unroll
                    for (int n = 0; n < 2; ++n) { const f32x4 v = acc[ai][bj][m][n]; u32x2 w; w.x = pk2(v[0], v[1]); w.y = pk2(v[2], v[3]); *(u32x2*)(rowp + bj * HALF + n * 16) = w; } } EPI_ROWS_END
    }
};
}

namespace fg {
constexpr int TM = 256, TN = 256, BK = 32, STG = 49152, NSTG = 3, MAXU = 6;
struct Tables { const LAS int* cnt; const LAS int* preU; const LAS int* ptab; const LAS int* utab; const LAS float* ctab; unsigned* flags; int stride, c0; };
__device__ __forceinline__ bool decode(const Tables& tb, int i, int& e, int& rt, int& ct) {
    if (i >= MAXU || tb.c0 < 0) return false;
    const int L = i * tb.stride + tb.c0; if (L >= tb.preU[32]) return false;
    e = 0;
    for (int j = 1; j < 32; ++j) e = (tb.preU[j] <= L) ? j : e;
    const int nrt = (tb.cnt[e] + 255) >> 8, r = L - tb.preU[e]; ct = r / nrt; rt = r - ct * nrt; return true;
}
template <int MODE, int DRY = 0>
__device__ __forceinline__ void fgemm_phase(const int tid, LAS unsigned char* lds, const Tables& tb, const char* Abase, const float* W1l, const float* W3l, bf16* Out, const int ub, const int ue) {
    constexpr int K = MODE == 0 ? 2048 : 512, NT = K / BK, LDN = MODE == 0 ? 512 : 2048;
    constexpr unsigned RBYTES = MODE == 0 ? 4096u : 1024u;
    const int wid = __builtin_amdgcn_readfirstlane(tid >> 6), lane = tid & 63, wr = wid >> 2, wc = wid & 3, fr = lane & 15, fq = lane >> 4;
    const unsigned ldsw = (unsigned)wid * 1024u;
    const int bc0 = 4 * lane, bc1 = (4 * lane) ^ 16;
    const int aoff = wr * 8192 + ((fr * 64 + fq * 16) ^ (((fr >> 3) & 1) << 5));
    const int bfo = 16384 + ((8 * fq) * 256 + ((wc * 64 + 2 * fr) ^ ((fq & 1) << 4))) * 4;
    const int nunits = ue;
    if (ue <= ub) return;
    const int total = (ue - ub) * NT;
    f32x4 acc[8][4];
#pragma unroll
    for (int m = 0; m < 8; ++m)
#pragma unroll
        for (int n = 0; n < 4; ++n) acc[m][n] = (f32x4){0.f, 0.f, 0.f, 0.f};
    int su = ub, skt = 0, ns = 0, sb3 = 0; unsigned s_aro[2]; const float* s_b0; const float* s_b1;
#define FG_BSRC(bc_, e_, ct_) (MODE == 0 ? ((((bc_) >> 5) & 1) ? W3l : W1l) + (size_t)(e_) * 2048 * 512 + (size_t)wid * 512 + (ct_) * 128 + 32 * ((bc_) >> 6) + ((bc_) & 31) \
                                         : W1l + (size_t)(e_) * 512 * 2048 + (size_t)wid * 2048 + (ct_) * 256 + (bc_))
#define FG_LOAD_UNIT(u_) do { const int e_ = tb.utab[3 * (u_)], ct_ = tb.utab[3 * (u_) + 2]; \
        if (MODE == 1 && tb.flags) {     \
            unsigned* fl_ = tb.flags + (e_ * 32 + tb.utab[3 * (u_) + 1]) * 16; unsigned sp_ = 0; \
            while (__hip_atomic_load(fl_, __ATOMIC_RELAXED, __HIP_MEMORY_SCOPE_AGENT) < 4u) { __builtin_amdgcn_s_sleep(4); if (++sp_ > (1u << 22)) break; } \
            __builtin_amdgcn_fence(__ATOMIC_ACQUIRE, "agent"); } \
        _Pragma("unroll") for (int i_ = 0; i_ < 2; ++i_) { const int b_ = i_ * 8192 + tid * 16, st_ = b_ >> 10, sb_ = b_ & 1023, swz_ = sb_ ^ (((sb_ >> 9) & 1) << 5); \
            const int p_ = tb.ptab[(u_) * 256 + st_ * 16 + swz_ / 64]; \
            s_aro[i_] = (p_ < 0 ? 0u : (MODE == 0 ? ((unsigned)p_ & 8191u) : (unsigned)p_) * RBYTES) + (unsigned)(swz_ % 64); } \
        s_b0 = FG_BSRC(bc0, e_, ct_); s_b1 = FG_BSRC(bc1, e_, ct_); } while (0)
#define FG_STAGE() do { LAS unsigned char* st_ = lds + sb3 * STG; \
        _Pragma("unroll") for (int i_ = 0; i_ < 2; ++i_) \
            __builtin_amdgcn_global_load_lds((const unsigned*)(Abase + (s_aro[i_] + (unsigned)skt * 64u)), (LAS unsigned*)(st_ + ldsw + i_ * 8192), 16, 0, 0); \
        _Pragma("unroll") for (int r_ = 0; r_ < 4; ++r_) __builtin_amdgcn_global_load_lds((const unsigned*)(((r_ & 1) ? s_b1 : s_b0) + (size_t)(skt * 32 + r_ * 8) * LDN), (LAS unsigned*)(st_ + 16384 + r_ * 8192 + ldsw), 16, 0, 0); \
        ++ns; sb3 = (sb3 == NSTG - 1) ? 0 : sb3 + 1; if (++skt == NT) { skt = 0; ++su; if (su < nunits) FG_LOAD_UNIT(su); } } while (0)
    FG_LOAD_UNIT(ub);
    FG_STAGE(); if (ns < total) FG_STAGE();
    int s = 0, cb3 = 0;
    for (int u = ub; u < nunits; ++u) {
#pragma unroll 1
        for (int kt = 0; kt < NT; ++kt, ++s) {
            if (ns - 1 - s >= 1) asm volatile("s_waitcnt vmcnt(6)" ::: "memory"); else asm volatile("s_waitcnt vmcnt(0)" ::: "memory");
            __builtin_amdgcn_s_barrier(); asm volatile("" ::: "memory");
            const LAS unsigned char* st = lds + cb3 * STG; cb3 = (cb3 == NSTG - 1) ? 0 : cb3 + 1;
            if (DRY == 2) { if (ns < total) FG_STAGE(); continue; }
            bf16x8 Af[8], Bf[4];
            f32x2 vb[2][8];
#pragma unroll
            for (int p2 = 0; p2 < 2; ++p2) { const LAS float* bp = (const LAS float*)(st + bfo) + p2 * 32;
#pragma unroll
                for (int j = 0; j < 8; ++j) vb[p2][j] = *(const LAS f32x2*)(bp + j * 256); }
#pragma unroll
            for (int m = 0; m < 8; ++m) Af[m] = *(const LAS bf16x8*)(st + aoff + m * 1024);
            if (ns < total) FG_STAGE();
#pragma unroll
            for (int p2 = 0; p2 < 2; ++p2) { const f32x2* v = vb[p2];
                u32x4 w0, w1; w0.x = pk2(v[0].x, v[1].x); w0.y = pk2(v[2].x, v[3].x); w0.z = pk2(v[4].x, v[5].x); w0.w = pk2(v[6].x, v[7].x);
                w1.x = pk2(v[0].y, v[1].y); w1.y = pk2(v[2].y, v[3].y); w1.z = pk2(v[4].y, v[5].y); w1.w = pk2(v[6].y, v[7].y);
                Bf[2 * p2] = __builtin_bit_cast(bf16x8, w0); Bf[2 * p2 + 1] = __builtin_bit_cast(bf16x8, w1); }
            if (DRY == 1) {
#pragma unroll
                for (int m = 0; m < 8; ++m) asm volatile("" :: "v"(Af[m]));
#pragma unroll
                for (int n = 0; n < 4; ++n) asm volatile("" :: "v"(Bf[n]));
                continue; }
            __builtin_amdgcn_s_setprio(1);
#pragma unroll
            for (int m = 0; m < 8; ++m)
#pragma unroll
                for (int n = 0; n < 4; ++n) acc[m][n] = __builtin_amdgcn_mfma_f32_16x16x32_bf16(Bf[n], Af[m], acc[m][n], 0, 0, 0);
            __builtin_amdgcn_s_setprio(0);
        }
        if (DRY == 0) {
            const int ct = tb.utab[3 * u + 2];
#pragma unroll
            for (int m = 0; m < 8; ++m) { const int ri = u * 256 + wr * 128 + m * 16 + fr; const int pair = tb.ptab[ri];
                if (pair >= 0) {
                    if (MODE == 0) { const float cb = tb.ctab[ri]; bf16* rowp = Out + (size_t)pair * 512 + ct * 128 + wc * 32 + 8 * fq;
                        const f32x4 g0 = acc[m][0], g1 = acc[m][1], u0 = acc[m][2], u1 = acc[m][3]; u32x4 w;
                        w.x = pk2(siluf_(g0[0]) * u0[0] * cb, siluf_(g1[0]) * u1[0] * cb); w.y = pk2(siluf_(g0[1]) * u0[1] * cb, siluf_(g1[1]) * u1[1] * cb);
                        w.z = pk2(siluf_(g0[2]) * u0[2] * cb, siluf_(g1[2]) * u1[2] * cb); w.w = pk2(siluf_(g0[3]) * u0[3] * cb, siluf_(g1[3]) * u1[3] * cb);
                        st16_wt(rowp, w); }
                    else { bf16* rowp = Out + (size_t)pair * D + ct * 256 + wc * 64 + 8 * fq;
#pragma unroll
                        for (int p2 = 0; p2 < 2; ++p2) { const f32x4 a = acc[m][2 * p2], b = acc[m][2 * p2 + 1]; u32x4 w;
                            w.x = pk2(a[0], b[0]); w.y = pk2(a[1], b[1]); w.z = pk2(a[2], b[2]); w.w = pk2(a[3], b[3]); st16_wt(rowp + 32 * p2, w); } } } }
#pragma unroll
            for (int m = 0; m < 8; ++m)
#pragma unroll
                for (int n = 0; n < 4; ++n) acc[m][n] = (f32x4){0.f, 0.f, 0.f, 0.f};
        }
    }
    asm volatile("s_waitcnt vmcnt(0)" ::: "memory");
    __syncthreads();
#undef FG_LOAD_UNIT
#undef FG_STAGE
#undef FG_BSRC
}
}

__device__ __forceinline__ void tr_item(const float* W, int ld, int K, int N, int col0, bf16* WT, int mode, int row_off, int item, int lane, const float* gk = nullptr) {
    const int nblk = N / 64, kb = item / nblk, nb = item - kb * nblk, k0 = 32 * kb, n0 = 64 * nb;
    const int kg = lane >> 4, c4 = lane & 15;
    const float* src = W + (size_t)(k0 + 8 * kg) * ld + col0 + n0 + 4 * c4;
    f32x4 v[8];
#pragma unroll
    for (int q = 0; q < 8; ++q) v[q] = *(const f32x4*)(src + (size_t)q * ld);
    if (gk) {
#pragma unroll
        for (int q = 0; q < 8; ++q) v[q] = v[q] * gk[k0 + 8 * kg + q]; }
#pragma unroll
    for (int i = 0; i < 4; ++i) { const int n = n0 + 4 * c4 + i; const int row = mode ? (32 * (n >> 4) + (n & 15) + row_off) : (n + row_off);
        u32x4 o; o.x = pk2(v[0][i], v[1][i]); o.y = pk2(v[2][i], v[3][i]); o.z = pk2(v[4][i], v[5][i]); o.w = pk2(v[6][i], v[7][i]);
        *(u32x4*)(WT + (size_t)row * K + k0 + 8 * kg) = o; }
}
__device__ __forceinline__ void wcomb_item(const float* win, const float* wg, bf16* WT, int item, int lane, const float* gk) {
    const int jb = item & 7, kb = item >> 3, j = jb * 64 + lane, k0 = kb * 8;
    float g[16];
#pragma unroll
    for (int r = 0; r < 16; ++r) g[r] = wg[r * 512 + j];
    float o[8];
#pragma unroll
    for (int q = 0; q < 8; ++q) { const float* wr_ = win + (size_t)(k0 + q) * EV_IN + 5120; float s = 0.f;
#pragma unroll
        for (int r = 0; r < 16; ++r) s += wr_[r] * g[r];
        o[q] = s * gk[k0 + q]; }
    u32x4 w; w.x = pk2(o[0], o[1]); w.y = pk2(o[2], o[3]); w.z = pk2(o[4], o[5]); w.w = pk2(o[6], o[7]);
    *(u32x4*)(WT + (size_t)(5120 + j) * D + k0) = w;
}
template <bool SRC_BF16, bool ADDY, bool WRITE_RES, int OUT>
__device__ __forceinline__ void norm_row(const void* src, const bf16* y0, const bf16* y1, bf16* res, const float* g, bf16* xn, float* of32, float* rs_out, int lane) {
    f32x4 v[8]; float ss = 0.f;
#pragma unroll
    for (int j = 0; j < 8; ++j) { const int col = 4 * lane + 256 * j;
        if (SRC_BF16) v[j] = up4(*(const u32x2*)((const bf16*)src + col)); else v[j] = *(const f32x4*)((const float*)src + col);
        if (ADDY) v[j] = v[j] + up4(*(const u32x2*)(y0 + col)) + up4(*(const u32x2*)(y1 + col));
        if (WRITE_RES) { const u32x2 w = dn4(v[j]); *(u32x2*)(res + col) = w; v[j] = up4(w); }
        ss += (v[j][0] * v[j][0] + v[j][1] * v[j][1]) + (v[j][2] * v[j][2] + v[j][3] * v[j][3]); }
    const float rs = rsqrtf(wave_sum(ss) * (1.0f / D) + EPS);
    if (rs_out && lane == 0) *rs_out = rs;
    if (OUT != 0) {
#pragma unroll
        for (int j = 0; j < 8; ++j) { const int col = 4 * lane + 256 * j; const f32x4 gv = *(const f32x4*)(g + col); const f32x4 o = v[j] * rs * gv;
            if (OUT == 1) *(u32x2*)(xn + col) = dn4(o); else *(f32x4*)(of32 + col) = o; } }
}

__device__ __forceinline__ void p0_prologue(Frame& F, KArgs& A) {
    const int gw = F.vcu * NWAVES + F.wave, NGW = F.G * NWAVES, lane = F.lane;
    unsigned char* ws = F.ws;
    constexpr int I_WIN = (D / 32) * (5120 / 64);
    constexpr int I_WC = (D / 8) * 8;
    constexpr int I_WOUT = (D / 32) * (D / 64);
    constexpr int I_ODW = (D / 32) * (1024 / 64);
    constexpr int I_GLU = (1024 / 32) * (2048 / 64);
    constexpr int I_PLEG = I_WOUT;
    constexpr int I_PLEP = (256 / 32) * (D / 64);
    constexpr int I_W1 = (D / 32) * (512 / 64);
    constexpr int I_W2 = (512 / 32) * (D / 64);
    constexpr int N_DENSE = 2 * (I_WIN + I_WC + I_WOUT + I_ODW + 2 * I_GLU) + 4 * (I_PLEG + I_PLEP);
    for (int it = gw; it < N_DENSE; it += NGW) {
        int r = it;
        if (r < 2 * I_WIN) { const int e = r / I_WIN; tr_item(A.in[6] + (size_t)e * D * EV_IN, EV_IN, D, 5120, 0, (bf16*)(ws + WS_WIN + e * SZ_WIN), 0, 0, r % I_WIN, lane, A.in[2] + (size_t)(2 * e) * D); continue; } r -= 2 * I_WIN;
        if (r < 2 * I_WC) { const int e = r / I_WC; wcomb_item(A.in[6] + (size_t)e * D * EV_IN, A.in[14] + (size_t)e * 16 * 512, (bf16*)(ws + WS_WIN + e * SZ_WIN), r % I_WC, lane, A.in[2] + (size_t)(2 * e) * D); continue; } r -= 2 * I_WC;
        if (r < 2 * I_WOUT) { const int e = r / I_WOUT; tr_item(A.in[17] + (size_t)e * D * D, D, D, D, 0, (bf16*)(ws + WS_WOUT + e * SZ_DD), 0, 0, r % I_WOUT, lane); continue; } r -= 2 * I_WOUT;
        if (r < 2 * I_ODW) { const int o = r / I_ODW; tr_item(A.in[18] + (size_t)o * D * 1024, 1024, D, 1024, 0, (bf16*)(ws + WS_ODWIN + o * SZ_ODWIN), 0, 0, r % I_ODW, lane, A.in[2] + (size_t)(2 * o + 1) * D); continue; } r -= 2 * I_ODW;
        if (r < 4 * I_GLU) { const int o = r / (2 * I_GLU), hf = (r / I_GLU) & 1; tr_item(A.in[27] + (size_t)o * 1024 * 4096, 4096, 1024, 2048, hf * 2048, (bf16*)(ws + WS_WGLU + o * SZ_WGLU), 1, hf * 16, r % I_GLU, lane); continue; } r -= 4 * I_GLU;
        if (r < 4 * I_PLEG) { const int l = r / I_PLEG; tr_item(A.in[35] + (size_t)l * D * D, D, D, D, 0, (bf16*)(ws + WS_PLEG + l * SZ_DD), 0, 0, r % I_PLEG, lane, A.in[4] + (size_t)l * D); continue; } r -= 4 * I_PLEG;
        { const int l = r / I_PLEP; tr_item(A.in[37] + (size_t)l * 256 * D, D, 256, D, 0, (bf16*)(ws + WS_PLEP + l * SZ_PLEP), 0, 0, r % I_PLEP, lane); }
    }
    for (int i = gw * 64 + lane; i < 4 * 16 * 4 * 48 * 40; i += NGW * 64) {
        const int k = i % 40, o = (i / 40) % 48, q = (i / (40 * 48)) & 3, t = (i / (40 * 48 * 4)) & 15, l = i / (40 * 48 * 64);
        unsigned hb = 0u, lb = 0u;
        if (o < 36 && k < 32) { const int kk = 512 * q + 32 * t + k;
            const float wv = o < 4 ? A.in[28][((size_t)l * D + kk) * 4 + o] : A.in[30][((size_t)l * D + kk) * 32 + (o - 4)];
            const float wf = wv * A.in[3][(size_t)l * D + kk]; hb = f2bf(wf); lb = f2bf(wf - bf2f(hb)); }
        bf16* img = (bf16*)(ws + WS_RTW) + (size_t)(l * 16 + t) * RTW_IMG + (q * 48 + o) * 40 + k;
        img[0] = (bf16)hb; img[4 * 48 * 40] = (bf16)lb;
    }
    { const float* p = A.in[1]; bf16* pb = (bf16*)(ws + WS_PB); const size_t n8 = (size_t)4 * T * 256 / 8;
        for (size_t i = (size_t)gw * 64 + lane; i < n8; i += (size_t)NGW * 64) { const f32x4 a = *(const f32x4*)(p + i * 8), b = *(const f32x4*)(p + i * 8 + 4);
            u32x4 w; w.x = pk2(a[0], a[1]); w.y = pk2(a[2], a[3]); w.z = pk2(b[0], b[1]); w.w = pk2(b[2], b[3]); *(u32x4*)(pb + i * 8) = w; } }
    for (int m = gw; m < T; m += NGW)
        norm_row<false, false, true, 0>(A.in[0] + (size_t)m * D, nullptr, nullptr, (bf16*)(ws + WS_XRES) + (size_t)m * D, nullptr, nullptr, nullptr, (float*)(ws + WS_RS) + m, lane);
}

__device__ __forceinline__ void lru_unit(Frame& F, KArgs& A, int e, int unit) {
    const int tid = F.tid, lane = F.lane, w = F.wave, b = unit >> 6, h = (unit >> 2) & 15, jq = unit & 3, n16 = lane & 15, kq = lane >> 4;
    LAS bf16* ZT = (LAS bf16*)F.lds;
    LAS bf16* XCB = ZT + 259 * 72;
    LAS float* aa = (LAS float*)(XCB + 256 * 72);
    LAS float* uu = aa + 4096;
    LAS bf16* GT = (LAS bf16*)(uu + 4096);
    LAS bf16* YT = GT + 4096;
    LAS float* sA = (LAS float*)(YT + 4096);
    LAS float* sH = sA + 512;
    LAS float* cin = sH + 512;
    LAS float* carry = cin + 512;
    LAS float* cw = carry + 16;
    const bf16* z = (const bf16*)(F.ws + WS_Z);
    bf16* ycat = (bf16*)(F.ws + WS_YCAT);
    float cwr[5][8];
    { const int c8 = tid & 7;
#pragma unroll
        for (int k = 0; k < 4; ++k) { const float* src = A.in[7] + ((size_t)e * 4 + k) * 1024 + h * 64 + c8 * 8; const f32x4 a = *(const f32x4*)src, b4 = *(const f32x4*)(src + 4);
            cwr[k][0] = a[0]; cwr[k][1] = a[1]; cwr[k][2] = a[2]; cwr[k][3] = a[3]; cwr[k][4] = b4[0]; cwr[k][5] = b4[1]; cwr[k][6] = b4[2]; cwr[k][7] = b4[3]; }
        const float* sb = A.in[8] + (size_t)e * 1024 + h * 64 + c8 * 8; const f32x4 a = *(const f32x4*)sb, b4 = *(const f32x4*)(sb + 4);
        cwr[4][0] = a[0]; cwr[4][1] = a[1]; cwr[4][2] = a[2]; cwr[4][3] = a[3]; cwr[4][4] = b4[0]; cwr[4][5] = b4[1]; cwr[4][6] = b4[2]; cwr[4][7] = b4[3]; }
    bf16x8 WAf[2], WXf[2];
    { const float* w_a = A.in[9] + ((size_t)(e * 16 + h) * 64) * 64 + jq * 16 + n16; const float* w_x = A.in[11] + ((size_t)(e * 16 + h) * 64) * 64 + jq * 16 + n16;
#pragma unroll
        for (int ks = 0; ks < 2; ++ks) { float va[8], vx[8];
#pragma unroll
            for (int j = 0; j < 8; ++j) { va[j] = w_a[(size_t)(32 * ks + 8 * kq + j) * 64]; vx[j] = w_x[(size_t)(32 * ks + 8 * kq + j) * 64]; }
            WAf[ks] = __builtin_bit_cast(bf16x8, (u32x4){pk2(va[0], va[1]), pk2(va[2], va[3]), pk2(va[4], va[5]), pk2(va[6], va[7])});
            WXf[ks] = __builtin_bit_cast(bf16x8, (u32x4){pk2(vx[0], vx[1]), pk2(vx[2], vx[3]), pk2(vx[4], vx[5]), pk2(vx[6], vx[7])}); } }
    float ba[4], bx[4], sp[4];
#pragma unroll
    for (int r = 0; r < 4; ++r) { const int ch = h * 64 + jq * 16 + 4 * kq + r; ba[r] = A.in[10][e * 1024 + ch]; bx[r] = A.in[12][e * 1024 + ch]; sp[r] = -8.0f * softplusf_(-A.in[13][e * 1024 + ch]); }
    u32x4 pz[4], pg;
#define LRU_PREFETCH(s0_) do { _Pragma("unroll") for (int r_ = 0; r_ < 4; ++r_) { const int piece = r_ * 512 + tid; pz[r_] = *(const u32x4*)(z + (size_t)(b * SEQ + (s0_) + (piece >> 3)) * ZW + h * 64 + (piece & 7) * 8); } \
        pg = *(const u32x4*)(z + (size_t)(b * SEQ + (s0_) + (tid >> 1)) * ZW + 1024 + h * 64 + jq * 16 + (tid & 1) * 8); } while (0)
    LRU_PREFETCH(0);
    const int tl = tid >> 1, half = tid & 1;
#pragma unroll 1
    for (int tb = 0; tb < 8; ++tb) {
        const int s0 = tb * 256;
        u32x4 halo = (u32x4){0u, 0u, 0u, 0u};
        if (tb > 0 && tid < 24) halo = *(const LAS u32x4*)(ZT + (256 + (tid >> 3)) * 72 + (tid & 7) * 8);
        LDS_BARRIER();
        if (tid < 24) *(LAS u32x4*)(ZT + (tid >> 3) * 72 + (tid & 7) * 8) = halo;
#pragma unroll
        for (int r = 0; r < 4; ++r) { const int piece = r * 512 + tid; *(LAS u32x4*)(ZT + (3 + (piece >> 3)) * 72 + (piece & 7) * 8) = pz[r]; }
        *(LAS u32x4*)(GT + (tid >> 1) * 16 + (tid & 1) * 8) = pg;
        if (tb < 7) LRU_PREFETCH(s0 + 256);
        LDS_BARRIER();
        { const int tg4 = tid >> 3, c8 = tid & 7; float xr[7][8];
#pragma unroll
            for (int r = 0; r < 7; ++r) { const u32x4 wv = *(const LAS u32x4*)(ZT + (4 * tg4 + r) * 72 + c8 * 8);
                xr[r][0] = lo16(wv.x); xr[r][1] = hi16(wv.x); xr[r][2] = lo16(wv.y); xr[r][3] = hi16(wv.y); xr[r][4] = lo16(wv.z); xr[r][5] = hi16(wv.z); xr[r][6] = lo16(wv.w); xr[r][7] = hi16(wv.w); }
#pragma unroll
            for (int i = 0; i < 4; ++i) { float accv[8];
#pragma unroll
                for (int q = 0; q < 8; ++q) { accv[q] = cwr[4][q];
#pragma unroll
                    for (int k = 0; k < 4; ++k) accv[q] += cwr[k][q] * xr[i + k][q]; }
                *(LAS u32x4*)(XCB + (4 * tg4 + i) * 72 + c8 * 8) = (u32x4){pk2(accv[0], accv[1]), pk2(accv[2], accv[3]), pk2(accv[4], accv[5]), pk2(accv[6], accv[7])}; } }
        LDS_BARRIER();
#pragma unroll
        for (int tt2 = 0; tt2 < 2; ++tt2) { const int tok = (2 * w + tt2) * 16 + n16; f32x4 da = (f32x4){0.f, 0.f, 0.f, 0.f}, dx = da;
#pragma unroll
            for (int ks = 0; ks < 2; ++ks) { const bf16x8 xf = *(const LAS bf16x8*)(XCB + tok * 72 + 32 * ks + 8 * kq);
                da = __builtin_amdgcn_mfma_f32_16x16x32_bf16(WAf[ks], xf, da, 0, 0, 0); dx = __builtin_amdgcn_mfma_f32_16x16x32_bf16(WXf[ks], xf, dx, 0, 0, 0); }
            const u32x2 xw = *(const LAS u32x2*)(XCB + tok * 72 + jq * 16 + 4 * kq); const float xo[4] = {lo16(xw.x), hi16(xw.x), lo16(xw.y), hi16(xw.y)};
            f32x4 av, uv;
#pragma unroll
            for (int r = 0; r < 4; ++r) { const float rg = sigmoidf_(da[r] + ba[r]), ig = sigmoidf_(dx[r] + bx[r]); const float la = rg * sp[r];
                av[r] = __expf(la); uv[r] = __builtin_amdgcn_sqrtf(fmaxf(one_minus_exp(2.0f * la), 0.f)) * ig * xo[r]; }
            *(LAS f32x4*)(aa + tok * 16 + 4 * kq) = av; *(LAS f32x4*)(uu + tok * 16 + 4 * kq) = uv; }
        LDS_BARRIER();
        const int ch = tid & 15, seg = tid >> 4;
        { float Ac = 1.f, Hh = 0.f;
#pragma unroll
            for (int q = 0; q < 8; ++q) { const float a = aa[(seg * 8 + q) * 16 + ch], u = uu[(seg * 8 + q) * 16 + ch]; Hh = a * Hh + u; Ac *= a; }
            sA[seg * 16 + ch] = Ac; sH[seg * 16 + ch] = Hh; }
        LDS_BARRIER();
        if (tid < 16) { float c = (tb == 0) ? 0.f : carry[tid];
#pragma unroll 4
            for (int sg = 0; sg < 32; ++sg) { cin[sg * 16 + tid] = c; c = sA[sg * 16 + tid] * c + sH[sg * 16 + tid]; }
            carry[tid] = c; }
        LDS_BARRIER();
        { float hh = cin[seg * 16 + ch];
#pragma unroll
            for (int q = 0; q < 8; ++q) { const int tq = seg * 8 + q; hh = aa[tq * 16 + ch] * hh + uu[tq * 16 + ch];
                YT[tq * 16 + ch] = (bf16)f2bf(hh * gelu_tanh(bf2f(GT[tq * 16 + ch]))); } }
        LDS_BARRIER();
        *(u32x4*)(ycat + (size_t)(b * SEQ + s0 + (tid >> 1)) * D + h * 64 + jq * 16 + (tid & 1) * 8) = *(const LAS u32x4*)(YT + (tid >> 1) * 16 + (tid & 1) * 8);
    }
#undef LRU_PREFETCH
    LDS_BARRIER();
}

__device__ __forceinline__ void gla_bcum(Frame& F, KArgs& A, int e, int h, size_t t0, LAS float* buf, int stride, LAS float* bl, LAS float* seg4) {
    const int tid = F.tid; const bf16* z = (const bf16*)(F.ws + WS_Z);
    { const int t = tid >> 3, d0 = (tid & 7) * 16; const bf16* zr = z + (t0 + t) * ZW + 5120 + h * 128 + d0; const float* bg = A.in[15] + e * 512 + h * 128 + d0;
#pragma unroll
        for (int c8 = 0; c8 < 2; ++c8) { const u32x4 w = *(const u32x4*)(zr + c8 * 8); LAS float* o = buf + t * stride + d0 + c8 * 8; const float* bb = bg + c8 * 8;
            o[0] = logsigmoidf_(lo16(w.x) + bb[0]) * 0.0625f; o[1] = logsigmoidf_(hi16(w.x) + bb[1]) * 0.0625f; o[2] = logsigmoidf_(lo16(w.y) + bb[2]) * 0.0625f; o[3] = logsigmoidf_(hi16(w.y) + bb[3]) * 0.0625f;
            o[4] = logsigmoidf_(lo16(w.z) + bb[4]) * 0.0625f; o[5] = logsigmoidf_(hi16(w.z) + bb[5]) * 0.0625f; o[6] = logsigmoidf_(lo16(w.w) + bb[6]) * 0.0625f; o[7] = logsigmoidf_(hi16(w.w) + bb[7]) * 0.0625f; } }
    __syncthreads();
    const int d = tid & 127, sg = tid >> 7; float v[16];
    { float run = 0.f;
#pragma unroll
        for (int j = 0; j < 16; ++j) { run += buf[(sg * 16 + j) * stride + d]; v[j] = run; }
        seg4[sg * 128 + d] = run; }
    __syncthreads();
    { float off = 0.f;
#pragma unroll
        for (int q = 0; q < 3; ++q) off += (q < sg) ? seg4[q * 128 + d] : 0.f;
#pragma unroll
        for (int j = 0; j < 16; ++j) buf[(sg * 16 + j) * stride + d] = v[j] + off;
        if (sg == 3) bl[d] = v[15] + off; }
    __syncthreads();
}
typedef short s16x4 __attribute__((ext_vector_type(4)));
__device__ __forceinline__ bf16x8 tr_frag(const LAS bf16* tile, int rs  , int row0, int col0, int lane) {
    const int g = lane >> 4, q = (lane & 15) >> 2, p = lane & 3;
    const LAS bf16* a0 = tile + (row0 + 8 * g + q) * rs + col0 + 4 * p;
    const s16x4 lo = __builtin_amdgcn_ds_read_tr16_b64_v4i16((LAS s16x4*)a0), hi = __builtin_amdgcn_ds_read_tr16_b64_v4i16((LAS s16x4*)(a0 + 4 * rs));
    return (bf16x8){lo[0], lo[1], lo[2], lo[3], hi[0], hi[1], hi[2], hi[3]};
}
__device__ __forceinline__ void gla_ds_unit(Frame& F, KArgs& A, int e, int unit) {
    const int tid = F.tid, lane = F.lane, w = F.wave, b = unit >> 7, h = (unit >> 5) & 3, c = unit & 31, bh = b * 4 + h; const size_t t0 = (size_t)b * SEQ + c * 64;
    const int n16 = lane & 15, kq = lane >> 4;
    LAS float* BC = (LAS float*)F.lds;
    LAS bf16* KE = (LAS bf16*)(F.lds + 33792);
    LAS bf16* VT = KE + 64 * 136;
    LAS float* BL = (LAS float*)(VT + 64 * 272);
    LAS float* SEG = BL + 128;
    const bf16* z = (const bf16*)(F.ws + WS_Z);
    gla_bcum(F, A, e, h, t0, BC, 132, BL, SEG);
    { const int t = tid >> 3, d0 = (tid & 7) * 16; const bf16* zr = z + (t0 + t) * ZW + 2560 + h * 128 + d0;
#pragma unroll
        for (int c8 = 0; c8 < 2; ++c8) { const u32x4 kw = *(const u32x4*)(zr + c8 * 8); const LAS float* bc = BC + t * 132 + d0 + c8 * 8; const LAS float* bl = BL + d0 + c8 * 8;
            const float kv[8] = {lo16(kw.x), hi16(kw.x), lo16(kw.y), hi16(kw.y), lo16(kw.z), hi16(kw.z), lo16(kw.w), hi16(kw.w)}; float ko[8];
#pragma unroll
            for (int j = 0; j < 8; ++j) ko[j] = kv[j] * __expf(bl[j] - bc[j]);
            *(LAS u32x4*)(KE + t * 136 + d0 + c8 * 8) = (u32x4){pk2(ko[0], ko[1]), pk2(ko[2], ko[3]), pk2(ko[4], ko[5]), pk2(ko[6], ko[7])}; }
        const int v0 = (tid & 7) * 32; const bf16* vr = z + (t0 + t) * ZW + 3072 + h * 256 + v0;
#pragma unroll
        for (int c8 = 0; c8 < 4; ++c8) *(LAS u32x4*)(VT + t * 272 + v0 + c8 * 8) = *(const u32x4*)(vr + c8 * 8); }
    if (tid < 128) ((float*)(F.ws + WS_DECAY))[(size_t)(bh * 32 + c) * 128 + tid] = __expf(BL[tid]);
    __syncthreads();
    f32x4 acc[2][8];
#pragma unroll
    for (int vb = 0; vb < 2; ++vb)
#pragma unroll
        for (int db = 0; db < 8; ++db) acc[vb][db] = (f32x4){0.f, 0.f, 0.f, 0.f};
#pragma unroll
    for (int ks = 0; ks < 2; ++ks) { bf16x8 af[2];
#pragma unroll
        for (int vb = 0; vb < 2; ++vb) af[vb] = tr_frag(VT, 272, 32 * ks, (2 * w + vb) * 16, lane);
#pragma unroll
        for (int db = 0; db < 8; ++db) { const bf16x8 bfr = tr_frag(KE, 136, 32 * ks, db * 16, lane);
#pragma unroll
            for (int vb = 0; vb < 2; ++vb) acc[vb][db] = __builtin_amdgcn_mfma_f32_16x16x32_bf16(af[vb], bfr, acc[vb][db], 0, 0, 0); } }
    bf16* ds = (bf16*)(F.ws + WS_DS) + (size_t)(bh * 32 + c) * 128 * 256;
#pragma unroll
    for (int db = 0; db < 8; ++db)
#pragma unroll
        for (int vb = 0; vb < 2; ++vb) *(u32x2*)(ds + (size_t)(db * 16 + n16) * 256 + (2 * w + vb) * 16 + 4 * kq) = dn4(acc[vb][db]);
    LDS_BARRIER();
}
__device__ __forceinline__ void gla_state_phase(Frame& F) {
    const bf16* ds = (const bf16*)(F.ws + WS_DS); bf16* sp = (bf16*)(F.ws + WS_SPREV); const float* dec = (const float*)(F.ws + WS_DECAY);
    for (int it = F.vcu * NTHR + F.tid; it < 16 * 128 * 64; it += F.G * NTHR) {
        const int bh = it >> 13, d = (it >> 6) & 127, v4 = it & 63; f32x4 st = (f32x4){0.f, 0.f, 0.f, 0.f};
#pragma unroll 1
        for (int c0 = 0; c0 < 32; c0 += 8) { f32x4 dv[8]; float dc[8];
#pragma unroll
            for (int j = 0; j < 8; ++j) { const size_t idx = ((size_t)(bh * 32 + c0 + j) * 128 + d) * 256 + v4 * 4; dv[j] = up4(*(const u32x2*)(ds + idx)); dc[j] = dec[(size_t)(bh * 32 + c0 + j) * 128 + d]; }
#pragma unroll
            for (int j = 0; j < 8; ++j) { const size_t idx = ((size_t)(bh * 32 + c0 + j) * 128 + d) * 256 + v4 * 4; u32x2 w; w.x = pk2(st[0], st[1]); w.y = pk2(st[2], st[3]); *(u32x2*)(sp + idx) = w; st = st * dc[j] + dv[j]; } }
    }
}
__device__ __forceinline__ void gla_out_unit(Frame& F, KArgs& A, int e, int unit) {
    const int tid = F.tid, lane = F.lane, w = F.wave, b = unit >> 7, h = (unit >> 5) & 3, c = unit & 31, bh = b * 4 + h; const size_t t0 = (size_t)b * SEQ + c * 64;
    const int n16 = lane & 15, kq = lane >> 4;
    LAS float* BC = (LAS float*)F.lds;
    LAS bf16* ATT = (LAS bf16*)F.lds;
    LAS bf16* QS = (LAS bf16*)(F.lds + 33792);
    LAS bf16* KS = QS + 64 * 136;
    LAS bf16* VT = KS + 64 * 136;
    LAS bf16* SB = VT + 64 * 272;
    LAS float* RSS = (LAS float*)(SB + 64 * 272);
    LAS float* BL = RSS + 512;
    LAS float* SEG = BL + 128;
    const bf16* z = (const bf16*)(F.ws + WS_Z);
    const bf16* spg = (const bf16*)(F.ws + WS_SPREV) + (size_t)(bh * 32 + c) * 128 * 256;
    gla_bcum(F, A, e, h, t0, BC, 132, BL, SEG);
    u32x4 sb2[4];
    { const int t = tid >> 3, d0 = (tid & 7) * 16; const bf16* qr = z + (t0 + t) * ZW + 2048 + h * 128 + d0; const bf16* kr = z + (t0 + t) * ZW + 2560 + h * 128 + d0;
#pragma unroll
        for (int c8 = 0; c8 < 2; ++c8) { const u32x4 qw = *(const u32x4*)(qr + c8 * 8), kw = *(const u32x4*)(kr + c8 * 8); const LAS float* bc = BC + t * 132 + d0 + c8 * 8;
            const float qv[8] = {lo16(qw.x), hi16(qw.x), lo16(qw.y), hi16(qw.y), lo16(qw.z), hi16(qw.z), lo16(qw.w), hi16(qw.w)};
            const float kv[8] = {lo16(kw.x), hi16(kw.x), lo16(kw.y), hi16(kw.y), lo16(kw.z), hi16(kw.z), lo16(kw.w), hi16(kw.w)};
            float qo[8], ko[8];
#pragma unroll
            for (int j = 0; j < 8; ++j) { const float bcv = bc[j]; qo[j] = qv[j] * 0.08838834764831845f * __expf(bcv); ko[j] = kv[j] * __expf(-bcv); }
            *(LAS u32x4*)(QS + t * 136 + d0 + c8 * 8) = (u32x4){pk2(qo[0], qo[1]), pk2(qo[2], qo[3]), pk2(qo[4], qo[5]), pk2(qo[6], qo[7])};
            *(LAS u32x4*)(KS + t * 136 + d0 + c8 * 8) = (u32x4){pk2(ko[0], ko[1]), pk2(ko[2], ko[3]), pk2(ko[4], ko[5]), pk2(ko[6], ko[7])}; }
        const int v0 = (tid & 7) * 32; const bf16* vr = z + (t0 + t) * ZW + 3072 + h * 256 + v0; const bf16* sr = spg + (size_t)t * 256 + v0;
#pragma unroll
        for (int c8 = 0; c8 < 4; ++c8) { *(LAS u32x4*)(VT + t * 272 + v0 + c8 * 8) = *(const u32x4*)(vr + c8 * 8); *(LAS u32x4*)(SB + t * 272 + v0 + c8 * 8) = *(const u32x4*)(sr + c8 * 8); }
#pragma unroll
        for (int c8 = 0; c8 < 4; ++c8) sb2[c8] = *(const u32x4*)(sr + (size_t)64 * 256 + c8 * 8); }
    LDS_BARRIER();
    { const int ib = w >> 1;
#pragma unroll
        for (int jj = 0; jj < 2; ++jj) { const int jb = (w & 1) * 2 + jj; f32x4 d = (f32x4){0.f, 0.f, 0.f, 0.f};
            if (jb <= ib) {
#pragma unroll
                for (int ks = 0; ks < 4; ++ks) { const bf16x8 kf = *(const LAS bf16x8*)(KS + (16 * jb + n16) * 136 + 32 * ks + 8 * kq), qf = *(const LAS bf16x8*)(QS + (16 * ib + n16) * 136 + 32 * ks + 8 * kq);
                    d = __builtin_amdgcn_mfma_f32_16x16x32_bf16(kf, qf, d, 0, 0, 0); }
#pragma unroll
                for (int r = 0; r < 4; ++r) if (16 * jb + 4 * kq + r > 16 * ib + n16) d[r] = 0.f; }
            *(LAS u32x2*)(ATT + (16 * ib + n16) * 72 + 16 * jb + 4 * kq) = (u32x2){pk2(d[0], d[1]), pk2(d[2], d[3])}; } }
    __syncthreads();
    f32x4 acc[2][4];
#pragma unroll
    for (int vb = 0; vb < 2; ++vb)
#pragma unroll
        for (int ib = 0; ib < 4; ++ib) acc[vb][ib] = (f32x4){0.f, 0.f, 0.f, 0.f};
#pragma unroll
    for (int ks = 0; ks < 2; ++ks) { bf16x8 af[2];
#pragma unroll
        for (int vb = 0; vb < 2; ++vb) af[vb] = tr_frag(VT, 272, 32 * ks, (2 * w + vb) * 16, lane);
#pragma unroll
        for (int ib = 0; ib < 4; ++ib) if (32 * ks <= 16 * ib + 15) { const bf16x8 bfr = *(const LAS bf16x8*)(ATT + (16 * ib + n16) * 72 + 32 * ks + 8 * kq);
#pragma unroll
            for (int vb = 0; vb < 2; ++vb) acc[vb][ib] = __builtin_amdgcn_mfma_f32_16x16x32_bf16(af[vb], bfr, acc[vb][ib], 0, 0, 0); } }
#pragma unroll
    for (int half = 0; half < 2; ++half) {
        if (half == 1) { LDS_BARRIER();
            const int t = tid >> 3, v0 = (tid & 7) * 32;
#pragma unroll
            for (int c8 = 0; c8 < 4; ++c8) *(LAS u32x4*)(SB + t * 272 + v0 + c8 * 8) = sb2[c8];
            LDS_BARRIER(); }
#pragma unroll
        for (int ks = 0; ks < 2; ++ks) { bf16x8 af[2];
#pragma unroll
            for (int vb = 0; vb < 2; ++vb) af[vb] = tr_frag(SB, 272, 32 * ks, (2 * w + vb) * 16, lane);
#pragma unroll
            for (int ib = 0; ib < 4; ++ib) { const bf16x8 bfr = *(const LAS bf16x8*)(QS + (16 * ib + n16) * 136 + 64 * half + 32 * ks + 8 * kq);
#pragma unroll
                for (int vb = 0; vb < 2; ++vb) acc[vb][ib] = __builtin_amdgcn_mfma_f32_16x16x32_bf16(af[vb], bfr, acc[vb][ib], 0, 0, 0); } } }
#pragma unroll
    for (int ib = 0; ib < 4; ++ib) { float ss = 0.f;
#pragma unroll
        for (int vb = 0; vb < 2; ++vb)
#pragma unroll
            for (int r = 0; r < 4; ++r) ss += acc[vb][ib][r] * acc[vb][ib][r];
        ss += shx(ss, 16, lane); ss += shx(ss, 32, lane);
        if (kq == 0) RSS[w * 64 + 16 * ib + n16] = ss; }
    u32x2 gwv[4][2]; f32x4 hnv[2];
#pragma unroll
    for (int vb = 0; vb < 2; ++vb) { const int v = (2 * w + vb) * 16 + 4 * kq; hnv[vb] = *(const f32x4*)(A.in[16] + e * 1024 + h * 256 + v);
#pragma unroll
        for (int ib = 0; ib < 4; ++ib) gwv[ib][vb] = *(const u32x2*)(z + (t0 + 16 * ib + n16) * ZW + 4096 + h * 256 + v); }
    LDS_BARRIER();
#pragma unroll
    for (int ib = 0; ib < 4; ++ib) { float tot = 0.f;
#pragma unroll
        for (int ww = 0; ww < 8; ++ww) tot += RSS[ww * 64 + 16 * ib + n16];
        const float rs = rsqrtf(tot * (1.0f / 256.0f) + EPS); const size_t t = t0 + 16 * ib + n16;
#pragma unroll
        for (int vb = 0; vb < 2; ++vb) { const int v = (2 * w + vb) * 16 + 4 * kq; const f32x4 hn = hnv[vb]; const u32x2 gw = gwv[ib][vb];
            const f32x4 o = acc[vb][ib];
            const float y0 = o[0] * rs * hn[0] * siluf_(lo16(gw.x)), y1 = o[1] * rs * hn[1] * siluf_(hi16(gw.x)), y2 = o[2] * rs * hn[2] * siluf_(lo16(gw.y)), y3 = o[3] * rs * hn[3] * siluf_(hi16(gw.y));
            *(u32x2*)((bf16*)(F.ws + WS_YCAT) + t * D + 1024 + h * 256 + v) = (u32x2){pk2(y0, y1), pk2(y2, y3)}; } }
    LDS_BARRIER();
}

__device__ __forceinline__ void s5_unit(Frame& F, KArgs& A, int o, int unit) {
    const int tid = F.tid, lane = F.lane, w = F.wave, b = unit >> 6, g = unit & 63;
    LAS unsigned* U = (LAS unsigned*)F.lds;
    LAS float* XBall = (LAS float*)(F.lds + 65536);
    LAS float* EE = XBall + 8 * 2560;
    const bf16* u = (const bf16*)(F.ws + WS_U);
#pragma unroll
    for (int r = 0; r < 8; ++r) { const int piece = r * 512 + tid, tok = piece >> 1, hf = piece & 1; const size_t o_ = (size_t)(b * SEQ + tok) * 1024 + g * 16 + hf * 8;
        const u32x4 p0 = *(const u32x4*)(u + o_), p1 = *(const u32x4*)(u + (size_t)T * 1024 + o_);
        *(LAS u32x4*)(U + tok * 8 + hf * 4) = (u32x4){pk2(lo16(p0.x) + lo16(p1.x), hi16(p0.x) + hi16(p1.x)), pk2(lo16(p0.y) + lo16(p1.y), hi16(p0.y) + hi16(p1.y)),
                                                     pk2(lo16(p0.z) + lo16(p1.z), hi16(p0.z) + hi16(p1.z)), pk2(lo16(p0.w) + lo16(p1.w), hi16(p0.w) + hi16(p1.w))}; }
    const int n16 = lane & 15, kq = lane >> 4;
    const size_t gbase = (size_t)(o * 64 + g) * 64;
    const float dt = expf(A.in[21][o * 64 + g]);
    float ab_re, ab_im;
    { const float lr = fminf(A.in[19][gbase + lane], -1e-4f), li = A.in[20][gbase + lane]; const float mag = expf(lr * dt); ab_re = mag * cosf(li * dt); ab_im = mag * sinf(li * dt); }
    bf16x8 Bb[8];
#pragma unroll
    for (int f = 0; f < 4; ++f) { const int p = 16 * f + n16; const float lr = fminf(A.in[19][gbase + p], -1e-4f), li = A.in[20][gbase + p];
        const float mag = expf(lr * dt), are = mag * cosf(li * dt), aim = mag * sinf(li * dt), den = lr * lr + li * li;
        const float cre = ((are - 1.0f) * lr + aim * li) / den, cim = (aim * lr - (are - 1.0f) * li) / den;
        u32x4 wr_ = (u32x4){0u, 0u, 0u, 0u}, wi_ = (u32x4){0u, 0u, 0u, 0u};
        if (kq < 2) { const float* br = A.in[22] + (gbase + p) * 16 + kq * 8; const float* bi = A.in[23] + (gbase + p) * 16 + kq * 8; float vr[8], vi[8];
#pragma unroll
            for (int j = 0; j < 8; ++j) { vr[j] = cre * br[j] - cim * bi[j]; vi[j] = cre * bi[j] + cim * br[j]; }
            wr_ = (u32x4){pk2(vr[0], vr[1]), pk2(vr[2], vr[3]), pk2(vr[4], vr[5]), pk2(vr[6], vr[7])}; wi_ = (u32x4){pk2(vi[0], vi[1]), pk2(vi[2], vi[3]), pk2(vi[4], vi[5]), pk2(vi[6], vi[7])}; }
        Bb[f] = __builtin_bit_cast(bf16x8, wr_); Bb[4 + f] = __builtin_bit_cast(bf16x8, wi_); }
    bf16x8 Ct[4];
#pragma unroll
    for (int ks = 0; ks < 4; ++ks) { const int k0 = 32 * ks + 8 * kq; const float* src = (k0 < 64 ? A.in[24] : A.in[25]) + (gbase / 64 * 16 + n16) * 64 + (k0 & 63); const float sg = k0 < 64 ? 1.0f : -1.0f;
        const u32x4 wv = (u32x4){pk2(sg * src[0], sg * src[1]), pk2(sg * src[2], sg * src[3]), pk2(sg * src[4], sg * src[5]), pk2(sg * src[6], sg * src[7])}; Ct[ks] = __builtin_bit_cast(bf16x8, wv); }
    const f32x4 dsk = *(const f32x4*)(A.in[26] + o * 1024 + g * 16 + kq * 4);
    __syncthreads();
    LAS float* xb = XBall + w * 2560;
    const f32x4 z4 = (f32x4){0.f, 0.f, 0.f, 0.f};
#define S5_BU(tok0) { bf16x8 Uf = (bf16x8){0, 0, 0, 0, 0, 0, 0, 0}; if (kq < 2) Uf = __builtin_bit_cast(bf16x8, *(const LAS u32x4*)(U + ((tok0) + n16) * 8 + kq * 4)); \
        _Pragma("unroll") for (int f = 0; f < 8; ++f) { const f32x4 d = __builtin_amdgcn_mfma_f32_16x16x32_bf16(Uf, Bb[f], z4, 0, 0, 0); \
            *(LAS f32x4*)(xb + (16 * f + n16) * 20 + 4 * kq) = d; } }
#define S5_READ_BU() f32x4 br4[4], bi4[4]; _Pragma("unroll") for (int j = 0; j < 4; ++j) { br4[j] = *(const LAS f32x4*)(xb + lane * 20 + 4 * j); bi4[j] = *(const LAS f32x4*)(xb + (64 + lane) * 20 + 4 * j); }
    float hr = 0.f, hi = 0.f;
    for (int sub = 0; sub < 16; ++sub) { const int tok0 = w * 256 + sub * 16;
        S5_BU(tok0)
        S5_READ_BU()
#pragma unroll
        for (int t = 0; t < 16; ++t) { const float br = br4[t >> 2][t & 3], bi = bi4[t >> 2][t & 3]; const float nr = ab_re * hr - ab_im * hi + br, ni = ab_re * hi + ab_im * hr + bi; hr = nr; hi = ni; } }
    EE[(w * 64 + lane) * 2] = hr; EE[(w * 64 + lane) * 2 + 1] = hi;
    float pr = ab_re, pi = ab_im;
#pragma unroll
    for (int sq = 0; sq < 8; ++sq) { const float nr = pr * pr - pi * pi, ni = 2.0f * pr * pi; pr = nr; pi = ni; }
    __syncthreads();
    hr = 0.f; hi = 0.f;
    for (int sg = 0; sg < w; ++sg) { const float er = EE[(sg * 64 + lane) * 2], ei = EE[(sg * 64 + lane) * 2 + 1]; const float nr = pr * hr - pi * hi + er, ni = pr * hi + pi * hr + ei; hr = nr; hi = ni; }
    for (int sub = 0; sub < 16; ++sub) { const int tok0 = w * 256 + sub * 16;
        S5_BU(tok0)
        S5_READ_BU()
        asm volatile("s_waitcnt lgkmcnt(0)" ::: "memory");
#pragma unroll
        for (int t = 0; t < 16; ++t) { const float br = br4[t >> 2][t & 3], bi = bi4[t >> 2][t & 3]; const float nr = ab_re * hr - ab_im * hi + br, ni = ab_re * hi + ab_im * hr + bi; hr = nr; hi = ni;
            xb[t * 132 + lane] = hr; xb[t * 132 + 64 + lane] = hi; }
        f32x4 y = z4;
#pragma unroll
        for (int ks = 0; ks < 4; ++ks) { const f32x4 h0 = *(const LAS f32x4*)(xb + n16 * 132 + 32 * ks + 8 * kq), h1 = *(const LAS f32x4*)(xb + n16 * 132 + 32 * ks + 8 * kq + 4);
            const u32x4 hw = (u32x4){pk2(h0[0], h0[1]), pk2(h0[2], h0[3]), pk2(h1[0], h1[1]), pk2(h1[2], h1[3])};
            y = __builtin_amdgcn_mfma_f32_16x16x32_bf16(Ct[ks], __builtin_bit_cast(bf16x8, hw), y, 0, 0, 0); }
        const int tok = tok0 + n16; const u32x2 uw = *(const LAS u32x2*)(U + tok * 8 + kq * 2);
        const float y0 = y[0] + dsk[0] * lo16(uw.x), y1 = y[1] + dsk[1] * hi16(uw.x), y2 = y[2] + dsk[2] * lo16(uw.y), y3 = y[3] + dsk[3] * hi16(uw.y);
        u32x2 ow; ow.x = pk2(gelu_tanh(y0), gelu_tanh(y1)); ow.y = pk2(gelu_tanh(y2), gelu_tanh(y3));
        *(u32x2*)((bf16*)(F.ws + WS_YS5) + (size_t)(b * SEQ + tok) * 1024 + g * 16 + kq * 4) = ow; }
#undef S5_BU
#undef S5_READ_BU
    LDS_BARRIER();
}

__device__ __forceinline__ void router_unit(Frame& F, KArgs& A, int l, int unit, const bool dry, const bf16* xres) {
    const int tid = F.tid, lane = F.lane, w = F.wave, tok0 = unit * 32, tg = w >> 2, kc = w & 3, n16 = lane & 15, kq = lane >> 4;
    LAS float* RED = (LAS float*)F.lds;
    LAS float* SSQ = (LAS float*)(F.lds + 5 * RTW_IMG * 2);
    LAS float* RS = SSQ + 128;
    const float* gn = A.in[3] + (size_t)l * D;
    const char* rimg = (const char*)(F.ws + WS_RTW) + (size_t)l * 16 * RTW_IMG * 2;
    f32x4 acc[3]; float ssq = 0.f;
#pragma unroll
    for (int nf = 0; nf < 3; ++nf) acc[nf] = (f32x4){0.f, 0.f, 0.f, 0.f};
    const bf16* xrow = xres + (size_t)(tok0 + tg * 16 + n16) * D + kc * 512 + 8 * kq;
    u32x4 xv[16];
#pragma unroll
    for (int s16 = 0; s16 < 16; ++s16) xv[s16] = *(const u32x4*)(xrow + 32 * s16);
#define RT_DMA(s_) do { const char* src_ = rimg + (size_t)(s_) * (RTW_IMG * 2) + lane * 16; LAS unsigned char* dst_ = F.lds + ((s_) % 5) * (RTW_IMG * 2); \
        _Pragma("unroll") for (int r_ = 0; r_ < 4; ++r_) { int pc_ = r_ * 8 + w; pc_ = pc_ < 30 ? pc_ : 29; \
            __builtin_amdgcn_global_load_lds((const unsigned*)(src_ + pc_ * 1024), (LAS unsigned*)(dst_ + pc_ * 1024), 16, 0, 0); } } while (0)
#define RT_DMA2(s_, b_) do { const char* src_ = rimg + (size_t)(s_) * (RTW_IMG * 2) + lane * 16; LAS unsigned char* dst_ = F.lds + (b_) * (RTW_IMG * 2); \
        _Pragma("unroll") for (int r_ = 0; r_ < 4; ++r_) { int pc_ = r_ * 8 + w; pc_ = pc_ < 30 ? pc_ : 29; \
            __builtin_amdgcn_global_load_lds((const unsigned*)(src_ + pc_ * 1024), (LAS unsigned*)(dst_ + pc_ * 1024), 16, 0, 0); } } while (0)
    RT_DMA(0); RT_DMA(1); RT_DMA(2); RT_DMA(3);
    int rb = 0;
#pragma unroll 1
    for (int so = 0; so < 4; ++so) {
#pragma unroll
        for (int sj = 0; sj < 4; ++sj) { const int s16 = 4 * so + sj;
            if (so < 3 || sj == 0) asm volatile("s_waitcnt vmcnt(12)" ::: "memory"); else if (sj == 1) asm volatile("s_waitcnt vmcnt(8)" ::: "memory");
            else if (sj == 2) asm volatile("s_waitcnt vmcnt(4)" ::: "memory"); else asm volatile("s_waitcnt vmcnt(0)" ::: "memory");
            __builtin_amdgcn_s_barrier(); asm volatile("" ::: "memory");
            if (so < 3) RT_DMA2(s16 + 4, rb == 0 ? 4 : rb - 1);
            const LAS bf16* WH = (const LAS bf16*)(F.lds + rb * (RTW_IMG * 2)); const LAS bf16* WL = WH + 4 * 48 * 40;
            rb = rb == 4 ? 0 : rb + 1;
            const u32x4 xw = xv[sj];
            { const float x0 = lo16(xw.x), x1 = hi16(xw.x), x2 = lo16(xw.y), x3 = hi16(xw.y), x4 = lo16(xw.z), x5 = hi16(xw.z), x6 = lo16(xw.w), x7 = hi16(xw.w);
              ssq += ((x0 * x0 + x1 * x1) + (x2 * x2 + x3 * x3)) + ((x4 * x4 + x5 * x5) + (x6 * x6 + x7 * x7)); }
            const bf16x8 xf = __builtin_bit_cast(bf16x8, xw);
#pragma unroll
            for (int nf = 0; nf < 3; ++nf) { const bf16x8 wh = *(const LAS bf16x8*)(WH + (kc * 48 + nf * 16 + n16) * 40 + 8 * kq), wl = *(const LAS bf16x8*)(WL + (kc * 48 + nf * 16 + n16) * 40 + 8 * kq);
                acc[nf] = __builtin_amdgcn_mfma_f32_16x16x32_bf16(wh, xf, acc[nf], 0, 0, 0); acc[nf] = __builtin_amdgcn_mfma_f32_16x16x32_bf16(wl, xf, acc[nf], 0, 0, 0); }
            asm volatile("s_waitcnt lgkmcnt(0)" ::: "memory");
        }
#pragma unroll
        for (int i = 0; i < 12; ++i) xv[i] = xv[i + 4];
    }
#undef RT_DMA2
#undef RT_DMA
    __syncthreads();
    ssq += shx(ssq, 16, tid & 63); ssq += shx(ssq, 32, tid & 63);
#pragma unroll
    for (int nf = 0; nf < 3; ++nf)
#pragma unroll
        for (int r = 0; r < 4; ++r) RED[((tg * 4 + kc) * 48 + nf * 16 + 4 * kq + r) * 16 + n16] = acc[nf][r];
    if (kq == 0) SSQ[(tg * 4 + kc) * 16 + n16] = ssq;
    __syncthreads();
    if (tid < 32) {
        const int tg2 = tid >> 4, tk = tid & 15, token = tok0 + tid;
        float lgt[36];
#pragma unroll
        for (int o = 0; o < 36; ++o) lgt[o] = (RED[((tg2 * 4 + 0) * 48 + o) * 16 + tk] + RED[((tg2 * 4 + 1) * 48 + o) * 16 + tk]) + (RED[((tg2 * 4 + 2) * 48 + o) * 16 + tk] + RED[((tg2 * 4 + 3) * 48 + o) * 16 + tk]);
        const float sq = (SSQ[(tg2 * 4 + 0) * 16 + tk] + SSQ[(tg2 * 4 + 1) * 16 + tk]) + (SSQ[(tg2 * 4 + 2) * 16 + tk] + SSQ[(tg2 * 4 + 3) * 16 + tk]);
        const float rs = rsqrtf(sq * (1.0f / D) + EPS); RS[tid] = rs;
        const float* brg = A.in[29] + l * 4; const float* bre = A.in[31] + l * 32;
        float lg[4];
#pragma unroll
        for (int j = 0; j < 4; ++j) lg[j] = lgt[j] * rs + brg[j];
        int gs = 0; float mx = lg[0];
#pragma unroll
        for (int j = 1; j < 4; ++j) if (lg[j] > mx) { mx = lg[j]; gs = j; }
        float sum = 0.f;
#pragma unroll
        for (int j = 0; j < 4; ++j) sum += expf(lg[j] - mx);
        const float gate_g = 1.0f / sum;
        float le[8];
#pragma unroll
        for (int j = 0; j < 8; ++j) { const float a = gs == 0 ? lgt[4 + j] : gs == 1 ? lgt[12 + j] : gs == 2 ? lgt[20 + j] : lgt[28 + j]; le[j] = a * rs + bre[gs * 8 + j]; }
        int i1 = 0; float m1 = le[0];
#pragma unroll
        for (int j = 1; j < 8; ++j) if (le[j] > m1) { m1 = le[j]; i1 = j; }
        int i2 = (i1 == 0) ? 1 : 0; float m2 = le[i2];
#pragma unroll
        for (int j = 0; j < 8; ++j) if (j != i1 && le[j] > m2) { m2 = le[j]; i2 = j; }
        const float e2 = expf(m2 - m1), w1 = 1.0f / (1.0f + e2), w2 = e2 / (1.0f + e2);
        float* comb = (float*)(F.ws + (dry ? WS_DS : WS_COMB)); int* list = (int*)(F.ws + (dry ? WS_DS + 4 * MiB : WS_LIST)); unsigned* cnt = dry ? (unsigned*)(F.ws + WS_DS + 8 * MiB) : (unsigned*)(F.ws + WS_CTL) + CW_CNT + l * 32 * 16;
        const int ea = gs * 8 + i1, eb = gs * 8 + i2;
        comb[token] = gate_g * w1; comb[T + token] = gate_g * w2;
        LAS unsigned* HIST = (LAS unsigned*)(RS + 32); LAS unsigned* BASE = HIST + 32;
        HIST[tid] = 0u; asm volatile("s_waitcnt lgkmcnt(0)" ::: "memory");
        const unsigned ra = atomicAdd((unsigned*)(HIST + ea), 1u), rb = atomicAdd((unsigned*)(HIST + eb), 1u);
        asm volatile("s_waitcnt lgkmcnt(0)" ::: "memory");
        { const unsigned n = HIST[tid]; BASE[tid] = n ? atomicAdd(cnt + tid * 16, n) : 0u; }
        asm volatile("s_waitcnt vmcnt(0) lgkmcnt(0)" ::: "memory");
        unsigned pa = BASE[ea] + ra, pb = BASE[eb] + rb;
        if (dry) { pa &= 8191u; pb &= 8191u; }
        list[ea * 8192 + pa] = token; list[eb * 8192 + pb] = T + token;
    }
    __syncthreads();
#pragma unroll 1
    for (int r2 = 0; r2 < 2; ++r2) { f32x4 v[2][8];
#pragma unroll
        for (int rr = 0; rr < 2; ++rr)
#pragma unroll
            for (int j = 0; j < 8; ++j) v[rr][j] = up4(*(const u32x2*)(xres + (size_t)(tok0 + w * 4 + r2 * 2 + rr) * D + 4 * lane + 256 * j));
#pragma unroll
        for (int rr = 0; rr < 2; ++rr) { const int row = w * 4 + r2 * 2 + rr; const float rs = RS[row]; const size_t t = (size_t)(tok0 + row);
#pragma unroll
            for (int j = 0; j < 8; ++j) { const int col = 4 * lane + 256 * j; const f32x4 o = v[rr][j] * rs * *(const f32x4*)(gn + col);
                u32x2 wv2; wv2.x = pk2(o[0], o[1]); wv2.y = pk2(o[2], o[3]); *(u32x2*)((bf16*)(F.ws + (dry ? WS_DS + 16 * MiB : WS_XN)) + t * D + col) = wv2; } } }
    __syncthreads();
}

__device__ __forceinline__ void moe_prepare(Frame& F, int l, int nct, pg8::MoeOrder& S) {
    LAS int* cntl = (LAS int*)(F.lds + EXTRA_OFF); LAS int* pre = cntl + 64; LAS int* ptab = cntl + 128;
    const unsigned* cnt = (const unsigned*)(F.ws + WS_CTL) + CW_CNT + l * 32 * 16; const int* list = (const int*)(F.ws + WS_LIST);
    if (F.tid < 32) { const unsigned c = __hip_atomic_load(cnt + F.tid * 16, __ATOMIC_RELAXED, __HIP_MEMORY_SCOPE_AGENT); cntl[F.tid] = (int)(c > 8192u ? 8192u : c); }
    __syncthreads();
    if (F.tid == 0) { int s = 0; for (int e = 0; e < 32; ++e) { pre[e] = s; s += (cntl[e] + 255) >> 8; } pre[32] = s; }
    __syncthreads();
    S.pre = pre; S.cnt = cntl; S.ptab = ptab; S.nct = nct; S.G = F.G; S.c = F.vcu;
    for (int ui = 0; ui < pg8::MOE_MAXU; ++ui) { int e, rt, ct;
        if (S.decode(ui, e, rt, ct) && F.tid < 256) { const int pos = rt * 256 + F.tid; ptab[ui * 256 + F.tid] = pos < cntl[e] ? list[e * 8192 + pos] : -1; } }
    __syncthreads();
}

__device__ __forceinline__ void moe_prepare2(Frame& F, int l, int nct, fg::Tables& tb, const bool merged) {
    LAS int* cntl = (LAS int*)(F.lds + EXTRA_OFF); LAS int* pre = cntl + 64; LAS int* utab = cntl + 100; LAS int* ptab = cntl + 128; LAS float* ctab = (LAS float*)(ptab + fg::MAXU * 256);
    const unsigned* cnt = (const unsigned*)(F.ws + WS_CTL) + CW_CNT + l * 32 * 16; const int* list = (const int*)(F.ws + WS_LIST); const float* comb = (const float*)(F.ws + WS_COMB);
    __syncthreads();
    if (F.tid < 32) { const unsigned c = __hip_atomic_load(cnt + F.tid * 16, __ATOMIC_RELAXED, __HIP_MEMORY_SCOPE_AGENT); cntl[F.tid] = (int)(c > 8192u ? 8192u : c); }
    __syncthreads();
    if (F.tid == 0) { int s = 0; for (int e = 0; e < 32; ++e) { pre[e] = s; s += ((cntl[e] + 255) >> 8) * nct; } pre[32] = s; }
    __syncthreads();
    tb.cnt = cntl; tb.preU = pre; tb.ptab = ptab; tb.utab = utab; tb.ctab = ctab;
    tb.flags = merged ? (unsigned*)(F.ws + WS_CTL) + CW_FLAG + l * 32 * 32 * 16 : nullptr;
    const int ucu = (F.G == 256) ? ((F.vcu & 7) * 32 + (F.vcu >> 3)) : F.vcu;
    tb.stride = F.G; tb.c0 = ucu;
    if (merged) { const int n2 = pre[32] >> 1; const int h = n2 > F.G ? (n2 - F.G < F.G / 2 ? n2 - F.G : F.G / 2) : 0; tb.stride = F.G - h; tb.c0 = ucu - h; }
    int nu = 0;
    for (int ui = 0; ui < fg::MAXU; ++ui) { int e, rt, ct;
        if (fg::decode(tb, ui, e, rt, ct)) { ++nu;
            if (F.tid < 256) { const int pos = rt * 256 + F.tid; const int pr = pos < cntl[e] ? list[e * 8192 + pos] : -1; ptab[ui * 256 + F.tid] = pr; ctab[ui * 256 + F.tid] = pr >= 0 ? comb[pr] : 0.f; }
            if (F.tid == 0) { utab[3 * ui] = e; utab[3 * ui + 1] = rt; utab[3 * ui + 2] = ct; } } }
    if (F.tid == 0) utab[3 * fg::MAXU] = nu;
    __syncthreads();
}

constexpr int PH_LAYER0 = 2, PH_PER_LAYER = 12, PH_FINAL = PH_LAYER0 + DEPTH * PH_PER_LAYER, PH_END = PH_FINAL + 1;

__global__ void __launch_bounds__(NTHR, 2) mk_fwd(Args args) {
    extern __shared__ __attribute__((aligned(16))) unsigned char lds_raw[];
    Frame F;
    F.lds = (LAS unsigned char*)lds_raw;
    F.tid = threadIdx.x; F.lane = F.tid & 63; F.wave = __builtin_amdgcn_readfirstlane(F.tid >> 6);
    F.G = gridDim.x; { const int bx = blockIdx.x; F.vcu = (F.G % 8 == 0) ? (bx % 8) * (F.G / 8) + bx / 8 : bx; }
    F.ws = args.ws;
    volatile LAS unsigned* MISC = (volatile LAS unsigned*)(F.lds + MISC_OFF);
    if (F.tid < 64) MISC[F.tid] = 0u;
    __syncthreads();
    const int lo = args.ph_lo, hi = args.ph_hi;
    const bool multi = (hi - lo) > 1;
    XcdBarrier bar; bar.bar = (unsigned*)(args.ws + WS_CTL) + CW_BAR; bar.x = 0; bar.st = MISC + 8;
    if (multi) bar = xcd_barrier_post((unsigned*)(args.ws + WS_CTL) + CW_BAR, MISC + 8);
#ifndef MK_REP_P0
#define MK_REP_P0 1
#endif
#ifndef MK_REP_EV
#define MK_REP_EV 1
#endif
#ifndef MK_REP_S5
#define MK_REP_S5 1
#endif
#ifndef MK_REP_MOE
#define MK_REP_MOE 1
#endif
#ifndef MK_MOE_DRY
#define MK_MOE_DRY 0
#endif
#ifndef MK_REP_RT
#define MK_REP_RT 1
#endif
#ifndef MK_REP_G
#define MK_REP_G 1
#endif
#ifndef MK_MASK
#define MK_MASK 0xffffffffu
#endif
#define ON(b) ((MK_MASK >> (b)) & 1u)
#define IN(k) (lo <= (k) && (k) < hi)
#define SEAM(k) do { if (multi && (k) + 1 < hi) xcd_barrier(bar, F.wave == 0 && lane_now() == 0); } while (0)
    LAS unsigned char* ring = F.lds;
#define PHASE_ENTER KArgs& args = *opaque_k((KArgs*)__builtin_amdgcn_kernarg_segment_ptr()); Frame P = F; P.vcu = opaque_s(F.vcu); P.G = opaque_s(F.G); const int PBX = opaque_s((int)blockIdx.x); (void)PBX; P.tid = opaque_v(F.wave * 64 + lane_now()); P.lane = P.tid & 63; P.wave = __builtin_amdgcn_readfirstlane(P.tid >> 6); P.ws = opaque_p(F.ws); unsigned char* ws = P.ws; (void)ws;

    if (ON(0) && IN(0)) { for (int rep = 0; rep < MK_REP_P0; ++rep) { PHASE_ENTER p0_prologue(P, args); SEAM(0); } }
    if (multi && lo == 0) {
        if (F.tid == 0) { unsigned base = 0; for (unsigned j = 0; j < 16; ++j) { const unsigned cj = xb_ld(&bar.bar[XB_XCNT(j)]); base += (j < bar.x) ? cj : 0u; } MISC[11] = base + MISC[10]; }
        __syncthreads();
        F.vcu = __builtin_amdgcn_readfirstlane((int)MISC[11]);
    }
    if (ON(1) && IN(1)) {
        PHASE_ENTER
        pg8::PPOrder S; S.init(T, D, 256, P.G, PBX, (size_t)T * 256 * 2, SZ_PLEP);
        pg8::EpiStoreBf16Split E{(bf16*)(ws + WS_PP), D, (size_t)T * D, nullptr};
        pg8::gemm_phase<pg8::EpiStoreBf16Split, pg8::PPOrder, false>(P.tid, ring, (const char*)(ws + WS_PB), (const char*)(ws + WS_PLEP), 256, S, E);
        SEAM(1);
    }
    for (int l = 0; l < DEPTH; ++l) {
        const int pb = PH_LAYER0 + l * PH_PER_LAYER, eo = l >> 1;
        const size_t xcur = WS_XRES + (size_t)(l & 1) * T * D * 2, xnxt = WS_XRES + (size_t)((l + 1) & 1) * T * D * 2;
        if (ON(2) && l > 0 && IN(pb + 0)) {
            PHASE_ENTER
            const int gw = P.vcu * NWAVES + P.wave, NGW = P.G * NWAVES;
            for (int m = gw; m < T; m += NGW) norm_row<true, false, false, 0>((const bf16*)(ws + xcur) + (size_t)m * D, nullptr, nullptr, nullptr, nullptr, nullptr, nullptr, (float*)(ws + WS_RS) + m, P.lane);
            SEAM(pb + 0);
        }
        if ((l & 1) == 0) {
            if (ON(3) && IN(pb + 1)) for (int rep = 0; rep < MK_REP_G; ++rep) {
                PHASE_ENTER
                pg8::StaticOrder S; S.init(T, ZW, D, P.G, PBX);
                pg8::EpiStoreBf16 E{(bf16*)(ws + WS_Z), ZW, (const float*)(ws + WS_RS)};
                pg8::gemm_phase<pg8::EpiStoreBf16, pg8::StaticOrder, false>(P.tid, ring, (const char*)(ws + xcur), (const char*)(ws + WS_WIN) + (size_t)eo * SZ_WIN, D, S, E);
                SEAM(pb + 1);
            }
            if (IN(pb + 2)) for (int rep = 0; rep < MK_REP_EV; ++rep) {
                if (ON(4)) { PHASE_ENTER for (int u = P.vcu; u < 256; u += P.G) lru_unit(P, args, eo, u); }
                if (ON(17)) { PHASE_ENTER for (int u = P.vcu; u < 512; u += P.G) gla_ds_unit(P, args, eo, u); }
                SEAM(pb + 2);
            }
            if (ON(5) && IN(pb + 3)) for (int rep = 0; rep < MK_REP_EV; ++rep) { PHASE_ENTER gla_state_phase(P); SEAM(pb + 3); }
            if (ON(6) && IN(pb + 4)) for (int rep = 0; rep < MK_REP_EV; ++rep) { PHASE_ENTER for (int u = P.vcu; u < 512; u += P.G) gla_out_unit(P, args, eo, u); SEAM(pb + 4); }
            if (ON(7) && IN(pb + 5)) {
                PHASE_ENTER
                pg8::StaticOrder S; S.init(T, D, D, P.G, PBX);
                pg8::EpiResid E{(bf16*)(ws + xcur)};
                pg8::gemm_phase<pg8::EpiResid, pg8::StaticOrder, false>(P.tid, ring, (const char*)(ws + WS_YCAT), (const char*)(ws + WS_WOUT) + (size_t)eo * SZ_DD, D, S, E);
                SEAM(pb + 5);
            }
        } else {
            if (ON(8) && IN(pb + 1)) for (int rep = 0; rep < MK_REP_G; ++rep) {
                PHASE_ENTER
                pg8::SplitK2Order S; S.init(T, 1024, D, P.G, PBX);
                pg8::EpiStoreBf16Split E{(bf16*)(ws + WS_U), 1024, (size_t)T * 1024, (const float*)(ws + WS_RS)};
                pg8::gemm_phase<pg8::EpiStoreBf16Split, pg8::SplitK2Order, false>(P.tid, ring, (const char*)(ws + xcur), (const char*)(ws + WS_ODWIN) + (size_t)eo * SZ_ODWIN, D, S, E, D / 128);
                SEAM(pb + 1);
            }
            if (ON(9) && IN(pb + 2)) for (int rep = 0; rep < MK_REP_S5; ++rep) { PHASE_ENTER for (int u = P.vcu; u < 256; u += P.G) s5_unit(P, args, eo, u); SEAM(pb + 2); }
            if (ON(10) && IN(pb + 3)) {
                PHASE_ENTER
                pg8::StaticOrder S; S.init(T, 4096, 1024, P.G, PBX);
                pg8::EpiGlu E{(bf16*)(ws + xcur)};
                pg8::gemm_phase<pg8::EpiGlu, pg8::StaticOrder, false>(P.tid, ring, (const char*)(ws + WS_YS5), (const char*)(ws + WS_WGLU) + (size_t)eo * SZ_WGLU, 1024, S, E);
                SEAM(pb + 3);
            }
        }
        if (ON(11) && IN(pb + 6)) for (int rep = 0; rep < MK_REP_RT; ++rep) { PHASE_ENTER for (int u = P.vcu; u < 256; u += P.G) router_unit(P, args, l, u, rep + 1 < MK_REP_RT, (const bf16*)(ws + xcur)); SEAM(pb + 6); }
        if (ON(12) && IN(pb + 7)) {
            PHASE_ENTER
            unsigned* flags = (unsigned*)(ws + WS_CTL) + CW_FLAG + l * 32 * 32 * 16;
            {
                fg::Tables tb; moe_prepare2(P, l, 4, tb, false);
                const int nu2 = __builtin_amdgcn_readfirstlane(tb.utab[3 * fg::MAXU]);
#pragma unroll 1
                for (int ui = 0; ui < nu2; ++ui) {
                    fg::fgemm_phase<0>(opaque_v(P.tid), ring, tb, (const char*)(ws + WS_XN), args.in[32] + (size_t)l * 32 * D * 512, args.in[33] + (size_t)l * 32 * D * 512, (bf16*)(ws + WS_H), ui, ui + 1);
                    if (P.tid == 0) { __builtin_amdgcn_fence(__ATOMIC_RELEASE, "agent"); asm volatile("s_waitcnt vmcnt(0)" ::: "memory");
                        __hip_atomic_fetch_add(flags + (tb.utab[3 * ui] * 32 + tb.utab[3 * ui + 1]) * 16, 1u, __ATOMIC_RELAXED, __HIP_MEMORY_SCOPE_AGENT); }
                }
            }
            {
                Frame Q = P; Q.tid = opaque_v(P.tid);
                fg::Tables tb; moe_prepare2(Q, l, 8, tb, true);
                const int nu3 = __builtin_amdgcn_readfirstlane(tb.utab[3 * fg::MAXU]);
                fg::fgemm_phase<1>(Q.tid, ring, tb, (const char*)(ws + WS_H), args.in[34] + (size_t)l * 32 * 512 * D, nullptr, (bf16*)(ws + WS_Y), 0, nu3);
            }
            SEAM(pb + 8);
        }
        if (ON(14) && IN(pb + 9)) {
            PHASE_ENTER
            const int gw = P.vcu * NWAVES + P.wave, NGW = P.G * NWAVES;
            for (int m = gw; m < T; m += NGW) { bf16* xr = (bf16*)(ws + xcur) + (size_t)m * D;
                norm_row<true, true, true, 0>(xr, (const bf16*)(ws + WS_Y) + (size_t)m * D, (const bf16*)(ws + WS_Y) + (size_t)(T + m) * D, xr, nullptr, nullptr, nullptr, (float*)(ws + WS_RS) + m, P.lane); }
            SEAM(pb + 9);
        }
        if (ON(15) && IN(pb + 10)) {
            PHASE_ENTER
            pg8::StaticOrder S; S.init(T, D, D, P.G, PBX);
            pg8::EpiPle E{(const bf16*)(ws + xcur), (bf16*)(ws + xnxt), (const bf16*)(ws + WS_PP) + (size_t)l * T * D, args.in[36] + (size_t)l * D, (const float*)(ws + WS_RS)};
            pg8::gemm_phase<pg8::EpiPle, pg8::StaticOrder, false>(P.tid, ring, (const char*)(ws + xcur), (const char*)(ws + WS_PLEG) + (size_t)l * SZ_DD, D, S, E);
            SEAM(pb + 10);
        }
    }
    if (ON(16) && IN(PH_FINAL)) {
        PHASE_ENTER
        const int gw = P.vcu * NWAVES + P.wave, NGW = P.G * NWAVES;
        for (int m = gw; m < T; m += NGW) norm_row<true, false, false, 2>((const bf16*)(ws + WS_XRES + (size_t)(DEPTH & 1) * T * D * 2) + (size_t)m * D, nullptr, nullptr, nullptr, args.in[5], nullptr, args.out + (size_t)m * D, nullptr, P.lane);
    }
#undef IN
#undef ON
#undef SEAM
#undef PHASE_ENTER
}

static bool phase_exists(int k) {
    if (k < PH_LAYER0 || k >= PH_FINAL) return true;
    const int l = (k - PH_LAYER0) / PH_PER_LAYER, r = (k - PH_LAYER0) % PH_PER_LAYER;
    if (r == 0) return l > 0;
    if (r == 11) return false;
    if (l & 1) return !(r == 4 || r == 5);
    return true;
}
extern "C" void kernel_launch(void* const* d_in, const int* in_sizes, int n_in, void* d_out, int out_size, void* d_ws, size_t ws_size, hipStream_t stream) {
    static int grid = 0;
    if (grid == 0) {
        if (n_in != 38 || out_size != T * D || ws_size < WS_END) { fprintf(stderr, "kernel_launch: unexpected problem (n_in %d, out %d, ws %zu < %zu)\n", n_in, out_size, ws_size, (size_t)WS_END); grid = -1; return; }
        int dev = 0, cus = 0, per_cu = 0;
        if (hipGetDevice(&dev) != hipSuccess || hipDeviceGetAttribute(&cus, hipDeviceAttributeMultiprocessorCount, dev) != hipSuccess) { grid = -1; return; }
        if (hipFuncSetAttribute((const void*)mk_fwd, hipFuncAttributeMaxDynamicSharedMemorySize, LDS_BYTES) != hipSuccess) { fprintf(stderr, "kernel_launch: hipFuncSetAttribute failed\n"); grid = -1; return; }
        if (hipOccupancyMaxActiveBlocksPerMultiprocessor(&per_cu, (const void*)mk_fwd, NTHR, LDS_BYTES) != hipSuccess || per_cu < 1) fprintf(stderr, "kernel_launch: occupancy query says %d\n", per_cu);
        (void)hipGetLastError();
        grid = cus;
    }
    if (grid < 0) return;
    (void)hipMemsetAsync((char*)d_ws + WS_CTL, 0, CTL_BYTES, stream);
    Args a{};
    for (int i = 0; i < 38; ++i) a.in[i] = (const float*)d_in[i];
    a.out = (float*)d_out; a.ws = (unsigned char*)d_ws;
#if MK_PER_PHASE
    for (int k = 0; k < PH_END; ++k) { if (!phase_exists(k)) continue; a.ph_lo = k; a.ph_hi = k + 1; hipLaunchKernelGGL(mk_fwd, dim3(grid), dim3(NTHR), LDS_BYTES, stream, a); }
#else
    (void)phase_exists;
    a.ph_lo = 0; a.ph_hi = PH_END;
    hipLaunchKernelGGL(mk_fwd, dim3(grid), dim3(NTHR), LDS_BYTES, stream, a);
#endif
    const hipError_t le = hipPeekAtLastError();
    if (le != hipSuccess) fprintf(stderr, "kernel_launch: launch failed: %s\n", hipGetErrorName(le));
}
```

```cpp
#include <hip/hip_runtime.h>
#include <cstdio>
#include <cstdint>

#ifndef MK_PER_PHASE
#define MK_PER_PHASE 0
#endif

#define GAS __attribute__((address_space(1)))
#define LAS __attribute__((address_space(3)))
typedef unsigned short bf16;
typedef short bf16x8 __attribute__((ext_vector_type(8)));
typedef float f32x4 __attribute__((ext_vector_type(4)));
typedef float f32x2 __attribute__((ext_vector_type(2)));
typedef unsigned u32x4 __attribute__((ext_vector_type(4)));
typedef unsigned u32x2 __attribute__((ext_vector_type(2)));

constexpr int T = 8192, D = 2048, SEQ = 2048, NB = 4, DEPTH = 4;
constexpr int ZW = 5632;
constexpr int EV_IN = 5136;
constexpr float EPS = 1e-6f;
constexpr int NWAVES = 8, NTHR = 512;

constexpr size_t MiB = 1u << 20;
constexpr size_t WS_CTL = 0, CTL_BYTES = 1 * MiB;
constexpr size_t WS_WIN = 1 * MiB;
constexpr size_t SZ_WIN = (size_t)ZW * D * 2;
constexpr size_t WS_WOUT = WS_WIN + 2 * SZ_WIN;
constexpr size_t SZ_DD = (size_t)D * D * 2;
constexpr size_t WS_ODWIN = WS_WOUT + 2 * SZ_DD;
constexpr size_t SZ_ODWIN = (size_t)1024 * D * 2;
constexpr size_t WS_WGLU = WS_ODWIN + 2 * SZ_ODWIN;
constexpr size_t SZ_WGLU = (size_t)4096 * 1024 * 2;
constexpr size_t WS_PLEG = WS_WGLU + 2 * SZ_WGLU;
constexpr size_t WS_PLEP = WS_PLEG + 4 * SZ_DD;
constexpr size_t SZ_PLEP = (size_t)D * 256 * 2;
constexpr size_t WS_W13 = WS_PLEP + 4 * SZ_PLEP;
constexpr size_t WS_RTW = WS_W13;
constexpr int RTW_IMG = 2 * 4 * 48 * 40;
constexpr size_t SZ_W13 = (size_t)1024 * D * 2;
constexpr size_t WS_W2 = WS_W13 + 128 * SZ_W13;
constexpr size_t SZ_W2 = (size_t)D * 512 * 2;
constexpr size_t WS_XRES = WS_W2 + 128 * SZ_W2;
constexpr size_t WS_XN = WS_XRES + (size_t)T * D * 4;
constexpr size_t WS_Z = WS_XN + (size_t)T * D * 2;
constexpr size_t WS_YCAT = WS_Z + (size_t)T * ZW * 2;
constexpr size_t WS_DS = WS_YCAT + (size_t)T * D * 2;
constexpr size_t SZ_DS = (size_t)16 * 32 * 128 * 256 * 4;
constexpr size_t WS_SPREV = WS_DS + SZ_DS;
constexpr size_t WS_DECAY = WS_SPREV + SZ_DS;
constexpr size_t WS_U = WS_DECAY + (size_t)16 * 32 * 128 * 4;
constexpr size_t WS_YS5 = WS_U + (size_t)2 * T * 1024 * 2;
constexpr size_t WS_PB = WS_YS5 + (size_t)T * 1024 * 2;
constexpr size_t WS_PP = WS_PB + (size_t)4 * T * 256 * 2;
constexpr size_t WS_H = WS_PP + (size_t)4 * T * D * 2;
constexpr size_t WS_Y = WS_H + (size_t)2 * T * 512 * 2;
constexpr size_t WS_LIST = WS_Y + (size_t)2 * T * D * 2;
constexpr size_t WS_COMB = WS_LIST + (size_t)32 * 8192 * 4;
constexpr size_t WS_RS = WS_COMB + (size_t)2 * T * 4;
constexpr size_t WS_END = WS_RS + (size_t)T * 4;
constexpr int CW_BAR = 4096;
constexpr int CW_FLAG = 32768;
constexpr int CW_CNT = 16384;

constexpr int LDS_BYTES = 163840;
constexpr int EXTRA_OFF = 147456;
constexpr int MISC_OFF = LDS_BYTES - 256;

__device__ __forceinline__ float bf2f(unsigned b) { return __uint_as_float(b << 16); }
__device__ __forceinline__ unsigned f2bf(float f) { unsigned u = __float_as_uint(f); return (u + 0x7fffu + ((u >> 16) & 1u)) >> 16; }
typedef __bf16 bf16x2_t __attribute__((ext_vector_type(2)));
__device__ __forceinline__ unsigned pk2(float lo, float hi) { const bf16x2_t r = __builtin_convertvector((f32x2){lo, hi}, bf16x2_t); return __builtin_bit_cast(unsigned, r); }
__device__ __forceinline__ float lo16(unsigned w) { return __uint_as_float(w << 16); }
__device__ __forceinline__ float hi16(unsigned w) { return __uint_as_float(w & 0xffff0000u); }
__device__ __forceinline__ f32x4 up4(u32x2 w) { return (f32x4){lo16(w.x), hi16(w.x), lo16(w.y), hi16(w.y)}; }
__device__ __forceinline__ u32x2 dn4(f32x4 v) { u32x2 w; w.x = pk2(v[0], v[1]); w.y = pk2(v[2], v[3]); return w; }
__device__ __forceinline__ float sigmoidf_(float x) { return __builtin_amdgcn_rcpf(1.0f + __expf(-x)); }
__device__ __forceinline__ float one_minus_exp(float t) { const float ser = -t * (1.0f + 0.5f * t * (1.0f + (1.0f / 3.0f) * t * (1.0f + 0.25f * t))); return t > -0.03125f ? ser : 1.0f - __expf(t); }
__device__ __forceinline__ float siluf_(float x) { return x * sigmoidf_(x); }
__device__ __forceinline__ float gelu_tanh(float x) { return x * sigmoidf_(1.5957691216f * (x + 0.044715f * x * x * x)); }
__device__ __forceinline__ float softplusf_(float x) { return fmaxf(x, 0.f) + log1pf(__expf(-fabsf(x))); }
__device__ __forceinline__ float logsigmoidf_(float x) { return fminf(x, 0.f) - __logf(1.0f + __expf(-fabsf(x))); }
__device__ __forceinline__ float dpp_f(float v, const int ctrl_sel) {
    const int i = __builtin_bit_cast(int, v);
    int r;
    if (ctrl_sel == 0) r = __builtin_amdgcn_update_dpp(0, i, 0xB1, 0xF, 0xF, false);
    else if (ctrl_sel == 1) r = __builtin_amdgcn_update_dpp(0, i, 0x4E, 0xF, 0xF, false);
    else if (ctrl_sel == 2) r = __builtin_amdgcn_update_dpp(0, i, 0x141, 0xF, 0xF, false);
    else r = __builtin_amdgcn_update_dpp(0, i, 0x140, 0xF, 0xF, false);
    return __builtin_bit_cast(float, r);
}
__device__ __forceinline__ float shx(float v, int mask, int lane) { return __builtin_bit_cast(float, __builtin_amdgcn_ds_bpermute((lane ^ mask) << 2, __builtin_bit_cast(int, v))); }
__device__ __forceinline__ float wave_sum(float v) {
    v += dpp_f(v, 0); v += dpp_f(v, 1); v += dpp_f(v, 2); v += dpp_f(v, 3);
    const int i = __builtin_bit_cast(int, v);
    const float r0 = __builtin_bit_cast(float, __builtin_amdgcn_readlane(i, 0)), r1 = __builtin_bit_cast(float, __builtin_amdgcn_readlane(i, 16));
    const float r2 = __builtin_bit_cast(float, __builtin_amdgcn_readlane(i, 32)), r3 = __builtin_bit_cast(float, __builtin_amdgcn_readlane(i, 48));
    return (r0 + r1) + (r2 + r3);
}
#define LDS_WAIT() asm volatile("s_waitcnt lgkmcnt(0)" ::: "memory")
#define LDS_BARRIER() do { asm volatile("s_waitcnt lgkmcnt(0)" ::: "memory"); __builtin_amdgcn_s_barrier(); asm volatile("" ::: "memory"); } while (0)
__device__ __forceinline__ int opaque_v(int v) { asm volatile("" : "+v"(v)); return v; }
__device__ __forceinline__ int lane_now() { int z = 0; asm volatile("" : "+s"(z)); return (int)__builtin_amdgcn_mbcnt_hi(~0u, __builtin_amdgcn_mbcnt_lo(~0u, (unsigned)z)); }
__device__ __forceinline__ int opaque_s(int v) { v = __builtin_amdgcn_readfirstlane(v); asm volatile("" : "+s"(v)); return v; }
__device__ __forceinline__ unsigned char* opaque_p(unsigned char* p) { __attribute__((address_space(1))) unsigned char* g = (__attribute__((address_space(1))) unsigned char*)p; asm volatile("" : "+s"(g)); return (unsigned char*)g; }

#define XB_TMO      128
#define XB_XCNT(j)  (256  + 64 * (j))
#define XB_XSUB(j)  (1280 + 64 * (j))
#define XB_XGEN(j)  (2304 + 64 * (j))
#define XB_TOP      3328
#define XB_TOPGEN   3392
#define XCD_BAR_WORDS 3456
#define XB_SPIN_CAP (1u << 18)
__device__ __forceinline__ unsigned xb_ld(unsigned* p)              { return __hip_atomic_load(p, __ATOMIC_RELAXED, __HIP_MEMORY_SCOPE_AGENT); }
__device__ __forceinline__ unsigned xb_add(unsigned* p, unsigned v) { return __hip_atomic_fetch_add(p, v, __ATOMIC_RELAXED, __HIP_MEMORY_SCOPE_AGENT); }
__device__ __forceinline__ unsigned xb_xcc_id() { return (unsigned)__builtin_amdgcn_s_getreg((3 << 11) | 20) & 0xFu; }
#define XB_SPIN(cond, bar) do { unsigned _sp = 0; while (cond) { __builtin_amdgcn_s_sleep(1); \
    if ((++_sp & 255u) == 0u) { if (xb_ld(&(bar)[XB_TMO])) break; if (_sp > XB_SPIN_CAP) { atomicAdd(&(bar)[XB_TMO], 1u); break; } } } } while (0)
struct XcdBarrier { unsigned* bar; unsigned x; volatile LAS unsigned* st; };
__device__ __forceinline__ XcdBarrier xcd_barrier_post(unsigned* bar, volatile LAS unsigned* st) {
    XcdBarrier b; b.bar = bar; b.x = xb_xcc_id(); b.st = st;
    if (threadIdx.x == 0) st[2] = xb_add(&bar[XB_XCNT(b.x)], 1u);
    return b;
}
__device__ __forceinline__ unsigned long long xcd_barrier_complete(unsigned* bar, unsigned x) {
    const unsigned G = gridDim.x * gridDim.y * gridDim.z;
    unsigned sum, cnt, mine, sp = 0u;
    for (;;) {
        sum = 0u; cnt = 0u; mine = 0u;
#pragma unroll 1
        for (unsigned j = 0; j < 16; ++j) { const unsigned c = xb_ld(&bar[XB_XCNT(j)]); sum += c; cnt += (c > 0u) ? 1u : 0u; mine = (j == x) ? c : mine; }
        if (sum == G) break;
        __builtin_amdgcn_s_sleep(1);
        if ((++sp & 255u) == 0u) { if (xb_ld(&bar[XB_TMO])) break; if (sp > XB_SPIN_CAP) { atomicAdd(&bar[XB_TMO], 1u); break; } }
    }
    const unsigned nloc = mine > 0u ? mine : 1u, nx = cnt > 0u ? cnt : 1u;
    return ((unsigned long long)nx << 32) | nloc;
}
__device__ __forceinline__ void xcd_barrier_leader(unsigned* bar, unsigned x, volatile LAS unsigned* st) {
    __builtin_amdgcn_s_waitcnt(0);
    unsigned nloc = st[0], nx = st[1];
    if (nloc == 0u) { const unsigned long long r = xcd_barrier_complete(bar, x); nloc = (unsigned)r; nx = (unsigned)(r >> 32); st[0] = nloc; st[1] = nx; }
    const unsigned old = xb_add(&bar[XB_XSUB(x)], 1u);
    const unsigned gen = old / nloc;
    if (old + 1u == (gen + 1u) * nloc) {
        __builtin_amdgcn_fence(__ATOMIC_RELEASE, "agent");
        asm volatile("s_waitcnt vmcnt(0)" ::: "memory");
        const unsigned og = xb_add(&bar[XB_TOP], 1u);
        const unsigned tg = og / nx;
        if (og + 1u == (tg + 1u) * nx) xb_add(&bar[XB_TOPGEN], 1u);
        else XB_SPIN(xb_ld(&bar[XB_TOPGEN]) == tg, bar);
        __builtin_amdgcn_fence(__ATOMIC_ACQUIRE, "agent");
        xb_add(&bar[XB_XGEN(x)], 1u);
        asm volatile("s_waitcnt vmcnt(0)" ::: "memory");
    } else {
        XB_SPIN(xb_ld(&bar[XB_XGEN(x)]) == gen, bar);
        __builtin_amdgcn_fence(__ATOMIC_ACQUIRE, "agent");
        asm volatile("s_waitcnt vmcnt(0)" ::: "memory");
    }
}
__device__ __forceinline__ void xcd_barrier(const XcdBarrier& b, const bool leader) {
    asm volatile("s_waitcnt vmcnt(0)" ::: "memory");
    __syncthreads();
    if (leader) xcd_barrier_leader(b.bar, b.x, b.st);
    __syncthreads();
}

struct Args { const float* in[38]; float* out; unsigned char* ws; int ph_lo, ph_hi; };
typedef const Args __attribute__((address_space(4))) KArgs;
__device__ __forceinline__ KArgs* opaque_k(KArgs* p) { asm volatile("" : "+s"(p)); return p; }
struct Frame {
    LAS unsigned char* lds;
    int tid, lane, wave, vcu, G;
    unsigned char* ws;
};

namespace pg8 {
constexpr int BM = 256, BK = 64, HALF = 128, HTB = HALF * BK * 2, STAGE_BYTES = 8 * HTB, NXCD = 8, WGM = 8;
__device__ __forceinline__ int lds_byte(int r, int c) { const int st = (r >> 4) * 2 + (c >> 5), rr = r & 15, cc = c & 31, ob = rr * 64 + cc * 2; return st * 1024 + (ob ^ (((ob >> 9) & 1) << 5)); }
__device__ __forceinline__ void stage_rc(int b, int& R, int& C) { const int st = b / 1024, sb = b % 1024, swz = sb ^ (((sb >> 9) & 1) << 5); R = (st >> 1) * 16 + swz / 64; C = (st & 1) * 32 + (swz % 64) / 2; }

struct Unit { int pm, pn; size_t a_off, b_off; int ui, e, nrows; };

struct StaticOrder {
    int nM, nN, nwg, G, c, K;
    __device__ void init(int M, int N, int K_, int G_, int c_) { nM = M / BM; nN = N / BM; nwg = nM * nN; G = G_; c = c_; K = K_; }
    __device__ __forceinline__ bool next(int i, Unit& u) const {
        const long L = (long)i * G + c; if (L >= nwg) return false;
        int wgid = (int)L; { const int q = nwg / NXCD, r = nwg % NXCD, xcd = wgid % NXCD, off = wgid / NXCD; wgid = (xcd < r ? xcd * (q + 1) : r * (q + 1) + (xcd - r) * q) + off; }
        const int nig = WGM * nN, gid = wgid / nig, fm = gid * WGM, gsz = (nM - fm) < WGM ? (nM - fm) : WGM;
        u.pm = fm + ((wgid % nig) % gsz); u.pn = (wgid % nig) / gsz;
        u.a_off = (size_t)u.pm * BM * K * 2; u.b_off = (size_t)u.pn * BM * K * 2; u.ui = i; u.e = 0; u.nrows = BM;
        return true;
    }
    __device__ __forceinline__ unsigned row_off(const Unit&, int) const { return 0u; }
};

struct SplitK2Order {
    StaticOrder base;
    __device__ void init(int M, int N, int K_, int G_, int c_) { base.init(M, N, K_, G_, c_); }
    __device__ __forceinline__ bool next(int i, Unit& u) const {
        const long L = (long)i * base.G + base.c; if (L >= 2 * base.nwg) return false;
        StaticOrder b2 = base; b2.G = 1; b2.c = 0;
        const int kh = (int)(L & 1); if (!b2.next((int)(L >> 1), u)) return false;
        u.a_off += (size_t)kh * base.K; u.b_off += (size_t)kh * base.K; u.ui = i; u.e = kh; return true;
    }
    __device__ __forceinline__ unsigned row_off(const Unit&, int) const { return 0u; }
};
struct PPOrder {
    StaticOrder base; size_t a_layer, b_layer;
    __device__ void init(int M, int N, int K_, int G_, int c_, size_t a_layer_, size_t b_layer_) { base.init(M, N, K_, G_, c_); a_layer = a_layer_; b_layer = b_layer_; }
    __device__ __forceinline__ bool next(int i, Unit& u) const {
        const long L = (long)i * base.G + base.c; if (L >= 4L * base.nwg) return false;
        const int ll = (int)(L / base.nwg); StaticOrder b2 = base; b2.G = 1; b2.c = 0;
        if (!b2.next((int)(L - (long)ll * base.nwg), u)) return false;
        u.a_off += (size_t)ll * a_layer; u.b_off += (size_t)ll * b_layer; u.ui = i; u.e = ll; return true;
    }
    __device__ __forceinline__ unsigned row_off(const Unit&, int) const { return 0u; }
};
constexpr int MOE_MAXU = 4;
struct MoeOrder {
    const LAS int* pre;
    const LAS int* cnt;
    const LAS int* ptab;
    int nct, G, c, K, brows;
    unsigned rshift_mask;
    unsigned rbytes;
    __device__ __forceinline__ bool decode(int i, int& e, int& rt, int& ct) const {
        if (i >= MOE_MAXU) return false;
        const int L = i * G + c, total = pre[32] * nct; if (L >= total) return false;
        const int rtg = L / nct; ct = L - rtg * nct; e = 0;
        for (int j = 1; j < 32; ++j) e = (pre[j] <= rtg) ? j : e;
        rt = rtg - pre[e]; return true;
    }
    __device__ __forceinline__ bool next(int i, Unit& u) const {
        int e, rt, ct; if (!decode(i, e, rt, ct)) return false;
        u.pm = rt; u.pn = ct; u.a_off = 0; u.b_off = ((size_t)e * brows + (size_t)ct * BM) * K * 2; u.ui = i; u.e = e;
        const int left = cnt[e] - rt * BM; u.nrows = left < BM ? left : BM; return true;
    }
    __device__ __forceinline__ unsigned row_off(const Unit& u, int r) const { const int p = ptab[u.ui * 256 + r]; return p < 0 ? 0u : ((unsigned)p & rshift_mask) * rbytes; }
};

template <class Epi, class Sched, bool GATHER>
__device__ __forceinline__ void gemm_phase(const int tid, LAS unsigned char* lds, const char* Abase, const char* Bbase, const int K, const Sched& S, const Epi& E, const int ntl = 0) {
    const int wid = __builtin_amdgcn_readfirstlane(tid >> 6), lane = tid & 63, wr = wid >> 2, wc = wid & 3, fr = lane & 15, fq = lane >> 4;
    const int nt = ntl ? ntl : K / BK;
    unsigned voff[2]; int RR[2]; unsigned CC2[2];
#pragma unroll
    for (int i = 0; i < 2; ++i) { int R, C; stage_rc(tid * 16 + i * 8192, R, C); voff[i] = (unsigned)(R * K + C) * 2u; RR[i] = R; CC2[i] = (unsigned)C * 2u; }
    const size_t kstep = (size_t)(BK * 2);
    const size_t hstep = (size_t)HALF * K * 2;
    const unsigned ldsw = (unsigned)wid * 1024u;
    const int aoff = lds_byte(wr * 64 + fr, fq * 8), boff = lds_byte(wc * 32 + fr, fq * 8);
#define PG8_SA(b, h) (((b) * 2 + (h)) * HTB)
#define PG8_SB(b, h) ((4 + (b) * 2 + (h)) * HTB)
#define PG8_STAGE_B(bufoff, gbase) do { _Pragma("unroll") for (int _i = 0; _i < 2; ++_i) \
        __builtin_amdgcn_global_load_lds((const unsigned*)((const char*)(gbase) + voff[_i]), (LAS unsigned*)(lds + (bufoff) + ldsw + _i * 8192), 16, 0, 0); } while (0)
#define PG8_STAGE_A(bufoff, gbase, ro, kb) do { _Pragma("unroll") for (int _i = 0; _i < 2; ++_i) { \
        if constexpr (GATHER) __builtin_amdgcn_global_load_lds((const unsigned*)(Abase + ((ro)[_i] + (unsigned)(kb))), (LAS unsigned*)(lds + (bufoff) + ldsw + _i * 8192), 16, 0, 0); \
        else __builtin_amdgcn_global_load_lds((const unsigned*)((const char*)(gbase) + voff[_i]), (LAS unsigned*)(lds + (bufoff) + ldsw + _i * 8192), 16, 0, 0); } } while (0)
#define PG8_LDA(dst, b, h) do { _Pragma("unroll") for (int m = 0; m < 4; ++m) _Pragma("unroll") for (int k = 0; k < 2; ++k) dst[m][k] = *(const LAS bf16x8*)(lds + PG8_SA(b, h) + aoff + m * 2048 + k * 1024); } while (0)
#define PG8_LDB(dst, b, h) do { _Pragma("unroll") for (int n = 0; n < 2; ++n) _Pragma("unroll") for (int k = 0; k < 2; ++k) dst[n][k] = *(const LAS bf16x8*)(lds + PG8_SB(b, h) + boff + n * 2048 + k * 1024); } while (0)
#define PG8_MMA(ai, bj, At, Bt) do { __builtin_amdgcn_s_setprio(1); _Pragma("unroll") for (int m = 0; m < 4; ++m) _Pragma("unroll") for (int n = 0; n < 2; ++n) _Pragma("unroll") for (int k = 0; k < 2; ++k) \
        acc[ai][bj][m][n] = __builtin_amdgcn_mfma_f32_16x16x32_bf16(Bt[n][k], At[m][k], acc[ai][bj][m][n], 0, 0, 0); __builtin_amdgcn_s_setprio(0); } while (0)
#define PG8_WAIT_V(n) asm volatile("s_waitcnt vmcnt(" #n ")" ::: "memory")
#define PG8_WAIT_L(n) asm volatile("s_waitcnt lgkmcnt(" #n ")" ::: "memory")
#define PG8_BAR __builtin_amdgcn_s_barrier()
#define PG8_SCHED __builtin_amdgcn_sched_barrier(0)
    Unit cur, nxt; int ui = 0;
    if (!S.next(0, cur)) return;
    f32x4 acc[2][2][4][2];
#pragma unroll
    for (int a = 0; a < 2; ++a)
#pragma unroll
        for (int b = 0; b < 2; ++b)
#pragma unroll
            for (int m = 0; m < 4; ++m)
#pragma unroll
                for (int n = 0; n < 2; ++n) acc[a][b][m][n] = (f32x4){0.f, 0.f, 0.f, 0.f};
    bf16x8 At[4][2], B0[2][2], B1[2][2];
    const char* cA = Abase + cur.a_off; const char* cB = Bbase + cur.b_off;
    unsigned cro0[2] = {0u, 0u}, cro1[2] = {0u, 0u}, nro0[2] = {0u, 0u}, nro1[2] = {0u, 0u};
    if constexpr (GATHER) {
#pragma unroll
        for (int i = 0; i < 2; ++i) { cro0[i] = S.row_off(cur, RR[i]) + CC2[i]; cro1[i] = S.row_off(cur, 128 + RR[i]) + CC2[i]; }
    }
    PG8_STAGE_B(PG8_SB(0, 0), cB); PG8_STAGE_A(PG8_SA(0, 0), cA, cro0, 0); PG8_STAGE_B(PG8_SB(0, 1), cB + hstep); PG8_STAGE_A(PG8_SA(0, 1), cA + hstep, cro1, 0);
    if (wr == 1) PG8_BAR;
    PG8_WAIT_V(4); PG8_BAR;
    PG8_STAGE_B(PG8_SB(1, 0), cB + kstep); PG8_STAGE_A(PG8_SA(1, 0), cA + kstep, cro0, kstep); PG8_STAGE_B(PG8_SB(1, 1), cB + hstep + kstep);
    PG8_WAIT_V(6); PG8_BAR;
    for (;;) {
        const bool has_next = S.next(ui + 1, nxt);
        const char* nA = has_next ? Abase + nxt.a_off : cA; const char* nB = has_next ? Bbase + nxt.b_off : cB;
        if constexpr (GATHER) {
#pragma unroll
            for (int i = 0; i < 2; ++i) { nro0[i] = has_next ? S.row_off(nxt, RR[i]) + CC2[i] : cro0[i]; nro1[i] = has_next ? S.row_off(nxt, 128 + RR[i]) + CC2[i] : cro1[i]; }
        }
        for (int t = 0; t < nt; t += 2) {
            const bool last = (t == nt - 2);
            const char* a1 = cA + (size_t)(t + 1) * kstep;
            const char* a2 = last ? nA : cA + (size_t)(t + 2) * kstep; const char* b2 = last ? nB : cB + (size_t)(t + 2) * kstep;
            const char* a3 = a2 + kstep; const char* b3 = b2 + kstep;
            unsigned r20[2], r21[2]; unsigned k1 = 0, k2 = 0, k3 = 0;
            if constexpr (GATHER) {
#pragma unroll
                for (int i = 0; i < 2; ++i) { r20[i] = last ? nro0[i] : cro0[i]; r21[i] = last ? nro1[i] : cro1[i]; }
                k1 = (unsigned)(t + 1) * 128u; k2 = last ? 0u : (unsigned)(t + 2) * 128u; k3 = k2 + 128u;
            } else { r20[0] = r20[1] = r21[0] = r21[1] = 0u; }
            PG8_LDB(B0, 0, 0); PG8_SCHED; PG8_LDA(At, 0, 0); PG8_STAGE_A(PG8_SA(1, 1), a1 + hstep, cro1, k1);
            PG8_WAIT_L(8); PG8_BAR; PG8_WAIT_L(0); PG8_MMA(0, 0, At, B0); PG8_BAR; PG8_SCHED;
            PG8_LDB(B1, 0, 1); PG8_STAGE_B(PG8_SB(0, 0), b2);
            PG8_BAR; PG8_WAIT_L(0); PG8_MMA(0, 1, At, B1); PG8_BAR;
            PG8_LDA(At, 0, 1); PG8_STAGE_A(PG8_SA(0, 0), a2, r20, k2);
            PG8_BAR; PG8_WAIT_L(0); PG8_MMA(1, 0, At, B0); PG8_BAR; PG8_SCHED;
            PG8_STAGE_B(PG8_SB(0, 1), b2 + hstep);
            PG8_WAIT_V(6); PG8_BAR; PG8_MMA(1, 1, At, B1); PG8_BAR;
            PG8_LDB(B0, 1, 0); PG8_SCHED; PG8_LDA(At, 1, 0); PG8_STAGE_A(PG8_SA(0, 1), a2 + hstep, r21, k2);
            PG8_WAIT_L(8); PG8_BAR; PG8_WAIT_L(0); PG8_MMA(0, 0, At, B0); PG8_BAR; PG8_SCHED;
            PG8_LDB(B1, 1, 1); PG8_STAGE_B(PG8_SB(1, 0), b3);
            PG8_BAR; PG8_WAIT_L(0); PG8_MMA(0, 1, At, B1); PG8_BAR;
            PG8_LDA(At, 1, 1); PG8_STAGE_A(PG8_SA(1, 0), a3, r20, k3);
            PG8_BAR; PG8_WAIT_L(0); PG8_MMA(1, 0, At, B0); PG8_BAR; PG8_SCHED;
            PG8_STAGE_B(PG8_SB(1, 1), b3 + hstep);
            PG8_WAIT_V(6); PG8_BAR; PG8_MMA(1, 1, At, B1); PG8_BAR;
        }
        E(acc, cur, wr, wc, fr, fq);
        if (!has_next) break;
#pragma unroll
        for (int a = 0; a < 2; ++a)
#pragma unroll
            for (int b = 0; b < 2; ++b)
#pragma unroll
                for (int m = 0; m < 4; ++m)
#pragma unroll
                    for (int n = 0; n < 2; ++n) acc[a][b][m][n] = (f32x4){0.f, 0.f, 0.f, 0.f};
        cur = nxt; cA = nA; cB = nB; ++ui;
        if constexpr (GATHER) {
#pragma unroll
            for (int i = 0; i < 2; ++i) { cro0[i] = nro0[i]; cro1[i] = nro1[i]; }
        }
    }
    PG8_WAIT_V(0);
    if (wr == 0) PG8_BAR;
    PG8_BAR;
#undef PG8_SA
#undef PG8_SB
#undef PG8_STAGE_A
#undef PG8_STAGE_B
#undef PG8_LDA
#undef PG8_LDB
#undef PG8_MMA
#undef PG8_WAIT_V
#undef PG8_WAIT_L
#undef PG8_BAR
#undef PG8_SCHED
}

#define EPI_ROWS_BEGIN _Pragma("unroll") for (int ai = 0; ai < 2; ++ai) _Pragma("unroll") for (int m = 0; m < 4; ++m) { const int rl = ai * HALF + wr * 64 + m * 16 + fr;
#define EPI_ROWS_END }
struct EpiStoreBf16 {
    bf16* O; int ldc; const float* rs;
    __device__ __forceinline__ void operator()(const f32x4 (&acc)[2][2][4][2], const Unit& u, int wr, int wc, int fr, int fq) const {
        EPI_ROWS_BEGIN bf16* rowp = O + (size_t)(u.pm * BM + rl) * ldc + u.pn * BM + wc * 32 + 4 * fq; const float sc = rs ? rs[u.pm * BM + rl] : 1.0f;
#pragma unroll
            for (int bj = 0; bj < 2; ++bj)
#pragma unroll
                for (int n = 0; n < 2; ++n) { const f32x4 v = acc[ai][bj][m][n] * sc; u32x2 w; w.x = pk2(v[0], v[1]); w.y = pk2(v[2], v[3]); *(u32x2*)(rowp + bj * HALF + n * 16) = w; } EPI_ROWS_END
    }
};
struct EpiStoreBf16Split {
    bf16* O; int ldc; size_t half_stride; const float* rs;
    __device__ __forceinline__ void operator()(const f32x4 (&acc)[2][2][4][2], const Unit& u, int wr, int wc, int fr, int fq) const {
        EPI_ROWS_BEGIN bf16* rowp = O + (size_t)u.e * half_stride + (size_t)(u.pm * BM + rl) * ldc + u.pn * BM + wc * 32 + 4 * fq; const float sc = rs ? rs[u.pm * BM + rl] : 1.0f;
#pragma unroll
            for (int bj = 0; bj < 2; ++bj)
#pragma unroll
                for (int n = 0; n < 2; ++n) { const f32x4 v = acc[ai][bj][m][n] * sc; u32x2 w; w.x = pk2(v[0], v[1]); w.y = pk2(v[2], v[3]); *(u32x2*)(rowp + bj * HALF + n * 16) = w; } EPI_ROWS_END
    }
};
struct EpiResid {
    bf16* X;
    __device__ __forceinline__ void operator()(const f32x4 (&acc)[2][2][4][2], const Unit& u, int wr, int wc, int fr, int fq) const {
#pragma unroll
        for (int ai = 0; ai < 2; ++ai)
#pragma unroll
            for (int mp = 0; mp < 2; ++mp) { bf16* base = X + (size_t)(u.pm * BM + ai * HALF + wr * 64 + mp * 32 + fr) * D + u.pn * BM + wc * 32 + 4 * fq; u32x2 xv[2][2][2];
#pragma unroll
                for (int m = 0; m < 2; ++m)
#pragma unroll
                    for (int bj = 0; bj < 2; ++bj)
#pragma unroll
                        for (int n = 0; n < 2; ++n) xv[m][bj][n] = *(const u32x2*)(base + (size_t)m * 16 * D + bj * HALF + n * 16);
#pragma unroll
                for (int m = 0; m < 2; ++m)
#pragma unroll
                    for (int bj = 0; bj < 2; ++bj)
#pragma unroll
                        for (int n = 0; n < 2; ++n) *(u32x2*)(base + (size_t)m * 16 * D + bj * HALF + n * 16) = dn4(up4(xv[m][bj][n]) + acc[ai][bj][mp * 2 + m][n]);
                asm volatile("" ::: "memory"); }
    }
};
struct EpiGlu {
    bf16* X;
    __device__ __forceinline__ void operator()(const f32x4 (&acc)[2][2][4][2], const Unit& u, int wr, int wc, int fr, int fq) const {
#pragma unroll
        for (int ai = 0; ai < 2; ++ai) { u32x2 xv[4][2];
#pragma unroll
            for (int m = 0; m < 4; ++m)
#pragma unroll
                for (int bj = 0; bj < 2; ++bj) xv[m][bj] = *(const u32x2*)(X + (size_t)(u.pm * BM + ai * HALF + wr * 64 + m * 16 + fr) * D + 4 * fq + 16 * (8 * u.pn + 4 * bj + wc));
#pragma unroll
            for (int m = 0; m < 4; ++m)
#pragma unroll
                for (int bj = 0; bj < 2; ++bj) { const f32x4 a = acc[ai][bj][m][0], g = acc[ai][bj][m][1]; f32x4 x = up4(xv[m][bj]);
#pragma unroll
                    for (int j = 0; j < 4; ++j) x[j] += a[j] * sigmoidf_(g[j]);
                    *(u32x2*)(X + (size_t)(u.pm * BM + ai * HALF + wr * 64 + m * 16 + fr) * D + 4 * fq + 16 * (8 * u.pn + 4 * bj + wc)) = dn4(x); }
            asm volatile("" ::: "memory"); }
    }
};
struct EpiPle {
    const bf16* X; bf16* Xo; const bf16* PP; const float* bias; const float* rs;
    __device__ __forceinline__ void operator()(const f32x4 (&acc)[2][2][4][2], const Unit& u, int wr, int wc, int fr, int fq) const {
        const int col0 = u.pn * BM + wc * 32 + 4 * fq;
        f32x4 bv[2][2];
#pragma unroll
        for (int bj = 0; bj < 2; ++bj)
#pragma unroll
            for (int n = 0; n < 2; ++n) bv[bj][n] = *(const f32x4*)(bias + col0 + bj * HALF + n * 16);
#pragma unroll
        for (int ai = 0; ai < 2; ++ai)
#pragma unroll
            for (int mp = 0; mp < 2; ++mp) { const size_t ro = (size_t)(u.pm * BM + ai * HALF + wr * 64 + mp * 32 + fr) * D + col0; u32x2 xv[2][2][2], pw[2][2][2];
                const float sc[2] = {rs[u.pm * BM + ai * HALF + wr * 64 + mp * 32 + fr], rs[u.pm * BM + ai * HALF + wr * 64 + mp * 32 + 16 + fr]};
#pragma unroll
                for (int m = 0; m < 2; ++m)
#pragma unroll
                    for (int bj = 0; bj < 2; ++bj)
#pragma unroll
                        for (int n = 0; n < 2; ++n) { const size_t o = ro + (size_t)m * 16 * D + bj * HALF + n * 16; xv[m][bj][n] = *(const u32x2*)(X + o); pw[m][bj][n] = *(const u32x2*)(PP + o); }
#pragma unroll
                for (int m = 0; m < 2; ++m)
#pragma unroll
                    for (int bj = 0; bj < 2; ++bj)
#pragma unroll
                        for (int n = 0; n < 2; ++n) { const size_t o = ro + (size_t)m * 16 * D + bj * HALF + n * 16; const f32x4 v = acc[ai][bj][mp * 2 + m][n] * sc[m] + bv[bj][n]; f32x4 x = up4(xv[m][bj][n]); const f32x4 p = up4(pw[m][bj][n]);
#pragma unroll
                            for (int j = 0; j < 4; ++j) x[j] += sigmoidf_(v[j]) * p[j];
                            *(u32x2*)(Xo + o) = dn4(x); }
                asm volatile("" ::: "memory"); }
    }
};
struct EpiMoeH {
    bf16* H; const float* comb; const LAS int* ptab;
    __device__ __forceinline__ void operator()(const f32x4 (&acc)[2][2][4][2], const Unit& u, int wr, int wc, int fr, int fq) const {
        EPI_ROWS_BEGIN const int pair = ptab[u.ui * 256 + rl];
            if (pair >= 0) { const float cb = comb[pair]; bf16* rowp = H + (size_t)pair * 512 + 4 * fq;
#pragma unroll
                for (int bj = 0; bj < 2; ++bj) { const f32x4 g = acc[ai][bj][m][0], up = acc[ai][bj][m][1]; u32x2 w;
                    w.x = pk2(siluf_(g[0]) * up[0] * cb, siluf_(g[1]) * up[1] * cb); w.y = pk2(siluf_(g[2]) * up[2] * cb, siluf_(g[3]) * up[3] * cb);
                    *(u32x2*)(rowp + 16 * (8 * u.pn + 4 * bj + wc)) = w; } } EPI_ROWS_END
    }
};
struct EpiMoeY {
    bf16* Y; const LAS int* ptab;
    __device__ __forceinline__ void operator()(const f32x4 (&acc)[2][2][4][2], const Unit& u, int wr, int wc, int fr, int fq) const {
        EPI_ROWS_BEGIN const int pair = ptab[u.ui * 256 + rl];
            if (pair >= 0) { bf16* rowp = Y + (size_t)pair * D + u.pn * BM + wc * 32 + 4 * fq;
#pragma unroll
                for (int bj = 0; bj < 2; ++bj)
#pragma unroll
                    for (int n = 0; n < 2; ++n) { const f32x4 v = acc[ai][bj][m][n]; u32x2 w; w.x = pk2(v[0], v[1]); w.y = pk2(v[2], v[3]); *(u32x2*)(rowp + bj * HALF + n * 16) = w; } } EPI_ROWS_END
    }
};
}

namespace fg {
constexpr int TM = 256, TN = 256, BK = 32, STG = 49152, NSTG = 3, MAXU = 6;
struct Tables { const LAS int* cnt; const LAS int* preU; const LAS int* ptab; const LAS int* utab; const LAS float* ctab; unsigned* flags; int stride, c0; };
__device__ __forceinline__ bool decode(const Tables& tb, int i, int& e, int& rt, int& ct) {
    if (i >= MAXU || tb.c0 < 0) return false;
    const int L = i * tb.stride + tb.c0; if (L >= tb.preU[32]) return false;
    e = 0;
    for (int j = 1; j < 32; ++j) e = (tb.preU[j] <= L) ? j : e;
    const int nrt = (tb.cnt[e] + 255) >> 8, r = L - tb.preU[e]; ct = r / nrt; rt = r - ct * nrt; return true;
}
template <int MODE, int DRY = 0>
__device__ __forceinline__ void fgemm_phase(const int tid, LAS unsigned char* lds, const Tables& tb, const char* Abase, const float* W1l, const float* W3l, bf16* Out, const int ub, const int ue) {
    constexpr int K = MODE == 0 ? 2048 : 512, NT = K / BK, LDN = MODE == 0 ? 512 : 2048;
    constexpr unsigned RBYTES = MODE == 0 ? 4096u : 1024u;
    const int wid = __builtin_amdgcn_readfirstlane(tid >> 6), lane = tid & 63, wr = wid >> 2, wc = wid & 3, fr = lane & 15, fq = lane >> 4;
    const unsigned ldsw = (unsigned)wid * 1024u;
    const int bc0 = 4 * lane, bc1 = (4 * lane) ^ 16;
    const int aoff = wr * 8192 + ((fr * 64 + fq * 16) ^ (((fr >> 3) & 1) << 5));
    const int bfo = 16384 + ((8 * fq) * 256 + ((wc * 64 + 2 * fr) ^ ((fq & 1) << 4))) * 4;
    const int nunits = ue;
    if (ue <= ub) return;
    const int total = (ue - ub) * NT;
    f32x4 acc[8][4];
#pragma unroll
    for (int m = 0; m < 8; ++m)
#pragma unroll
        for (int n = 0; n < 4; ++n) acc[m][n] = (f32x4){0.f, 0.f, 0.f, 0.f};
    int su = ub, skt = 0, ns = 0, sb3 = 0; unsigned s_aro[2]; const float* s_b0; const float* s_b1;
#define FG_BSRC(bc_, e_, ct_) (MODE == 0 ? ((((bc_) >> 5) & 1) ? W3l : W1l) + (size_t)(e_) * 2048 * 512 + (size_t)wid * 512 + (ct_) * 128 + 32 * ((bc_) >> 6) + ((bc_) & 31) \
                                         : W1l + (size_t)(e_) * 512 * 2048 + (size_t)wid * 2048 + (ct_) * 256 + (bc_))
#define FG_LOAD_UNIT(u_) do { const int e_ = tb.utab[3 * (u_)], ct_ = tb.utab[3 * (u_) + 2]; \
        if (MODE == 1 && tb.flags) {     \
            unsigned* fl_ = tb.flags + (e_ * 32 + tb.utab[3 * (u_) + 1]) * 16; unsigned sp_ = 0; \
            while (__hip_atomic_load(fl_, __ATOMIC_RELAXED, __HIP_MEMORY_SCOPE_AGENT) < 4u) { __builtin_amdgcn_s_sleep(4); if (++sp_ > (1u << 22)) break; } \
            __builtin_amdgcn_fence(__ATOMIC_ACQUIRE, "agent"); } \
        _Pragma("unroll") for (int i_ = 0; i_ < 2; ++i_) { const int b_ = i_ * 8192 + tid * 16, st_ = b_ >> 10, sb_ = b_ & 1023, swz_ = sb_ ^ (((sb_ >> 9) & 1) << 5); \
            const int p_ = tb.ptab[(u_) * 256 + st_ * 16 + swz_ / 64]; \
            s_aro[i_] = (p_ < 0 ? 0u : (MODE == 0 ? ((unsigned)p_ & 8191u) : (unsigned)p_) * RBYTES) + (unsigned)(swz_ % 64); } \
        s_b0 = FG_BSRC(bc0, e_, ct_); s_b1 = FG_BSRC(bc1, e_, ct_); } while (0)
#define FG_STAGE() do { LAS unsigned char* st_ = lds + sb3 * STG; \
        _Pragma("unroll") for (int i_ = 0; i_ < 2; ++i_) \
            __builtin_amdgcn_global_load_lds((const unsigned*)(Abase + (s_aro[i_] + (unsigned)skt * 64u)), (LAS unsigned*)(st_ + ldsw + i_ * 8192), 16, 0, 0); \
        _Pragma("unroll") for (int r_ = 0; r_ < 4; ++r_) __builtin_amdgcn_global_load_lds((const unsigned*)(((r_ & 1) ? s_b1 : s_b0) + (size_t)(skt * 32 + r_ * 8) * LDN), (LAS unsigned*)(st_ + 16384 + r_ * 8192 + ldsw), 16, 0, 0); \
        ++ns; sb3 = (sb3 == NSTG - 1) ? 0 : sb3 + 1; if (++skt == NT) { skt = 0; ++su; if (su < nunits) FG_LOAD_UNIT(su); } } while (0)
    FG_LOAD_UNIT(ub);
    FG_STAGE(); if (ns < total) FG_STAGE();
    int s = 0, cb3 = 0;
    for (int u = ub; u < nunits; ++u) {
#pragma unroll 1
        for (int kt = 0; kt < NT; ++kt, ++s) {
            if (ns - 1 - s >= 1) asm volatile("s_waitcnt vmcnt(6)" ::: "memory"); else asm volatile("s_waitcnt vmcnt(0)" ::: "memory");
            __builtin_amdgcn_s_barrier(); asm volatile("" ::: "memory");
            const LAS unsigned char* st = lds + cb3 * STG; cb3 = (cb3 == NSTG - 1) ? 0 : cb3 + 1;
            if (DRY == 2) { if (ns < total) FG_STAGE(); continue; }
            bf16x8 Af[8], Bf[4];
            f32x2 vb[2][8];
#pragma unroll
            for (int p2 = 0; p2 < 2; ++p2) { const LAS float* bp = (const LAS float*)(st + bfo) + p2 * 32;
#pragma unroll
                for (int j = 0; j < 8; ++j) vb[p2][j] = *(const LAS f32x2*)(bp + j * 256); }
#pragma unroll
            for (int m = 0; m < 8; ++m) Af[m] = *(const LAS bf16x8*)(st + aoff + m * 1024);
            if (ns < total) FG_STAGE();
#pragma unroll
            for (int p2 = 0; p2 < 2; ++p2) { const f32x2* v = vb[p2];
                u32x4 w0, w1; w0.x = pk2(v[0].x, v[1].x); w0.y = pk2(v[2].x, v[3].x); w0.z = pk2(v[4].x, v[5].x); w0.w = pk2(v[6].x, v[7].x);
                w1.x = pk2(v[0].y, v[1].y); w1.y = pk2(v[2].y, v[3].y); w1.z = pk2(v[4].y, v[5].y); w1.w = pk2(v[6].y, v[7].y);
                Bf[2 * p2] = __builtin_bit_cast(bf16x8, w0); Bf[2 * p2 + 1] = __builtin_bit_cast(bf16x8, w1); }
            if (DRY == 1) {
#pragma unroll
                for (int m = 0; m < 8; ++m) asm volatile("" :: "v"(Af[m]));
#pragma unroll
                for (int n = 0; n < 4; ++n) asm volatile("" :: "v"(Bf[n]));
                continue; }
            __builtin_amdgcn_s_setprio(1);
#pragma unroll
            for (int m = 0; m < 8; ++m)
#pragma unroll
                for (int n = 0; n < 4; ++n) acc[m][n] = __builtin_amdgcn_mfma_f32_16x16x32_bf16(Bf[n], Af[m], acc[m][n], 0, 0, 0);
            __builtin_amdgcn_s_setprio(0);
        }
        if (DRY == 0) {
            const int ct = tb.utab[3 * u + 2];
#pragma unroll
            for (int m = 0; m < 8; ++m) { const int ri = u * 256 + wr * 128 + m * 16 + fr; const int pair = tb.ptab[ri];
                if (pair >= 0) {
                    if (MODE == 0) { const float cb = tb.ctab[ri]; bf16* rowp = Out + (size_t)pair * 512 + ct * 128 + wc * 32 + 8 * fq;
                        const f32x4 g0 = acc[m][0], g1 = acc[m][1], u0 = acc[m][2], u1 = acc[m][3]; u32x4 w;
                        w.x = pk2(siluf_(g0[0]) * u0[0] * cb, siluf_(g1[0]) * u1[0] * cb); w.y = pk2(siluf_(g0[1]) * u0[1] * cb, siluf_(g1[1]) * u1[1] * cb);
                        w.z = pk2(siluf_(g0[2]) * u0[2] * cb, siluf_(g1[2]) * u1[2] * cb); w.w = pk2(siluf_(g0[3]) * u0[3] * cb, siluf_(g1[3]) * u1[3] * cb);
                        *(u32x4*)rowp = w; }
                    else { bf16* rowp = Out + (size_t)pair * D + ct * 256 + wc * 64 + 8 * fq;
#pragma unroll
                        for (int p2 = 0; p2 < 2; ++p2) { const f32x4 a = acc[m][2 * p2], b = acc[m][2 * p2 + 1]; u32x4 w;
                            w.x = pk2(a[0], b[0]); w.y = pk2(a[1], b[1]); w.z = pk2(a[2], b[2]); w.w = pk2(a[3], b[3]); *(u32x4*)(rowp + 32 * p2) = w; } } } }
#pragma unroll
            for (int m = 0; m < 8; ++m)
#pragma unroll
                for (int n = 0; n < 4; ++n) acc[m][n] = (f32x4){0.f, 0.f, 0.f, 0.f};
        }
    }
    asm volatile("s_waitcnt vmcnt(0)" ::: "memory");
    __syncthreads();
#undef FG_LOAD_UNIT
#undef FG_STAGE
#undef FG_BSRC
}
}

__device__ __forceinline__ void tr_item(const float* W, int ld, int K, int N, int col0, bf16* WT, int mode, int row_off, int item, int lane, const float* gk = nullptr) {
    const int nblk = N / 64, kb = item / nblk, nb = item - kb * nblk, k0 = 32 * kb, n0 = 64 * nb;
    const int kg = lane >> 4, c4 = lane & 15;
    const float* src = W + (size_t)(k0 + 8 * kg) * ld + col0 + n0 + 4 * c4;
    f32x4 v[8];
#pragma unroll
    for (int q = 0; q < 8; ++q) v[q] = *(const f32x4*)(src + (size_t)q * ld);
    if (gk) {
#pragma unroll
        for (int q = 0; q < 8; ++q) v[q] = v[q] * gk[k0 + 8 * kg + q]; }
#pragma unroll
    for (int i = 0; i < 4; ++i) { const int n = n0 + 4 * c4 + i; const int row = mode ? (32 * (n >> 4) + (n & 15) + row_off) : (n + row_off);
        u32x4 o; o.x = pk2(v[0][i], v[1][i]); o.y = pk2(v[2][i], v[3][i]); o.z = pk2(v[4][i], v[5][i]); o.w = pk2(v[6][i], v[7][i]);
        *(u32x4*)(WT + (size_t)row * K + k0 + 8 * kg) = o; }
}
__device__ __forceinline__ void wcomb_item(const float* win, const float* wg, bf16* WT, int item, int lane, const float* gk) {
    const int jb = item & 7, kb = item >> 3, j = jb * 64 + lane, k0 = kb * 8;
    float g[16];
#pragma unroll
    for (int r = 0; r < 16; ++r) g[r] = wg[r * 512 + j];
    float o[8];
#pragma unroll
    for (int q = 0; q < 8; ++q) { const float* wr_ = win + (size_t)(k0 + q) * EV_IN + 5120; float s = 0.f;
#pragma unroll
        for (int r = 0; r < 16; ++r) s += wr_[r] * g[r];
        o[q] = s * gk[k0 + q]; }
    u32x4 w; w.x = pk2(o[0], o[1]); w.y = pk2(o[2], o[3]); w.z = pk2(o[4], o[5]); w.w = pk2(o[6], o[7]);
    *(u32x4*)(WT + (size_t)(5120 + j) * D + k0) = w;
}
template <bool SRC_BF16, bool ADDY, bool WRITE_RES, int OUT>
__device__ __forceinline__ void norm_row(const void* src, const bf16* y0, const bf16* y1, bf16* res, const float* g, bf16* xn, float* of32, float* rs_out, int lane) {
    f32x4 va[4], vb[4]; float ss = 0.f;
#pragma unroll
    for (int j = 0; j < 4; ++j) { const int col = 8 * lane + 512 * j;
        if (SRC_BF16) { const u32x4 w = *(const u32x4*)((const bf16*)src + col); va[j] = up4((u32x2){w.x, w.y}); vb[j] = up4((u32x2){w.z, w.w}); }
        else { va[j] = *(const f32x4*)((const float*)src + col); vb[j] = *(const f32x4*)((const float*)src + col + 4); }
        if (ADDY) { const u32x4 a = *(const u32x4*)(y0 + col), b = *(const u32x4*)(y1 + col);
            va[j] = va[j] + up4((u32x2){a.x, a.y}) + up4((u32x2){b.x, b.y}); vb[j] = vb[j] + up4((u32x2){a.z, a.w}) + up4((u32x2){b.z, b.w}); }
        if (WRITE_RES) { const u32x2 wl = dn4(va[j]), wh = dn4(vb[j]); *(u32x4*)(res + col) = (u32x4){wl.x, wl.y, wh.x, wh.y}; va[j] = up4(wl); vb[j] = up4(wh); }
        ss += ((va[j][0] * va[j][0] + va[j][1] * va[j][1]) + (va[j][2] * va[j][2] + va[j][3] * va[j][3])) + ((vb[j][0] * vb[j][0] + vb[j][1] * vb[j][1]) + (vb[j][2] * vb[j][2] + vb[j][3] * vb[j][3])); }
    const float rs = rsqrtf(wave_sum(ss) * (1.0f / D) + EPS);
    if (rs_out && lane == 0) *rs_out = rs;
    if (OUT != 0) {
#pragma unroll
        for (int j = 0; j < 4; ++j) { const int col = 8 * lane + 512 * j; const f32x4 oa = va[j] * rs * *(const f32x4*)(g + col), ob = vb[j] * rs * *(const f32x4*)(g + col + 4);
            if (OUT == 1) { const u32x2 wl = dn4(oa), wh = dn4(ob); *(u32x4*)(xn + col) = (u32x4){wl.x, wl.y, wh.x, wh.y}; } else { *(f32x4*)(of32 + col) = oa; *(f32x4*)(of32 + col + 4) = ob; } } }
}

__device__ __forceinline__ void p0_prologue(Frame& F, KArgs& A) {
    const int gw = F.vcu * NWAVES + F.wave, NGW = F.G * NWAVES, lane = F.lane;
    unsigned char* ws = F.ws;
    constexpr int I_WIN = (D / 32) * (5120 / 64);
    constexpr int I_WC = (D / 8) * 8;
    constexpr int I_WOUT = (D / 32) * (D / 64);
    constexpr int I_ODW = (D / 32) * (1024 / 64);
    constexpr int I_GLU = (1024 / 32) * (2048 / 64);
    constexpr int I_PLEG = I_WOUT;
    constexpr int I_PLEP = (256 / 32) * (D / 64);
    constexpr int I_W1 = (D / 32) * (512 / 64);
    constexpr int I_W2 = (512 / 32) * (D / 64);
    constexpr int N_DENSE = 2 * (I_WIN + I_WC + I_WOUT + I_ODW + 2 * I_GLU) + 4 * (I_PLEG + I_PLEP);
    for (int it = gw; it < N_DENSE; it += NGW) {
        int r = it;
        if (r < 2 * I_WIN) { const int e = r / I_WIN; tr_item(A.in[6] + (size_t)e * D * EV_IN, EV_IN, D, 5120, 0, (bf16*)(ws + WS_WIN + e * SZ_WIN), 0, 0, r % I_WIN, lane, A.in[2] + (size_t)(2 * e) * D); continue; } r -= 2 * I_WIN;
        if (r < 2 * I_WC) { const int e = r / I_WC; wcomb_item(A.in[6] + (size_t)e * D * EV_IN, A.in[14] + (size_t)e * 16 * 512, (bf16*)(ws + WS_WIN + e * SZ_WIN), r % I_WC, lane, A.in[2] + (size_t)(2 * e) * D); continue; } r -= 2 * I_WC;
        if (r < 2 * I_WOUT) { const int e = r / I_WOUT; tr_item(A.in[17] + (size_t)e * D * D, D, D, D, 0, (bf16*)(ws + WS_WOUT + e * SZ_DD), 0, 0, r % I_WOUT, lane); continue; } r -= 2 * I_WOUT;
        if (r < 2 * I_ODW) { const int o = r / I_ODW; tr_item(A.in[18] + (size_t)o * D * 1024, 1024, D, 1024, 0, (bf16*)(ws + WS_ODWIN + o * SZ_ODWIN), 0, 0, r % I_ODW, lane, A.in[2] + (size_t)(2 * o + 1) * D); continue; } r -= 2 * I_ODW;
        if (r < 4 * I_GLU) { const int o = r / (2 * I_GLU), hf = (r / I_GLU) & 1; tr_item(A.in[27] + (size_t)o * 1024 * 4096, 4096, 1024, 2048, hf * 2048, (bf16*)(ws + WS_WGLU + o * SZ_WGLU), 1, hf * 16, r % I_GLU, lane); continue; } r -= 4 * I_GLU;
        if (r < 4 * I_PLEG) { const int l = r / I_PLEG; tr_item(A.in[35] + (size_t)l * D * D, D, D, D, 0, (bf16*)(ws + WS_PLEG + l * SZ_DD), 0, 0, r % I_PLEG, lane, A.in[4] + (size_t)l * D); continue; } r -= 4 * I_PLEG;
        { const int l = r / I_PLEP; tr_item(A.in[37] + (size_t)l * 256 * D, D, 256, D, 0, (bf16*)(ws + WS_PLEP + l * SZ_PLEP), 0, 0, r % I_PLEP, lane); }
    }
    for (int i = gw * 64 + lane; i < 4 * 16 * 4 * 48 * 40; i += NGW * 64) {
        const int k = i % 40, o = (i / 40) % 48, q = (i / (40 * 48)) & 3, t = (i / (40 * 48 * 4)) & 15, l = i / (40 * 48 * 64);
        unsigned hb = 0u, lb = 0u;
        if (o < 36 && k < 32) { const int kk = 512 * q + 32 * t + k;
            const float wv = o < 4 ? A.in[28][((size_t)l * D + kk) * 4 + o] : A.in[30][((size_t)l * D + kk) * 32 + (o - 4)];
            const float wf = wv * A.in[3][(size_t)l * D + kk]; hb = f2bf(wf); lb = f2bf(wf - bf2f(hb)); }
        bf16* img = (bf16*)(ws + WS_RTW) + (size_t)(l * 16 + t) * RTW_IMG + (q * 48 + o) * 40 + k;
        img[0] = (bf16)hb; img[4 * 48 * 40] = (bf16)lb;
    }
    { const float* p = A.in[1]; bf16* pb = (bf16*)(ws + WS_PB); const size_t n8 = (size_t)4 * T * 256 / 8;
        for (size_t i = (size_t)gw * 64 + lane; i < n8; i += (size_t)NGW * 64) { const f32x4 a = *(const f32x4*)(p + i * 8), b = *(const f32x4*)(p + i * 8 + 4);
            u32x4 w; w.x = pk2(a[0], a[1]); w.y = pk2(a[2], a[3]); w.z = pk2(b[0], b[1]); w.w = pk2(b[2], b[3]); *(u32x4*)(pb + i * 8) = w; } }
    for (int m = gw; m < T; m += NGW)
        norm_row<false, false, true, 0>(A.in[0] + (size_t)m * D, nullptr, nullptr, (bf16*)(ws + WS_XRES) + (size_t)m * D, nullptr, nullptr, nullptr, (float*)(ws + WS_RS) + m, lane);
}

__device__ __forceinline__ void lru_unit(Frame& F, KArgs& A, int e, int unit) {
    const int tid = F.tid, lane = F.lane, w = F.wave, b = unit >> 6, h = (unit >> 2) & 15, jq = unit & 3, n16 = lane & 15, kq = lane >> 4;
    LAS bf16* ZT = (LAS bf16*)F.lds;
    LAS bf16* XCB = ZT + 259 * 72;
    LAS float* aa = (LAS float*)(XCB + 256 * 72);
    LAS float* uu = aa + 4096;
    LAS bf16* GT = (LAS bf16*)(uu + 4096);
    LAS bf16* YT = GT + 4096;
    LAS float* sA = (LAS float*)(YT + 4096);
    LAS float* sH = sA + 512;
    LAS float* cin = sH + 512;
    LAS float* carry = cin + 512;
    LAS float* cw = carry + 16;
    const bf16* z = (const bf16*)(F.ws + WS_Z);
    bf16* ycat = (bf16*)(F.ws + WS_YCAT);
    float cwr[5][8];
    { const int c8 = tid & 7;
#pragma unroll
        for (int k = 0; k < 4; ++k) { const float* src = A.in[7] + ((size_t)e * 4 + k) * 1024 + h * 64 + c8 * 8; const f32x4 a = *(const f32x4*)src, b4 = *(const f32x4*)(src + 4);
            cwr[k][0] = a[0]; cwr[k][1] = a[1]; cwr[k][2] = a[2]; cwr[k][3] = a[3]; cwr[k][4] = b4[0]; cwr[k][5] = b4[1]; cwr[k][6] = b4[2]; cwr[k][7] = b4[3]; }
        const float* sb = A.in[8] + (size_t)e * 1024 + h * 64 + c8 * 8; const f32x4 a = *(const f32x4*)sb, b4 = *(const f32x4*)(sb + 4);
        cwr[4][0] = a[0]; cwr[4][1] = a[1]; cwr[4][2] = a[2]; cwr[4][3] = a[3]; cwr[4][4] = b4[0]; cwr[4][5] = b4[1]; cwr[4][6] = b4[2]; cwr[4][7] = b4[3]; }
    bf16x8 WAf[2], WXf[2];
    { const float* w_a = A.in[9] + ((size_t)(e * 16 + h) * 64) * 64 + jq * 16 + n16; const float* w_x = A.in[11] + ((size_t)(e * 16 + h) * 64) * 64 + jq * 16 + n16;
#pragma unroll
        for (int ks = 0; ks < 2; ++ks) { float va[8], vx[8];
#pragma unroll
            for (int j = 0; j < 8; ++j) { va[j] = w_a[(size_t)(32 * ks + 8 * kq + j) * 64]; vx[j] = w_x[(size_t)(32 * ks + 8 * kq + j) * 64]; }
            WAf[ks] = __builtin_bit_cast(bf16x8, (u32x4){pk2(va[0], va[1]), pk2(va[2], va[3]), pk2(va[4], va[5]), pk2(va[6], va[7])});
            WXf[ks] = __builtin_bit_cast(bf16x8, (u32x4){pk2(vx[0], vx[1]), pk2(vx[2], vx[3]), pk2(vx[4], vx[5]), pk2(vx[6], vx[7])}); } }
    float ba[4], bx[4], sp[4];
#pragma unroll
    for (int r = 0; r < 4; ++r) { const int ch = h * 64 + jq * 16 + 4 * kq + r; ba[r] = A.in[10][e * 1024 + ch]; bx[r] = A.in[12][e * 1024 + ch]; sp[r] = -8.0f * softplusf_(-A.in[13][e * 1024 + ch]); }
    u32x4 pz[4], pg;
#define LRU_PREFETCH(s0_) do { _Pragma("unroll") for (int r_ = 0; r_ < 4; ++r_) { const int piece = r_ * 512 + tid; pz[r_] = *(const u32x4*)(z + (size_t)(b * SEQ + (s0_) + (piece >> 3)) * ZW + h * 64 + (piece & 7) * 8); } \
        pg = *(const u32x4*)(z + (size_t)(b * SEQ + (s0_) + (tid >> 1)) * ZW + 1024 + h * 64 + jq * 16 + (tid & 1) * 8); } while (0)
    LRU_PREFETCH(0);
    const int tl = tid >> 1, half = tid & 1;
#pragma unroll 1
    for (int tb = 0; tb < 8; ++tb) {
        const int s0 = tb * 256;
        u32x4 halo = (u32x4){0u, 0u, 0u, 0u};
        if (tb > 0 && tid < 24) halo = *(const LAS u32x4*)(ZT + (256 + (tid >> 3)) * 72 + (tid & 7) * 8);
        LDS_BARRIER();
        if (tid < 24) *(LAS u32x4*)(ZT + (tid >> 3) * 72 + (tid & 7) * 8) = halo;
#pragma unroll
        for (int r = 0; r < 4; ++r) { const int piece = r * 512 + tid; *(LAS u32x4*)(ZT + (3 + (piece >> 3)) * 72 + (piece & 7) * 8) = pz[r]; }
        *(LAS u32x4*)(GT + (tid >> 1) * 16 + (tid & 1) * 8) = pg;
        if (tb < 7) LRU_PREFETCH(s0 + 256);
        LDS_BARRIER();
        { const int tg4 = tid >> 3, c8 = tid & 7; float xr[7][8];
#pragma unroll
            for (int r = 0; r < 7; ++r) { const u32x4 wv = *(const LAS u32x4*)(ZT + (4 * tg4 + r) * 72 + c8 * 8);
                xr[r][0] = lo16(wv.x); xr[r][1] = hi16(wv.x); xr[r][2] = lo16(wv.y); xr[r][3] = hi16(wv.y); xr[r][4] = lo16(wv.z); xr[r][5] = hi16(wv.z); xr[r][6] = lo16(wv.w); xr[r][7] = hi16(wv.w); }
#pragma unroll
            for (int i = 0; i < 4; ++i) { float accv[8];
#pragma unroll
                for (int q = 0; q < 8; ++q) { accv[q] = cwr[4][q];
#pragma unroll
                    for (int k = 0; k < 4; ++k) accv[q] += cwr[k][q] * xr[i + k][q]; }
                *(LAS u32x4*)(XCB + (4 * tg4 + i) * 72 + c8 * 8) = (u32x4){pk2(accv[0], accv[1]), pk2(accv[2], accv[3]), pk2(accv[4], accv[5]), pk2(accv[6], accv[7])}; } }
        LDS_BARRIER();
#pragma unroll
        for (int tt2 = 0; tt2 < 2; ++tt2) { const int tok = (2 * w + tt2) * 16 + n16; f32x4 da = (f32x4){0.f, 0.f, 0.f, 0.f}, dx = da;
#pragma unroll
            for (int ks = 0; ks < 2; ++ks) { const bf16x8 xf = *(const LAS bf16x8*)(XCB + tok * 72 + 32 * ks + 8 * kq);
                da = __builtin_amdgcn_mfma_f32_16x16x32_bf16(WAf[ks], xf, da, 0, 0, 0); dx = __builtin_amdgcn_mfma_f32_16x16x32_bf16(WXf[ks], xf, dx, 0, 0, 0); }
            const u32x2 xw = *(const LAS u32x2*)(XCB + tok * 72 + jq * 16 + 4 * kq); const float xo[4] = {lo16(xw.x), hi16(xw.x), lo16(xw.y), hi16(xw.y)};
            f32x4 av, uv;
#pragma unroll
            for (int r = 0; r < 4; ++r) { const float rg = sigmoidf_(da[r] + ba[r]), ig = sigmoidf_(dx[r] + bx[r]); const float la = rg * sp[r];
                av[r] = __expf(la); uv[r] = __builtin_amdgcn_sqrtf(fmaxf(one_minus_exp(2.0f * la), 0.f)) * ig * xo[r]; }
            *(LAS f32x4*)(aa + tok * 16 + 4 * kq) = av; *(LAS f32x4*)(uu + tok * 16 + 4 * kq) = uv; }
        LDS_BARRIER();
        const int ch = tid & 15, seg = tid >> 4;
        { float Ac = 1.f, Hh = 0.f;
#pragma unroll
            for (int q = 0; q < 8; ++q) { const float a = aa[(seg * 8 + q) * 16 + ch], u = uu[(seg * 8 + q) * 16 + ch]; Hh = a * Hh + u; Ac *= a; }
            sA[seg * 16 + ch] = Ac; sH[seg * 16 + ch] = Hh; }
        LDS_BARRIER();
        if (tid < 16) { float c = (tb == 0) ? 0.f : carry[tid];
#pragma unroll 4
            for (int sg = 0; sg < 32; ++sg) { cin[sg * 16 + tid] = c; c = sA[sg * 16 + tid] * c + sH[sg * 16 + tid]; }
            carry[tid] = c; }
        LDS_BARRIER();
        { float hh = cin[seg * 16 + ch];
#pragma unroll
            for (int q = 0; q < 8; ++q) { const int tq = seg * 8 + q; hh = aa[tq * 16 + ch] * hh + uu[tq * 16 + ch];
                YT[tq * 16 + ch] = (bf16)f2bf(hh * gelu_tanh(bf2f(GT[tq * 16 + ch]))); } }
        LDS_BARRIER();
        *(u32x4*)(ycat + (size_t)(b * SEQ + s0 + (tid >> 1)) * D + h * 64 + jq * 16 + (tid & 1) * 8) = *(const LAS u32x4*)(YT + (tid >> 1) * 16 + (tid & 1) * 8);
    }
#undef LRU_PREFETCH
    LDS_BARRIER();
}

__device__ __forceinline__ void gla_bcum(Frame& F, KArgs& A, int e, int h, size_t t0, LAS float* buf, int stride, LAS float* bl, LAS float* seg4) {
    const int tid = F.tid; const bf16* z = (const bf16*)(F.ws + WS_Z);
    { const int t = tid >> 3, d0 = (tid & 7) * 16; const bf16* zr = z + (t0 + t) * ZW + 5120 + h * 128 + d0; const float* bg = A.in[15] + e * 512 + h * 128 + d0;
#pragma unroll
        for (int c8 = 0; c8 < 2; ++c8) { const u32x4 w = *(const u32x4*)(zr + c8 * 8); LAS float* o = buf + t * stride + d0 + c8 * 8; const float* bb = bg + c8 * 8;
            o[0] = logsigmoidf_(lo16(w.x) + bb[0]) * 0.0625f; o[1] = logsigmoidf_(hi16(w.x) + bb[1]) * 0.0625f; o[2] = logsigmoidf_(lo16(w.y) + bb[2]) * 0.0625f; o[3] = logsigmoidf_(hi16(w.y) + bb[3]) * 0.0625f;
            o[4] = logsigmoidf_(lo16(w.z) + bb[4]) * 0.0625f; o[5] = logsigmoidf_(hi16(w.z) + bb[5]) * 0.0625f; o[6] = logsigmoidf_(lo16(w.w) + bb[6]) * 0.0625f; o[7] = logsigmoidf_(hi16(w.w) + bb[7]) * 0.0625f; } }
    __syncthreads();
    const int d = tid & 127, sg = tid >> 7; float v[16];
    { float run = 0.f;
#pragma unroll
        for (int j = 0; j < 16; ++j) { run += buf[(sg * 16 + j) * stride + d]; v[j] = run; }
        seg4[sg * 128 + d] = run; }
    __syncthreads();
    { float off = 0.f;
#pragma unroll
        for (int q = 0; q < 3; ++q) off += (q < sg) ? seg4[q * 128 + d] : 0.f;
#pragma unroll
        for (int j = 0; j < 16; ++j) buf[(sg * 16 + j) * stride + d] = v[j] + off;
        if (sg == 3) bl[d] = v[15] + off; }
    __syncthreads();
}
typedef short s16x4 __attribute__((ext_vector_type(4)));
__device__ __forceinline__ bf16x8 tr_frag(const LAS bf16* tile, int rs  , int row0, int col0, int lane) {
    const int g = lane >> 4, q = (lane & 15) >> 2, p = lane & 3;
    const LAS bf16* a0 = tile + (row0 + 8 * g + q) * rs + col0 + 4 * p;
    const s16x4 lo = __builtin_amdgcn_ds_read_tr16_b64_v4i16((LAS s16x4*)a0), hi = __builtin_amdgcn_ds_read_tr16_b64_v4i16((LAS s16x4*)(a0 + 4 * rs));
    return (bf16x8){lo[0], lo[1], lo[2], lo[3], hi[0], hi[1], hi[2], hi[3]};
}
__device__ __forceinline__ void gla_ds_unit(Frame& F, KArgs& A, int e, int unit) {
    const int tid = F.tid, lane = F.lane, w = F.wave, b = unit >> 7, h = (unit >> 5) & 3, c = unit & 31, bh = b * 4 + h; const size_t t0 = (size_t)b * SEQ + c * 64;
    const int n16 = lane & 15, kq = lane >> 4;
    LAS float* BC = (LAS float*)F.lds;
    LAS bf16* KE = (LAS bf16*)(F.lds + 33792);
    LAS bf16* VT = KE + 64 * 136;
    LAS float* BL = (LAS float*)(VT + 64 * 272);
    LAS float* SEG = BL + 128;
    const bf16* z = (const bf16*)(F.ws + WS_Z);
    gla_bcum(F, A, e, h, t0, BC, 132, BL, SEG);
    { const int t = tid >> 3, d0 = (tid & 7) * 16; const bf16* zr = z + (t0 + t) * ZW + 2560 + h * 128 + d0;
#pragma unroll
        for (int c8 = 0; c8 < 2; ++c8) { const u32x4 kw = *(const u32x4*)(zr + c8 * 8); const LAS float* bc = BC + t * 132 + d0 + c8 * 8; const LAS float* bl = BL + d0 + c8 * 8;
            const float kv[8] = {lo16(kw.x), hi16(kw.x), lo16(kw.y), hi16(kw.y), lo16(kw.z), hi16(kw.z), lo16(kw.w), hi16(kw.w)}; float ko[8];
#pragma unroll
            for (int j = 0; j < 8; ++j) ko[j] = kv[j] * __expf(bl[j] - bc[j]);
            *(LAS u32x4*)(KE + t * 136 + d0 + c8 * 8) = (u32x4){pk2(ko[0], ko[1]), pk2(ko[2], ko[3]), pk2(ko[4], ko[5]), pk2(ko[6], ko[7])}; }
        const int v0 = (tid & 7) * 32; const bf16* vr = z + (t0 + t) * ZW + 3072 + h * 256 + v0;
#pragma unroll
        for (int c8 = 0; c8 < 4; ++c8) *(LAS u32x4*)(VT + t * 272 + v0 + c8 * 8) = *(const u32x4*)(vr + c8 * 8); }
    if (tid < 128) ((float*)(F.ws + WS_DECAY))[(size_t)(bh * 32 + c) * 128 + tid] = __expf(BL[tid]);
    __syncthreads();
    f32x4 acc[2][8];
#pragma unroll
    for (int vb = 0; vb < 2; ++vb)
#pragma unroll
        for (int db = 0; db < 8; ++db) acc[vb][db] = (f32x4){0.f, 0.f, 0.f, 0.f};
#pragma unroll
    for (int ks = 0; ks < 2; ++ks) { bf16x8 af[2];
#pragma unroll
        for (int vb = 0; vb < 2; ++vb) af[vb] = tr_frag(VT, 272, 32 * ks, (2 * w + vb) * 16, lane);
#pragma unroll
        for (int db = 0; db < 8; ++db) { const bf16x8 bfr = tr_frag(KE, 136, 32 * ks, db * 16, lane);
#pragma unroll
            for (int vb = 0; vb < 2; ++vb) acc[vb][db] = __builtin_amdgcn_mfma_f32_16x16x32_bf16(af[vb], bfr, acc[vb][db], 0, 0, 0); } }
    bf16* ds = (bf16*)(F.ws + WS_DS) + (size_t)(bh * 32 + c) * 128 * 256;
#pragma unroll
    for (int db = 0; db < 8; ++db)
#pragma unroll
        for (int vb = 0; vb < 2; ++vb) *(u32x2*)(ds + (size_t)(db * 16 + n16) * 256 + (2 * w + vb) * 16 + 4 * kq) = dn4(acc[vb][db]);
    LDS_BARRIER();
}
__device__ __forceinline__ void gla_state_phase(Frame& F) {
    const bf16* ds = (const bf16*)(F.ws + WS_DS); bf16* sp = (bf16*)(F.ws + WS_SPREV); const float* dec = (const float*)(F.ws + WS_DECAY);
    for (int it = F.vcu * NTHR + F.tid; it < 16 * 128 * 64; it += F.G * NTHR) {
        const int bh = it >> 13, d = (it >> 6) & 127, v4 = it & 63; f32x4 st = (f32x4){0.f, 0.f, 0.f, 0.f};
#pragma unroll 1
        for (int c0 = 0; c0 < 32; c0 += 8) { f32x4 dv[8]; float dc[8];
#pragma unroll
            for (int j = 0; j < 8; ++j) { const size_t idx = ((size_t)(bh * 32 + c0 + j) * 128 + d) * 256 + v4 * 4; dv[j] = up4(*(const u32x2*)(ds + idx)); dc[j] = dec[(size_t)(bh * 32 + c0 + j) * 128 + d]; }
#pragma unroll
            for (int j = 0; j < 8; ++j) { const size_t idx = ((size_t)(bh * 32 + c0 + j) * 128 + d) * 256 + v4 * 4; u32x2 w; w.x = pk2(st[0], st[1]); w.y = pk2(st[2], st[3]); *(u32x2*)(sp + idx) = w; st = st * dc[j] + dv[j]; } }
    }
}
__device__ __forceinline__ void gla_out_unit(Frame& F, KArgs& A, int e, int unit) {
    const int tid = F.tid, lane = F.lane, w = F.wave, b = unit >> 7, h = (unit >> 5) & 3, c = unit & 31, bh = b * 4 + h; const size_t t0 = (size_t)b * SEQ + c * 64;
    const int n16 = lane & 15, kq = lane >> 4;
    LAS float* BC = (LAS float*)F.lds;
    LAS bf16* ATT = (LAS bf16*)F.lds;
    LAS bf16* QS = (LAS bf16*)(F.lds + 33792);
    LAS bf16* KS = QS + 64 * 136;
    LAS bf16* VT = KS + 64 * 136;
    LAS bf16* SB = VT + 64 * 272;
    LAS float* RSS = (LAS float*)(SB + 64 * 272);
    LAS float* BL = RSS + 512;
    LAS float* SEG = BL + 128;
    const bf16* z = (const bf16*)(F.ws + WS_Z);
    const bf16* spg = (const bf16*)(F.ws + WS_SPREV) + (size_t)(bh * 32 + c) * 128 * 256;
    gla_bcum(F, A, e, h, t0, BC, 132, BL, SEG);
    u32x4 sb2[4];
    { const int t = tid >> 3, d0 = (tid & 7) * 16; const bf16* qr = z + (t0 + t) * ZW + 2048 + h * 128 + d0; const bf16* kr = z + (t0 + t) * ZW + 2560 + h * 128 + d0;
#pragma unroll
        for (int c8 = 0; c8 < 2; ++c8) { const u32x4 qw = *(const u32x4*)(qr + c8 * 8), kw = *(const u32x4*)(kr + c8 * 8); const LAS float* bc = BC + t * 132 + d0 + c8 * 8;
            const float qv[8] = {lo16(qw.x), hi16(qw.x), lo16(qw.y), hi16(qw.y), lo16(qw.z), hi16(qw.z), lo16(qw.w), hi16(qw.w)};
            const float kv[8] = {lo16(kw.x), hi16(kw.x), lo16(kw.y), hi16(kw.y), lo16(kw.z), hi16(kw.z), lo16(kw.w), hi16(kw.w)};
            float qo[8], ko[8];
#pragma unroll
            for (int j = 0; j < 8; ++j) { const float bcv = bc[j]; qo[j] = qv[j] * 0.08838834764831845f * __expf(bcv); ko[j] = kv[j] * __expf(-bcv); }
            *(LAS u32x4*)(QS + t * 136 + d0 + c8 * 8) = (u32x4){pk2(qo[0], qo[1]), pk2(qo[2], qo[3]), pk2(qo[4], qo[5]), pk2(qo[6], qo[7])};
            *(LAS u32x4*)(KS + t * 136 + d0 + c8 * 8) = (u32x4){pk2(ko[0], ko[1]), pk2(ko[2], ko[3]), pk2(ko[4], ko[5]), pk2(ko[6], ko[7])}; }
        const int v0 = (tid & 7) * 32; const bf16* vr = z + (t0 + t) * ZW + 3072 + h * 256 + v0; const bf16* sr = spg + (size_t)t * 256 + v0;
#pragma unroll
        for (int c8 = 0; c8 < 4; ++c8) { *(LAS u32x4*)(VT + t * 272 + v0 + c8 * 8) = *(const u32x4*)(vr + c8 * 8); *(LAS u32x4*)(SB + t * 272 + v0 + c8 * 8) = *(const u32x4*)(sr + c8 * 8); }
#pragma unroll
        for (int c8 = 0; c8 < 4; ++c8) sb2[c8] = *(const u32x4*)(sr + (size_t)64 * 256 + c8 * 8); }
    LDS_BARRIER();
    { const int ib = w >> 1;
#pragma unroll
        for (int jj = 0; jj < 2; ++jj) { const int jb = (w & 1) * 2 + jj; f32x4 d = (f32x4){0.f, 0.f, 0.f, 0.f};
            if (jb <= ib) {
#pragma unroll
                for (int ks = 0; ks < 4; ++ks) { const bf16x8 kf = *(const LAS bf16x8*)(KS + (16 * jb + n16) * 136 + 32 * ks + 8 * kq), qf = *(const LAS bf16x8*)(QS + (16 * ib + n16) * 136 + 32 * ks + 8 * kq);
                    d = __builtin_amdgcn_mfma_f32_16x16x32_bf16(kf, qf, d, 0, 0, 0); }
#pragma unroll
                for (int r = 0; r < 4; ++r) if (16 * jb + 4 * kq + r > 16 * ib + n16) d[r] = 0.f; }
            *(LAS u32x2*)(ATT + (16 * ib + n16) * 72 + 16 * jb + 4 * kq) = (u32x2){pk2(d[0], d[1]), pk2(d[2], d[3])}; } }
    __syncthreads();
    f32x4 acc[2][4];
#pragma unroll
    for (int vb = 0; vb < 2; ++vb)
#pragma unroll
        for (int ib = 0; ib < 4; ++ib) acc[vb][ib] = (f32x4){0.f, 0.f, 0.f, 0.f};
#pragma unroll
    for (int ks = 0; ks < 2; ++ks) { bf16x8 af[2];
#pragma unroll
        for (int vb = 0; vb < 2; ++vb) af[vb] = tr_frag(VT, 272, 32 * ks, (2 * w + vb) * 16, lane);
#pragma unroll
        for (int ib = 0; ib < 4; ++ib) if (32 * ks <= 16 * ib + 15) { const bf16x8 bfr = *(const LAS bf16x8*)(ATT + (16 * ib + n16) * 72 + 32 * ks + 8 * kq);
#pragma unroll
            for (int vb = 0; vb < 2; ++vb) acc[vb][ib] = __builtin_amdgcn_mfma_f32_16x16x32_bf16(af[vb], bfr, acc[vb][ib], 0, 0, 0); } }
#pragma unroll
    for (int half = 0; half < 2; ++half) {
        if (half == 1) { LDS_BARRIER();
            const int t = tid >> 3, v0 = (tid & 7) * 32;
#pragma unroll
            for (int c8 = 0; c8 < 4; ++c8) *(LAS u32x4*)(SB + t * 272 + v0 + c8 * 8) = sb2[c8];
            LDS_BARRIER(); }
#pragma unroll
        for (int ks = 0; ks < 2; ++ks) { bf16x8 af[2];
#pragma unroll
            for (int vb = 0; vb < 2; ++vb) af[vb] = tr_frag(SB, 272, 32 * ks, (2 * w + vb) * 16, lane);
#pragma unroll
            for (int ib = 0; ib < 4; ++ib) { const bf16x8 bfr = *(const LAS bf16x8*)(QS + (16 * ib + n16) * 136 + 64 * half + 32 * ks + 8 * kq);
#pragma unroll
                for (int vb = 0; vb < 2; ++vb) acc[vb][ib] = __builtin_amdgcn_mfma_f32_16x16x32_bf16(af[vb], bfr, acc[vb][ib], 0, 0, 0); } } }
#pragma unroll
    for (int ib = 0; ib < 4; ++ib) { float ss = 0.f;
#pragma unroll
        for (int vb = 0; vb < 2; ++vb)
#pragma unroll
            for (int r = 0; r < 4; ++r) ss += acc[vb][ib][r] * acc[vb][ib][r];
        ss += shx(ss, 16, lane); ss += shx(ss, 32, lane);
        if (kq == 0) RSS[w * 64 + 16 * ib + n16] = ss; }
    u32x2 gwv[4][2]; f32x4 hnv[2];
#pragma unroll
    for (int vb = 0; vb < 2; ++vb) { const int v = (2 * w + vb) * 16 + 4 * kq; hnv[vb] = *(const f32x4*)(A.in[16] + e * 1024 + h * 256 + v);
#pragma unroll
        for (int ib = 0; ib < 4; ++ib) gwv[ib][vb] = *(const u32x2*)(z + (t0 + 16 * ib + n16) * ZW + 4096 + h * 256 + v); }
    LDS_BARRIER();
#pragma unroll
    for (int ib = 0; ib < 4; ++ib) { float tot = 0.f;
#pragma unroll
        for (int ww = 0; ww < 8; ++ww) tot += RSS[ww * 64 + 16 * ib + n16];
        const float rs = rsqrtf(tot * (1.0f / 256.0f) + EPS); const size_t t = t0 + 16 * ib + n16;
#pragma unroll
        for (int vb = 0; vb < 2; ++vb) { const int v = (2 * w + vb) * 16 + 4 * kq; const f32x4 hn = hnv[vb]; const u32x2 gw = gwv[ib][vb];
            const f32x4 o = acc[vb][ib];
            const float y0 = o[0] * rs * hn[0] * siluf_(lo16(gw.x)), y1 = o[1] * rs * hn[1] * siluf_(hi16(gw.x)), y2 = o[2] * rs * hn[2] * siluf_(lo16(gw.y)), y3 = o[3] * rs * hn[3] * siluf_(hi16(gw.y));
            *(u32x2*)((bf16*)(F.ws + WS_YCAT) + t * D + 1024 + h * 256 + v) = (u32x2){pk2(y0, y1), pk2(y2, y3)}; } }
    LDS_BARRIER();
}

__device__ __forceinline__ void s5_unit(Frame& F, KArgs& A, int o, int unit) {
    const int tid = F.tid, lane = F.lane, w = F.wave, b = unit >> 6, g = unit & 63;
    LAS unsigned* U = (LAS unsigned*)F.lds;
    LAS float* XBall = (LAS float*)(F.lds + 65536);
    LAS float* EE = XBall + 8 * 2560;
    const bf16* u = (const bf16*)(F.ws + WS_U);
#pragma unroll
    for (int r = 0; r < 8; ++r) { const int piece = r * 512 + tid, tok = piece >> 1, hf = piece & 1; const size_t o_ = (size_t)(b * SEQ + tok) * 1024 + g * 16 + hf * 8;
        const u32x4 p0 = *(const u32x4*)(u + o_), p1 = *(const u32x4*)(u + (size_t)T * 1024 + o_);
        *(LAS u32x4*)(U + tok * 8 + hf * 4) = (u32x4){pk2(lo16(p0.x) + lo16(p1.x), hi16(p0.x) + hi16(p1.x)), pk2(lo16(p0.y) + lo16(p1.y), hi16(p0.y) + hi16(p1.y)),
                                                     pk2(lo16(p0.z) + lo16(p1.z), hi16(p0.z) + hi16(p1.z)), pk2(lo16(p0.w) + lo16(p1.w), hi16(p0.w) + hi16(p1.w))}; }
    const int n16 = lane & 15, kq = lane >> 4;
    const size_t gbase = (size_t)(o * 64 + g) * 64;
    const float dt = expf(A.in[21][o * 64 + g]);
    float ab_re, ab_im;
    { const float lr = fminf(A.in[19][gbase + lane], -1e-4f), li = A.in[20][gbase + lane]; const float mag = expf(lr * dt); ab_re = mag * cosf(li * dt); ab_im = mag * sinf(li * dt); }
    bf16x8 Bb[8];
#pragma unroll
    for (int f = 0; f < 4; ++f) { const int p = 16 * f + n16; const float lr = fminf(A.in[19][gbase + p], -1e-4f), li = A.in[20][gbase + p];
        const float mag = expf(lr * dt), are = mag * cosf(li * dt), aim = mag * sinf(li * dt), den = lr * lr + li * li;
        const float cre = ((are - 1.0f) * lr + aim * li) / den, cim = (aim * lr - (are - 1.0f) * li) / den;
        u32x4 wr_ = (u32x4){0u, 0u, 0u, 0u}, wi_ = (u32x4){0u, 0u, 0u, 0u};
        if (kq < 2) { const float* br = A.in[22] + (gbase + p) * 16 + kq * 8; const float* bi = A.in[23] + (gbase + p) * 16 + kq * 8; float vr[8], vi[8];
#pragma unroll
            for (int j = 0; j < 8; ++j) { vr[j] = cre * br[j] - cim * bi[j]; vi[j] = cre * bi[j] + cim * br[j]; }
            wr_ = (u32x4){pk2(vr[0], vr[1]), pk2(vr[2], vr[3]), pk2(vr[4], vr[5]), pk2(vr[6], vr[7])}; wi_ = (u32x4){pk2(vi[0], vi[1]), pk2(vi[2], vi[3]), pk2(vi[4], vi[5]), pk2(vi[6], vi[7])}; }
        Bb[f] = __builtin_bit_cast(bf16x8, wr_); Bb[4 + f] = __builtin_bit_cast(bf16x8, wi_); }
    bf16x8 Ct[4];
#pragma unroll
    for (int ks = 0; ks < 4; ++ks) { const int k0 = 32 * ks + 8 * kq; const float* src = (k0 < 64 ? A.in[24] : A.in[25]) + (gbase / 64 * 16 + n16) * 64 + (k0 & 63); const float sg = k0 < 64 ? 1.0f : -1.0f;
        const u32x4 wv = (u32x4){pk2(sg * src[0], sg * src[1]), pk2(sg * src[2], sg * src[3]), pk2(sg * src[4], sg * src[5]), pk2(sg * src[6], sg * src[7])}; Ct[ks] = __builtin_bit_cast(bf16x8, wv); }
    const f32x4 dsk = *(const f32x4*)(A.in[26] + o * 1024 + g * 16 + kq * 4);
    __syncthreads();
    LAS float* xb = XBall + w * 2560;
    const f32x4 z4 = (f32x4){0.f, 0.f, 0.f, 0.f};
#define S5_BU(tok0) { bf16x8 Uf = (bf16x8){0, 0, 0, 0, 0, 0, 0, 0}; if (kq < 2) Uf = __builtin_bit_cast(bf16x8, *(const LAS u32x4*)(U + ((tok0) + n16) * 8 + kq * 4)); \
        _Pragma("unroll") for (int f = 0; f < 8; ++f) { const f32x4 d = __builtin_amdgcn_mfma_f32_16x16x32_bf16(Uf, Bb[f], z4, 0, 0, 0); \
            *(LAS f32x4*)(xb + (16 * f + n16) * 20 + 4 * kq) = d; } }
#define S5_READ_BU() f32x4 br4[4], bi4[4]; _Pragma("unroll") for (int j = 0; j < 4; ++j) { br4[j] = *(const LAS f32x4*)(xb + lane * 20 + 4 * j); bi4[j] = *(const LAS f32x4*)(xb + (64 + lane) * 20 + 4 * j); }
    float hr = 0.f, hi = 0.f;
    for (int sub = 0; sub < 16; ++sub) { const int tok0 = w * 256 + sub * 16;
        S5_BU(tok0)
        S5_READ_BU()
#pragma unroll
        for (int t = 0; t < 16; ++t) { const float br = br4[t >> 2][t & 3], bi = bi4[t >> 2][t & 3]; const float nr = ab_re * hr - ab_im * hi + br, ni = ab_re * hi + ab_im * hr + bi; hr = nr; hi = ni; } }
    EE[(w * 64 + lane) * 2] = hr; EE[(w * 64 + lane) * 2 + 1] = hi;
    float pr = ab_re, pi = ab_im;
#pragma unroll
    for (int sq = 0; sq < 8; ++sq) { const float nr = pr * pr - pi * pi, ni = 2.0f * pr * pi; pr = nr; pi = ni; }
    __syncthreads();
    hr = 0.f; hi = 0.f;
    for (int sg = 0; sg < w; ++sg) { const float er = EE[(sg * 64 + lane) * 2], ei = EE[(sg * 64 + lane) * 2 + 1]; const float nr = pr * hr - pi * hi + er, ni = pr * hi + pi * hr + ei; hr = nr; hi = ni; }
    for (int sub = 0; sub < 16; ++sub) { const int tok0 = w * 256 + sub * 16;
        S5_BU(tok0)
        S5_READ_BU()
        asm volatile("s_waitcnt lgkmcnt(0)" ::: "memory");
#pragma unroll
        for (int t = 0; t < 16; ++t) { const float br = br4[t >> 2][t & 3], bi = bi4[t >> 2][t & 3]; const float nr = ab_re * hr - ab_im * hi + br, ni = ab_re * hi + ab_im * hr + bi; hr = nr; hi = ni;
            xb[t * 132 + lane] = hr; xb[t * 132 + 64 + lane] = hi; }
        f32x4 y = z4;
#pragma unroll
        for (int ks = 0; ks < 4; ++ks) { const f32x4 h0 = *(const LAS f32x4*)(xb + n16 * 132 + 32 * ks + 8 * kq), h1 = *(const LAS f32x4*)(xb + n16 * 132 + 32 * ks + 8 * kq + 4);
            const u32x4 hw = (u32x4){pk2(h0[0], h0[1]), pk2(h0[2], h0[3]), pk2(h1[0], h1[1]), pk2(h1[2], h1[3])};
            y = __builtin_amdgcn_mfma_f32_16x16x32_bf16(Ct[ks], __builtin_bit_cast(bf16x8, hw), y, 0, 0, 0); }
        const int tok = tok0 + n16; const u32x2 uw = *(const LAS u32x2*)(U + tok * 8 + kq * 2);
        const float y0 = y[0] + dsk[0] * lo16(uw.x), y1 = y[1] + dsk[1] * hi16(uw.x), y2 = y[2] + dsk[2] * lo16(uw.y), y3 = y[3] + dsk[3] * hi16(uw.y);
        u32x2 ow; ow.x = pk2(gelu_tanh(y0), gelu_tanh(y1)); ow.y = pk2(gelu_tanh(y2), gelu_tanh(y3));
        *(u32x2*)((bf16*)(F.ws + WS_YS5) + (size_t)(b * SEQ + tok) * 1024 + g * 16 + kq * 4) = ow; }
#undef S5_BU
#undef S5_READ_BU
    LDS_BARRIER();
}

__device__ __forceinline__ void router_unit(Frame& F, KArgs& A, int l, int unit, const bool dry, const bf16* xres) {
    const int tid = F.tid, lane = F.lane, w = F.wave, tok0 = unit * 32, tg = w >> 2, kc = w & 3, n16 = lane & 15, kq = lane >> 4;
    LAS float* RED = (LAS float*)F.lds;
    LAS float* SSQ = (LAS float*)(F.lds + 5 * RTW_IMG * 2);
    LAS float* RS = SSQ + 128;
    const float* gn = A.in[3] + (size_t)l * D;
    const char* rimg = (const char*)(F.ws + WS_RTW) + (size_t)l * 16 * RTW_IMG * 2;
    f32x4 acc[3]; float ssq = 0.f;
#pragma unroll
    for (int nf = 0; nf < 3; ++nf) acc[nf] = (f32x4){0.f, 0.f, 0.f, 0.f};
    const bf16* xrow = xres + (size_t)(tok0 + tg * 16 + n16) * D + kc * 512 + 8 * kq;
    u32x4 xv[16];
#pragma unroll
    for (int s16 = 0; s16 < 16; ++s16) xv[s16] = *(const u32x4*)(xrow + 32 * s16);
#define RT_DMA(s_) do { const char* src_ = rimg + (size_t)(s_) * (RTW_IMG * 2) + lane * 16; LAS unsigned char* dst_ = F.lds + ((s_) % 5) * (RTW_IMG * 2); \
        _Pragma("unroll") for (int r_ = 0; r_ < 4; ++r_) { int pc_ = r_ * 8 + w; pc_ = pc_ < 30 ? pc_ : 29; \
            __builtin_amdgcn_global_load_lds((const unsigned*)(src_ + pc_ * 1024), (LAS unsigned*)(dst_ + pc_ * 1024), 16, 0, 0); } } while (0)
#define RT_DMA2(s_, b_) do { const char* src_ = rimg + (size_t)(s_) * (RTW_IMG * 2) + lane * 16; LAS unsigned char* dst_ = F.lds + (b_) * (RTW_IMG * 2); \
        _Pragma("unroll") for (int r_ = 0; r_ < 4; ++r_) { int pc_ = r_ * 8 + w; pc_ = pc_ < 30 ? pc_ : 29; \
            __builtin_amdgcn_global_load_lds((const unsigned*)(src_ + pc_ * 1024), (LAS unsigned*)(dst_ + pc_ * 1024), 16, 0, 0); } } while (0)
    RT_DMA(0); RT_DMA(1); RT_DMA(2); RT_DMA(3);
    int rb = 0;
#pragma unroll 1
    for (int so = 0; so < 4; ++so) {
#pragma unroll
        for (int sj = 0; sj < 4; ++sj) { const int s16 = 4 * so + sj;
            if (so < 3 || sj == 0) asm volatile("s_waitcnt vmcnt(12)" ::: "memory"); else if (sj == 1) asm volatile("s_waitcnt vmcnt(8)" ::: "memory");
            else if (sj == 2) asm volatile("s_waitcnt vmcnt(4)" ::: "memory"); else asm volatile("s_waitcnt vmcnt(0)" ::: "memory");
            __builtin_amdgcn_s_barrier(); asm volatile("" ::: "memory");
            if (so < 3) RT_DMA2(s16 + 4, rb == 0 ? 4 : rb - 1);
            const LAS bf16* WH = (const LAS bf16*)(F.lds + rb * (RTW_IMG * 2)); const LAS bf16* WL = WH + 4 * 48 * 40;
            rb = rb == 4 ? 0 : rb + 1;
            const u32x4 xw = xv[sj];
            { const float x0 = lo16(xw.x), x1 = hi16(xw.x), x2 = lo16(xw.y), x3 = hi16(xw.y), x4 = lo16(xw.z), x5 = hi16(xw.z), x6 = lo16(xw.w), x7 = hi16(xw.w);
              ssq += ((x0 * x0 + x1 * x1) + (x2 * x2 + x3 * x3)) + ((x4 * x4 + x5 * x5) + (x6 * x6 + x7 * x7)); }
            const bf16x8 xf = __builtin_bit_cast(bf16x8, xw);
#pragma unroll
            for (int nf = 0; nf < 3; ++nf) { const bf16x8 wh = *(const LAS bf16x8*)(WH + (kc * 48 + nf * 16 + n16) * 40 + 8 * kq), wl = *(const LAS bf16x8*)(WL + (kc * 48 + nf * 16 + n16) * 40 + 8 * kq);
                acc[nf] = __builtin_amdgcn_mfma_f32_16x16x32_bf16(wh, xf, acc[nf], 0, 0, 0); acc[nf] = __builtin_amdgcn_mfma_f32_16x16x32_bf16(wl, xf, acc[nf], 0, 0, 0); }
            asm volatile("s_waitcnt lgkmcnt(0)" ::: "memory");
        }
#pragma unroll
        for (int i = 0; i < 12; ++i) xv[i] = xv[i + 4];
    }
#undef RT_DMA2
#undef RT_DMA
    __syncthreads();
    ssq += shx(ssq, 16, tid & 63); ssq += shx(ssq, 32, tid & 63);
#pragma unroll
    for (int nf = 0; nf < 3; ++nf)
#pragma unroll
        for (int r = 0; r < 4; ++r) RED[((tg * 4 + kc) * 48 + nf * 16 + 4 * kq + r) * 16 + n16] = acc[nf][r];
    if (kq == 0) SSQ[(tg * 4 + kc) * 16 + n16] = ssq;
    __syncthreads();
    if (tid < 32) {
        const int tg2 = tid >> 4, tk = tid & 15, token = tok0 + tid;
        float lgt[36];
#pragma unroll
        for (int o = 0; o < 36; ++o) lgt[o] = (RED[((tg2 * 4 + 0) * 48 + o) * 16 + tk] + RED[((tg2 * 4 + 1) * 48 + o) * 16 + tk]) + (RED[((tg2 * 4 + 2) * 48 + o) * 16 + tk] + RED[((tg2 * 4 + 3) * 48 + o) * 16 + tk]);
        const float sq = (SSQ[(tg2 * 4 + 0) * 16 + tk] + SSQ[(tg2 * 4 + 1) * 16 + tk]) + (SSQ[(tg2 * 4 + 2) * 16 + tk] + SSQ[(tg2 * 4 + 3) * 16 + tk]);
        const float rs = rsqrtf(sq * (1.0f / D) + EPS); RS[tid] = rs;
        const float* brg = A.in[29] + l * 4; const float* bre = A.in[31] + l * 32;
        float lg[4];
#pragma unroll
        for (int j = 0; j < 4; ++j) lg[j] = lgt[j] * rs + brg[j];
        int gs = 0; float mx = lg[0];
#pragma unroll
        for (int j = 1; j < 4; ++j) if (lg[j] > mx) { mx = lg[j]; gs = j; }
        float sum = 0.f;
#pragma unroll
        for (int j = 0; j < 4; ++j) sum += expf(lg[j] - mx);
        const float gate_g = 1.0f / sum;
        float le[8];
#pragma unroll
        for (int j = 0; j < 8; ++j) { const float a = gs == 0 ? lgt[4 + j] : gs == 1 ? lgt[12 + j] : gs == 2 ? lgt[20 + j] : lgt[28 + j]; le[j] = a * rs + bre[gs * 8 + j]; }
        int i1 = 0; float m1 = le[0];
#pragma unroll
        for (int j = 1; j < 8; ++j) if (le[j] > m1) { m1 = le[j]; i1 = j; }
        int i2 = (i1 == 0) ? 1 : 0; float m2 = le[i2];
#pragma unroll
        for (int j = 0; j < 8; ++j) if (j != i1 && le[j] > m2) { m2 = le[j]; i2 = j; }
        const float e2 = expf(m2 - m1), w1 = 1.0f / (1.0f + e2), w2 = e2 / (1.0f + e2);
        float* comb = (float*)(F.ws + (dry ? WS_DS : WS_COMB)); int* list = (int*)(F.ws + (dry ? WS_DS + 4 * MiB : WS_LIST)); unsigned* cnt = dry ? (unsigned*)(F.ws + WS_DS + 8 * MiB) : (unsigned*)(F.ws + WS_CTL) + CW_CNT + l * 32 * 16;
        const int ea = gs * 8 + i1, eb = gs * 8 + i2;
        comb[token] = gate_g * w1; comb[T + token] = gate_g * w2;
        LAS unsigned* HIST = (LAS unsigned*)(RS + 32); LAS unsigned* BASE = HIST + 32;
        HIST[tid] = 0u; asm volatile("s_waitcnt lgkmcnt(0)" ::: "memory");
        const unsigned ra = atomicAdd((unsigned*)(HIST + ea), 1u), rb = atomicAdd((unsigned*)(HIST + eb), 1u);
        asm volatile("s_waitcnt lgkmcnt(0)" ::: "memory");
        { const unsigned n = HIST[tid]; BASE[tid] = n ? atomicAdd(cnt + tid * 16, n) : 0u; }
        asm volatile("s_waitcnt vmcnt(0) lgkmcnt(0)" ::: "memory");
        unsigned pa = BASE[ea] + ra, pb = BASE[eb] + rb;
        if (dry) { pa &= 8191u; pb &= 8191u; }
        list[ea * 8192 + pa] = token; list[eb * 8192 + pb] = T + token;
    }
    __syncthreads();
    { u32x4 raw[4][4];
#pragma unroll
        for (int rr = 0; rr < 4; ++rr)
#pragma unroll
            for (int j = 0; j < 4; ++j) raw[rr][j] = *(const u32x4*)(xres + (size_t)(tok0 + w * 4 + rr) * D + 8 * lane + 512 * j);
#pragma unroll
        for (int rr = 0; rr < 4; ++rr) { const int row = w * 4 + rr; const float rs = RS[row]; const size_t t = (size_t)(tok0 + row);
#pragma unroll
            for (int j = 0; j < 4; ++j) { const int col = 8 * lane + 512 * j; const u32x4 r4 = raw[rr][j];
                const f32x4 oa = up4((u32x2){r4.x, r4.y}) * rs * *(const f32x4*)(gn + col), ob = up4((u32x2){r4.z, r4.w}) * rs * *(const f32x4*)(gn + col + 4);
                const u32x2 wl = dn4(oa), wh = dn4(ob);
                *(u32x4*)((bf16*)(F.ws + (dry ? WS_DS + 16 * MiB : WS_XN)) + t * D + col) = (u32x4){wl.x, wl.y, wh.x, wh.y}; } } }
    __syncthreads();
}

__device__ __forceinline__ void moe_prepare(Frame& F, int l, int nct, pg8::MoeOrder& S) {
    LAS int* cntl = (LAS int*)(F.lds + EXTRA_OFF); LAS int* pre = cntl + 64; LAS int* ptab = cntl + 128;
    const unsigned* cnt = (const unsigned*)(F.ws + WS_CTL) + CW_CNT + l * 32 * 16; const int* list = (const int*)(F.ws + WS_LIST);
    if (F.tid < 32) { const unsigned c = __hip_atomic_load(cnt + F.tid * 16, __ATOMIC_RELAXED, __HIP_MEMORY_SCOPE_AGENT); cntl[F.tid] = (int)(c > 8192u ? 8192u : c); }
    __syncthreads();
    if (F.tid == 0) { int s = 0; for (int e = 0; e < 32; ++e) { pre[e] = s; s += (cntl[e] + 255) >> 8; } pre[32] = s; }
    __syncthreads();
    S.pre = pre; S.cnt = cntl; S.ptab = ptab; S.nct = nct; S.G = F.G; S.c = F.vcu;
    for (int ui = 0; ui < pg8::MOE_MAXU; ++ui) { int e, rt, ct;
        if (S.decode(ui, e, rt, ct) && F.tid < 256) { const int pos = rt * 256 + F.tid; ptab[ui * 256 + F.tid] = pos < cntl[e] ? list[e * 8192 + pos] : -1; } }
    __syncthreads();
}

__device__ __forceinline__ void moe_prepare2(Frame& F, int l, int nct, fg::Tables& tb, const bool merged) {
    LAS int* cntl = (LAS int*)(F.lds + EXTRA_OFF); LAS int* pre = cntl + 64; LAS int* utab = cntl + 100; LAS int* ptab = cntl + 128; LAS float* ctab = (LAS float*)(ptab + fg::MAXU * 256);
    const unsigned* cnt = (const unsigned*)(F.ws + WS_CTL) + CW_CNT + l * 32 * 16; const int* list = (const int*)(F.ws + WS_LIST); const float* comb = (const float*)(F.ws + WS_COMB);
    __syncthreads();
    if (F.tid < 32) { const unsigned c = __hip_atomic_load(cnt + F.tid * 16, __ATOMIC_RELAXED, __HIP_MEMORY_SCOPE_AGENT); cntl[F.tid] = (int)(c > 8192u ? 8192u : c); }
    __syncthreads();
    if (F.tid == 0) { int s = 0; for (int e = 0; e < 32; ++e) { pre[e] = s; s += ((cntl[e] + 255) >> 8) * nct; } pre[32] = s; }
    __syncthreads();
    tb.cnt = cntl; tb.preU = pre; tb.ptab = ptab; tb.utab = utab; tb.ctab = ctab;
    tb.flags = merged ? (unsigned*)(F.ws + WS_CTL) + CW_FLAG + l * 32 * 32 * 16 : nullptr;
    const int ucu = (F.G == 256) ? ((F.vcu & 7) * 32 + (F.vcu >> 3)) : F.vcu;
    tb.stride = F.G; tb.c0 = ucu;
    if (merged) { const int n2 = pre[32] >> 1; const int h = n2 > F.G ? (n2 - F.G < F.G / 2 ? n2 - F.G : F.G / 2) : 0; tb.stride = F.G - h; tb.c0 = ucu - h; }
    int nu = 0;
    for (int ui = 0; ui < fg::MAXU; ++ui) { int e, rt, ct;
        if (fg::decode(tb, ui, e, rt, ct)) { ++nu;
            if (F.tid < 256) { const int pos = rt * 256 + F.tid; const int pr = pos < cntl[e] ? list[e * 8192 + pos] : -1; ptab[ui * 256 + F.tid] = pr; ctab[ui * 256 + F.tid] = pr >= 0 ? comb[pr] : 0.f; }
            if (F.tid == 0) { utab[3 * ui] = e; utab[3 * ui + 1] = rt; utab[3 * ui + 2] = ct; } } }
    if (F.tid == 0) utab[3 * fg::MAXU] = nu;
    __syncthreads();
}

constexpr int PH_LAYER0 = 2, PH_PER_LAYER = 12, PH_FINAL = PH_LAYER0 + DEPTH * PH_PER_LAYER, PH_END = PH_FINAL + 1;

__global__ void __launch_bounds__(NTHR, 2) mk_fwd(Args args) {
    extern __shared__ __attribute__((aligned(16))) unsigned char lds_raw[];
    Frame F;
    F.lds = (LAS unsigned char*)lds_raw;
    F.tid = threadIdx.x; F.lane = F.tid & 63; F.wave = __builtin_amdgcn_readfirstlane(F.tid >> 6);
    F.G = gridDim.x; { const int bx = blockIdx.x; F.vcu = (F.G % 8 == 0) ? (bx % 8) * (F.G / 8) + bx / 8 : bx; }
    F.ws = args.ws;
    volatile LAS unsigned* MISC = (volatile LAS unsigned*)(F.lds + MISC_OFF);
    if (F.tid < 64) MISC[F.tid] = 0u;
    __syncthreads();
    const int lo = args.ph_lo, hi = args.ph_hi;
    const bool multi = (hi - lo) > 1;
    XcdBarrier bar; bar.bar = (unsigned*)(args.ws + WS_CTL) + CW_BAR; bar.x = 0; bar.st = MISC + 8;
    if (multi) bar = xcd_barrier_post((unsigned*)(args.ws + WS_CTL) + CW_BAR, MISC + 8);
#ifndef MK_REP_P0
#define MK_REP_P0 1
#endif
#ifndef MK_REP_EV
#define MK_REP_EV 1
#endif
#ifndef MK_REP_S5
#define MK_REP_S5 1
#endif
#ifndef MK_REP_MOE
#define MK_REP_MOE 1
#endif
#ifndef MK_MOE_DRY
#define MK_MOE_DRY 0
#endif
#ifndef MK_REP_RT
#define MK_REP_RT 1
#endif
#ifndef MK_REP_G
#define MK_REP_G 1
#endif
#ifndef MK_MASK
#define MK_MASK 0xffffffffu
#endif
#define ON(b) ((MK_MASK >> (b)) & 1u)
#define IN(k) (lo <= (k) && (k) < hi)
#define SEAM(k) do { if (multi && (k) + 1 < hi) xcd_barrier(bar, F.wave == 0 && lane_now() == 0); } while (0)
    LAS unsigned char* ring = F.lds;
#define PHASE_ENTER KArgs& args = *opaque_k((KArgs*)__builtin_amdgcn_kernarg_segment_ptr()); Frame P = F; P.vcu = opaque_s(F.vcu); P.G = opaque_s(F.G); const int PBX = opaque_s((int)blockIdx.x); (void)PBX; P.tid = opaque_v(F.wave * 64 + lane_now()); P.lane = P.tid & 63; P.wave = __builtin_amdgcn_readfirstlane(P.tid >> 6); P.ws = opaque_p(F.ws); unsigned char* ws = P.ws; (void)ws;

    if (ON(0) && IN(0)) { for (int rep = 0; rep < MK_REP_P0; ++rep) { PHASE_ENTER p0_prologue(P, args); SEAM(0); } }
    if (multi && lo == 0) {
        if (F.tid == 0) { unsigned base = 0; for (unsigned j = 0; j < 16; ++j) { const unsigned cj = xb_ld(&bar.bar[XB_XCNT(j)]); base += (j < bar.x) ? cj : 0u; } MISC[11] = base + MISC[10]; }
        __syncthreads();
        F.vcu = __builtin_amdgcn_readfirstlane((int)MISC[11]);
    }
    if (ON(1) && IN(1)) {
        PHASE_ENTER
        pg8::PPOrder S; S.init(T, D, 256, P.G, PBX, (size_t)T * 256 * 2, SZ_PLEP);
        pg8::EpiStoreBf16Split E{(bf16*)(ws + WS_PP), D, (size_t)T * D, nullptr};
        pg8::gemm_phase<pg8::EpiStoreBf16Split, pg8::PPOrder, false>(P.tid, ring, (const char*)(ws + WS_PB), (const char*)(ws + WS_PLEP), 256, S, E);
        SEAM(1);
    }
    for (int l = 0; l < DEPTH; ++l) {
        const int pb = PH_LAYER0 + l * PH_PER_LAYER, eo = l >> 1;
        const size_t xcur = WS_XRES + (size_t)(l & 1) * T * D * 2, xnxt = WS_XRES + (size_t)((l + 1) & 1) * T * D * 2;
        if (ON(2) && l > 0 && IN(pb + 0)) {
            PHASE_ENTER
            const int gw = P.vcu * NWAVES + P.wave, NGW = P.G * NWAVES;
            for (int m = gw; m < T; m += NGW) norm_row<true, false, false, 0>((const bf16*)(ws + xcur) + (size_t)m * D, nullptr, nullptr, nullptr, nullptr, nullptr, nullptr, (float*)(ws + WS_RS) + m, P.lane);
            SEAM(pb + 0);
        }
        if ((l & 1) == 0) {
            if (ON(3) && IN(pb + 1)) for (int rep = 0; rep < MK_REP_G; ++rep) {
                PHASE_ENTER
                pg8::StaticOrder S; S.init(T, ZW, D, P.G, PBX);
                pg8::EpiStoreBf16 E{(bf16*)(ws + WS_Z), ZW, (const float*)(ws + WS_RS)};
                pg8::gemm_phase<pg8::EpiStoreBf16, pg8::StaticOrder, false>(P.tid, ring, (const char*)(ws + xcur), (const char*)(ws + WS_WIN) + (size_t)eo * SZ_WIN, D, S, E);
                SEAM(pb + 1);
            }
            if (IN(pb + 2)) for (int rep = 0; rep < MK_REP_EV; ++rep) {
                if (ON(4)) { PHASE_ENTER for (int u = P.vcu; u < 256; u += P.G) lru_unit(P, args, eo, u); }
                if (ON(17)) { PHASE_ENTER for (int u = P.vcu; u < 512; u += P.G) gla_ds_unit(P, args, eo, u); }
                SEAM(pb + 2);
            }
            if (ON(5) && IN(pb + 3)) for (int rep = 0; rep < MK_REP_EV; ++rep) { PHASE_ENTER gla_state_phase(P); SEAM(pb + 3); }
            if (ON(6) && IN(pb + 4)) for (int rep = 0; rep < MK_REP_EV; ++rep) { PHASE_ENTER for (int u = P.vcu; u < 512; u += P.G) gla_out_unit(P, args, eo, u); SEAM(pb + 4); }
            if (ON(7) && IN(pb + 5)) {
                PHASE_ENTER
                pg8::StaticOrder S; S.init(T, D, D, P.G, PBX);
                pg8::EpiResid E{(bf16*)(ws + xcur)};
                pg8::gemm_phase<pg8::EpiResid, pg8::StaticOrder, false>(P.tid, ring, (const char*)(ws + WS_YCAT), (const char*)(ws + WS_WOUT) + (size_t)eo * SZ_DD, D, S, E);
                SEAM(pb + 5);
            }
        } else {
            if (ON(8) && IN(pb + 1)) for (int rep = 0; rep < MK_REP_G; ++rep) {
                PHASE_ENTER
                pg8::SplitK2Order S; S.init(T, 1024, D, P.G, PBX);
                pg8::EpiStoreBf16Split E{(bf16*)(ws + WS_U), 1024, (size_t)T * 1024, (const float*)(ws + WS_RS)};
                pg8::gemm_phase<pg8::EpiStoreBf16Split, pg8::SplitK2Order, false>(P.tid, ring, (const char*)(ws + xcur), (const char*)(ws + WS_ODWIN) + (size_t)eo * SZ_ODWIN, D, S, E, D / 128);
                SEAM(pb + 1);
            }
            if (ON(9) && IN(pb + 2)) for (int rep = 0; rep < MK_REP_S5; ++rep) { PHASE_ENTER for (int u = P.vcu; u < 256; u += P.G) s5_unit(P, args, eo, u); SEAM(pb + 2); }
            if (ON(10) && IN(pb + 3)) {
                PHASE_ENTER
                pg8::StaticOrder S; S.init(T, 4096, 1024, P.G, PBX);
                pg8::EpiGlu E{(bf16*)(ws + xcur)};
                pg8::gemm_phase<pg8::EpiGlu, pg8::StaticOrder, false>(P.tid, ring, (const char*)(ws + WS_YS5), (const char*)(ws + WS_WGLU) + (size_t)eo * SZ_WGLU, 1024, S, E);
                SEAM(pb + 3);
            }
        }
        if (ON(11) && IN(pb + 6)) for (int rep = 0; rep < MK_REP_RT; ++rep) { PHASE_ENTER for (int u = P.vcu; u < 256; u += P.G) router_unit(P, args, l, u, rep + 1 < MK_REP_RT, (const bf16*)(ws + xcur)); SEAM(pb + 6); }
        if (ON(12) && IN(pb + 7)) {
            PHASE_ENTER
            unsigned* flags = (unsigned*)(ws + WS_CTL) + CW_FLAG + l * 32 * 32 * 16;
            {
                fg::Tables tb; moe_prepare2(P, l, 4, tb, false);
                const int nu2 = __builtin_amdgcn_readfirstlane(tb.utab[3 * fg::MAXU]);
#pragma unroll 1
                for (int ui = 0; ui < nu2; ++ui) {
                    fg::fgemm_phase<0>(opaque_v(P.tid), ring, tb, (const char*)(ws + WS_XN), args.in[32] + (size_t)l * 32 * D * 512, args.in[33] + (size_t)l * 32 * D * 512, (bf16*)(ws + WS_H), ui, ui + 1);
                    if (P.tid == 0) { __builtin_amdgcn_fence(__ATOMIC_RELEASE, "agent"); asm volatile("s_waitcnt vmcnt(0)" ::: "memory");
                        __hip_atomic_fetch_add(flags + (tb.utab[3 * ui] * 32 + tb.utab[3 * ui + 1]) * 16, 1u, __ATOMIC_RELAXED, __HIP_MEMORY_SCOPE_AGENT); }
                }
            }
            {
                Frame Q = P; Q.tid = opaque_v(P.tid);
                fg::Tables tb; moe_prepare2(Q, l, 8, tb, true);
                const int nu3 = __builtin_amdgcn_readfirstlane(tb.utab[3 * fg::MAXU]);
                fg::fgemm_phase<1>(Q.tid, ring, tb, (const char*)(ws + WS_H), args.in[34] + (size_t)l * 32 * 512 * D, nullptr, (bf16*)(ws + WS_Y), 0, nu3);
            }
            SEAM(pb + 8);
        }
        if (ON(14) && IN(pb + 9)) {
            PHASE_ENTER
            const int gw = P.vcu * NWAVES + P.wave, NGW = P.G * NWAVES;
            for (int m = gw; m < T; m += NGW) { bf16* xr = (bf16*)(ws + xcur) + (size_t)m * D;
                norm_row<true, true, true, 0>(xr, (const bf16*)(ws + WS_Y) + (size_t)m * D, (const bf16*)(ws + WS_Y) + (size_t)(T + m) * D, xr, nullptr, nullptr, nullptr, (float*)(ws + WS_RS) + m, P.lane); }
            SEAM(pb + 9);
        }
        if (ON(15) && IN(pb + 10)) {
            PHASE_ENTER
            pg8::StaticOrder S; S.init(T, D, D, P.G, PBX);
            pg8::EpiPle E{(const bf16*)(ws + xcur), (bf16*)(ws + xnxt), (const bf16*)(ws + WS_PP) + (size_t)l * T * D, args.in[36] + (size_t)l * D, (const float*)(ws + WS_RS)};
            pg8::gemm_phase<pg8::EpiPle, pg8::StaticOrder, false>(P.tid, ring, (const char*)(ws + xcur), (const char*)(ws + WS_PLEG) + (size_t)l * SZ_DD, D, S, E);
            SEAM(pb + 10);
        }
    }
    if (ON(16) && IN(PH_FINAL)) {
        PHASE_ENTER
        const int gw = P.vcu * NWAVES + P.wave, NGW = P.G * NWAVES;
        for (int m = gw; m < T; m += NGW) norm_row<true, false, false, 2>((const bf16*)(ws + WS_XRES + (size_t)(DEPTH & 1) * T * D * 2) + (size_t)m * D, nullptr, nullptr, nullptr, args.in[5], nullptr, args.out + (size_t)m * D, nullptr, P.lane);
    }
#undef IN
#undef ON
#undef SEAM
#undef PHASE_ENTER
}

static bool phase_exists(int k) {
    if (k < PH_LAYER0 || k >= PH_FINAL) return true;
    const int l = (k - PH_LAYER0) / PH_PER_LAYER, r = (k - PH_LAYER0) % PH_PER_LAYER;
    if (r == 0) return l > 0;
    if (r == 11) return false;
    if (l & 1) return !(r == 4 || r == 5);
    return true;
}
extern "C" void kernel_launch(void* const* d_in, const int* in_sizes, int n_in, void* d_out, int out_size, void* d_ws, size_t ws_size, hipStream_t stream) {
    static int grid = 0;
    if (grid == 0) {
        if (n_in != 38 || out_size != T * D || ws_size < WS_END) { fprintf(stderr, "kernel_launch: unexpected problem (n_in %d, out %d, ws %zu < %zu)\n", n_in, out_size, ws_size, (size_t)WS_END); grid = -1; return; }
        int dev = 0, cus = 0, per_cu = 0;
        if (hipGetDevice(&dev) != hipSuccess || hipDeviceGetAttribute(&cus, hipDeviceAttributeMultiprocessorCount, dev) != hipSuccess) { grid = -1; return; }
        if (hipFuncSetAttribute((const void*)mk_fwd, hipFuncAttributeMaxDynamicSharedMemorySize, LDS_BYTES) != hipSuccess) { fprintf(stderr, "kernel_launch: hipFuncSetAttribute failed\n"); grid = -1; return; }
        if (hipOccupancyMaxActiveBlocksPerMultiprocessor(&per_cu, (const void*)mk_fwd, NTHR, LDS_BYTES) != hipSuccess || per_cu < 1) fprintf(stderr, "kernel_launch: occupancy query says %d\n", per_cu);
        (void)hipGetLastError();
        grid = cus;
    }
    if (grid < 0) return;
    (void)hipMemsetAsync((char*)d_ws + WS_CTL, 0, CTL_BYTES, stream);
    Args a{};
    for (int i = 0; i < 38; ++i) a.in[i] = (const float*)d_in[i];
    a.out = (float*)d_out; a.ws = (unsigned char*)d_ws;
#if MK_PER_PHASE
    for (int k = 0; k < PH_END; ++k) { if (!phase_exists(k)) continue; a.ph_lo = k; a.ph_hi = k + 1; hipLaunchKernelGGL(mk_fwd, dim3(grid), dim3(NTHR), LDS_BYTES, stream, a); }
#else
    (void)phase_exists;
    a.ph_lo = 0; a.ph_hi = PH_END;
    hipLaunchKernelGGL(mk_fwd, dim3(grid), dim3(NTHR), LDS_BYTES, stream, a);
#endif
    const hipError_t le = hipPeekAtLastError();
    if (le != hipSuccess) fprintf(stderr, "kernel_launch: launch failed: %s\n", hipGetErrorName(le));
}
```

```cpp
#include <hip/hip_runtime.h>
#include <cstdio>
#include <cstdint>

#ifndef MK_PER_PHASE
#define MK_PER_PHASE 0
#endif

#define GAS __attribute__((address_space(1)))
#define LAS __attribute__((address_space(3)))
typedef unsigned short bf16;
typedef short bf16x8 __attribute__((ext_vector_type(8)));
typedef float f32x4 __attribute__((ext_vector_type(4)));
typedef float f32x2 __attribute__((ext_vector_type(2)));
typedef unsigned u32x4 __attribute__((ext_vector_type(4)));
typedef unsigned u32x2 __attribute__((ext_vector_type(2)));

constexpr int T = 8192, D = 2048, SEQ = 2048, NB = 4, DEPTH = 4;
constexpr int ZW = 5632;
constexpr int EV_IN = 5136;
constexpr float EPS = 1e-6f;
constexpr int NWAVES = 8, NTHR = 512;

constexpr size_t MiB = 1u << 20;
constexpr size_t WS_CTL = 0, CTL_BYTES = 1 * MiB;
constexpr size_t WS_WIN = 1 * MiB;
constexpr size_t SZ_WIN = (size_t)ZW * D * 2;
constexpr size_t WS_WOUT = WS_WIN + 2 * SZ_WIN;
constexpr size_t SZ_DD = (size_t)D * D * 2;
constexpr size_t WS_ODWIN = WS_WOUT + 2 * SZ_DD;
constexpr size_t SZ_ODWIN = (size_t)1024 * D * 2;
constexpr size_t WS_WGLU = WS_ODWIN + 2 * SZ_ODWIN;
constexpr size_t SZ_WGLU = (size_t)4096 * 1024 * 2;
constexpr size_t WS_PLEG = WS_WGLU + 2 * SZ_WGLU;
constexpr size_t WS_PLEP = WS_PLEG + 4 * SZ_DD;
constexpr size_t SZ_PLEP = (size_t)D * 256 * 2;
constexpr size_t WS_W13 = WS_PLEP + 4 * SZ_PLEP;
constexpr size_t WS_RTW = WS_W13;
constexpr int RTW_IMG = 2 * 4 * 48 * 40;
constexpr size_t SZ_W13 = (size_t)1024 * D * 2;
constexpr size_t WS_W2 = WS_W13 + 128 * SZ_W13;
constexpr size_t SZ_W2 = (size_t)D * 512 * 2;
constexpr size_t WS_XRES = WS_W2 + 128 * SZ_W2;
constexpr size_t WS_XN = WS_XRES + (size_t)T * D * 4;
constexpr size_t WS_Z = WS_XN + (size_t)T * D * 2;
constexpr size_t WS_YCAT = WS_Z + (size_t)T * ZW * 2;
constexpr size_t WS_DS = WS_YCAT + (size_t)T * D * 2;
constexpr size_t SZ_DS = (size_t)16 * 32 * 128 * 256 * 4;
constexpr size_t WS_SPREV = WS_DS + SZ_DS;
constexpr size_t WS_DECAY = WS_SPREV + SZ_DS;
constexpr size_t WS_U = WS_DECAY + (size_t)16 * 32 * 128 * 4;
constexpr size_t WS_YS5 = WS_U + (size_t)2 * T * 1024 * 2;
constexpr size_t WS_PB = WS_YS5 + (size_t)T * 1024 * 2;
constexpr size_t WS_PP = WS_PB + (size_t)4 * T * 256 * 2;
constexpr size_t WS_H = WS_PP + (size_t)4 * T * D * 2;
constexpr size_t WS_Y = WS_H + (size_t)2 * T * 512 * 2;
constexpr size_t WS_LIST = WS_Y + (size_t)2 * T * D * 2;
constexpr size_t WS_COMB = WS_LIST + (size_t)32 * 8192 * 4;
constexpr size_t WS_RS = WS_COMB + (size_t)2 * T * 4;
constexpr size_t WS_END = WS_RS + (size_t)T * 4;
constexpr int CW_BAR = 4096;
constexpr int CW_FLAG = 32768;
constexpr int CW_CNT = 16384;

constexpr int LDS_BYTES = 163840;
constexpr int EXTRA_OFF = 147456;
constexpr int MISC_OFF = LDS_BYTES - 256;

__device__ __forceinline__ float bf2f(unsigned b) { return __uint_as_float(b << 16); }
__device__ __forceinline__ unsigned f2bf(float f) { unsigned u = __float_as_uint(f); return (u + 0x7fffu + ((u >> 16) & 1u)) >> 16; }
typedef __bf16 bf16x2_t __attribute__((ext_vector_type(2)));
__device__ __forceinline__ unsigned pk2(float lo, float hi) { const bf16x2_t r = __builtin_convertvector((f32x2){lo, hi}, bf16x2_t); return __builtin_bit_cast(unsigned, r); }
__device__ __forceinline__ float lo16(unsigned w) { return __uint_as_float(w << 16); }
__device__ __forceinline__ float hi16(unsigned w) { return __uint_as_float(w & 0xffff0000u); }
__device__ __forceinline__ f32x4 up4(u32x2 w) { return (f32x4){lo16(w.x), hi16(w.x), lo16(w.y), hi16(w.y)}; }
__device__ __forceinline__ u32x2 dn4(f32x4 v) { u32x2 w; w.x = pk2(v[0], v[1]); w.y = pk2(v[2], v[3]); return w; }
__device__ __forceinline__ float sigmoidf_(float x) { return __builtin_amdgcn_rcpf(1.0f + __expf(-x)); }
__device__ __forceinline__ float one_minus_exp(float t) { const float ser = -t * (1.0f + 0.5f * t * (1.0f + (1.0f / 3.0f) * t * (1.0f + 0.25f * t))); return t > -0.03125f ? ser : 1.0f - __expf(t); }
__device__ __forceinline__ float siluf_(float x) { return x * sigmoidf_(x); }
__device__ __forceinline__ float gelu_tanh(float x) { return x * sigmoidf_(1.5957691216f * (x + 0.044715f * x * x * x)); }
__device__ __forceinline__ float softplusf_(float x) { return fmaxf(x, 0.f) + log1pf(__expf(-fabsf(x))); }
__device__ __forceinline__ float logsigmoidf_(float x) { return fminf(x, 0.f) - __logf(1.0f + __expf(-fabsf(x))); }
__device__ __forceinline__ float dpp_f(float v, const int ctrl_sel) {
    const int i = __builtin_bit_cast(int, v);
    int r;
    if (ctrl_sel == 0) r = __builtin_amdgcn_update_dpp(0, i, 0xB1, 0xF, 0xF, false);
    else if (ctrl_sel == 1) r = __builtin_amdgcn_update_dpp(0, i, 0x4E, 0xF, 0xF, false);
    else if (ctrl_sel == 2) r = __builtin_amdgcn_update_dpp(0, i, 0x141, 0xF, 0xF, false);
    else r = __builtin_amdgcn_update_dpp(0, i, 0x140, 0xF, 0xF, false);
    return __builtin_bit_cast(float, r);
}
__device__ __forceinline__ float shx(float v, int mask, int lane) { return __builtin_bit_cast(float, __builtin_amdgcn_ds_bpermute((lane ^ mask) << 2, __builtin_bit_cast(int, v))); }
__device__ __forceinline__ float wave_sum(float v) {
    v += dpp_f(v, 0); v += dpp_f(v, 1); v += dpp_f(v, 2); v += dpp_f(v, 3);
    const int i = __builtin_bit_cast(int, v);
    const float r0 = __builtin_bit_cast(float, __builtin_amdgcn_readlane(i, 0)), r1 = __builtin_bit_cast(float, __builtin_amdgcn_readlane(i, 16));
    const float r2 = __builtin_bit_cast(float, __builtin_amdgcn_readlane(i, 32)), r3 = __builtin_bit_cast(float, __builtin_amdgcn_readlane(i, 48));
    return (r0 + r1) + (r2 + r3);
}
#define LDS_WAIT() asm volatile("s_waitcnt lgkmcnt(0)" ::: "memory")
#define LDS_BARRIER() do { asm volatile("s_waitcnt lgkmcnt(0)" ::: "memory"); __builtin_amdgcn_s_barrier(); asm volatile("" ::: "memory"); } while (0)
__device__ __forceinline__ int opaque_v(int v) { asm volatile("" : "+v"(v)); return v; }
__device__ __forceinline__ int lane_now() { int z = 0; asm volatile("" : "+s"(z)); return (int)__builtin_amdgcn_mbcnt_hi(~0u, __builtin_amdgcn_mbcnt_lo(~0u, (unsigned)z)); }
__device__ __forceinline__ int opaque_s(int v) { v = __builtin_amdgcn_readfirstlane(v); asm volatile("" : "+s"(v)); return v; }
__device__ __forceinline__ unsigned char* opaque_p(unsigned char* p) { __attribute__((address_space(1))) unsigned char* g = (__attribute__((address_space(1))) unsigned char*)p; asm volatile("" : "+s"(g)); return (unsigned char*)g; }

#define XB_TMO      128
#define XB_XCNT(j)  (256  + 64 * (j))
#define XB_XSUB(j)  (1280 + 64 * (j))
#define XB_XGEN(j)  (2304 + 64 * (j))
#define XB_TOP      3328
#define XB_TOPGEN   3392
#define XCD_BAR_WORDS 3456
#define XB_SPIN_CAP (1u << 18)
__device__ __forceinline__ unsigned xb_ld(unsigned* p)              { return __hip_atomic_load(p, __ATOMIC_RELAXED, __HIP_MEMORY_SCOPE_AGENT); }
__device__ __forceinline__ unsigned xb_add(unsigned* p, unsigned v) { return __hip_atomic_fetch_add(p, v, __ATOMIC_RELAXED, __HIP_MEMORY_SCOPE_AGENT); }
__device__ __forceinline__ unsigned xb_xcc_id() { return (unsigned)__builtin_amdgcn_s_getreg((3 << 11) | 20) & 0xFu; }
#define XB_SPIN(cond, bar) do { unsigned _sp = 0; while (cond) { __builtin_amdgcn_s_sleep(1); \
    if ((++_sp & 255u) == 0u) { if (xb_ld(&(bar)[XB_TMO])) break; if (_sp > XB_SPIN_CAP) { atomicAdd(&(bar)[XB_TMO], 1u); break; } } } } while (0)
struct XcdBarrier { unsigned* bar; unsigned x; volatile LAS unsigned* st; };
__device__ __forceinline__ XcdBarrier xcd_barrier_post(unsigned* bar, volatile LAS unsigned* st) {
    XcdBarrier b; b.bar = bar; b.x = xb_xcc_id(); b.st = st;
    if (threadIdx.x == 0) st[2] = xb_add(&bar[XB_XCNT(b.x)], 1u);
    return b;
}
__device__ __forceinline__ unsigned long long xcd_barrier_complete(unsigned* bar, unsigned x) {
    const unsigned G = gridDim.x * gridDim.y * gridDim.z;
    unsigned sum, cnt, mine, sp = 0u;
    for (;;) {
        sum = 0u; cnt = 0u; mine = 0u;
#pragma unroll 1
        for (unsigned j = 0; j < 16; ++j) { const unsigned c = xb_ld(&bar[XB_XCNT(j)]); sum += c; cnt += (c > 0u) ? 1u : 0u; mine = (j == x) ? c : mine; }
        if (sum == G) break;
        __builtin_amdgcn_s_sleep(1);
        if ((++sp & 255u) == 0u) { if (xb_ld(&bar[XB_TMO])) break; if (sp > XB_SPIN_CAP) { atomicAdd(&bar[XB_TMO], 1u); break; } }
    }
    const unsigned nloc = mine > 0u ? mine : 1u, nx = cnt > 0u ? cnt : 1u;
    return ((unsigned long long)nx << 32) | nloc;
}
__device__ __forceinline__ void xcd_barrier_leader(unsigned* bar, unsigned x, volatile LAS unsigned* st) {
    __builtin_amdgcn_s_waitcnt(0);
    unsigned nloc = st[0], nx = st[1];
    if (nloc == 0u) { const unsigned long long r = xcd_barrier_complete(bar, x); nloc = (unsigned)r; nx = (unsigned)(r >> 32); st[0] = nloc; st[1] = nx; }
    const unsigned old = xb_add(&bar[XB_XSUB(x)], 1u);
    const unsigned gen = old / nloc;
    if (old + 1u == (gen + 1u) * nloc) {
        __builtin_amdgcn_fence(__ATOMIC_RELEASE, "agent");
        asm volatile("s_waitcnt vmcnt(0)" ::: "memory");
        const unsigned og = xb_add(&bar[XB_TOP], 1u);
        const unsigned tg = og / nx;
        if (og + 1u == (tg + 1u) * nx) xb_add(&bar[XB_TOPGEN], 1u);
        else XB_SPIN(xb_ld(&bar[XB_TOPGEN]) == tg, bar);
        __builtin_amdgcn_fence(__ATOMIC_ACQUIRE, "agent");
        xb_add(&bar[XB_XGEN(x)], 1u);
        asm volatile("s_waitcnt vmcnt(0)" ::: "memory");
    } else {
        XB_SPIN(xb_ld(&bar[XB_XGEN(x)]) == gen, bar);
        __builtin_amdgcn_fence(__ATOMIC_ACQUIRE, "agent");
        asm volatile("s_waitcnt vmcnt(0)" ::: "memory");
    }
}
__device__ __forceinline__ void xcd_barrier(const XcdBarrier& b, const bool leader) {
    asm volatile("s_waitcnt vmcnt(0)" ::: "memory");
    __syncthreads();
    if (leader) xcd_barrier_leader(b.bar, b.x, b.st);
    __syncthreads();
}

struct Args { const float* in[38]; float* out; unsigned char* ws; int ph_lo, ph_hi; };
typedef const Args __attribute__((address_space(4))) KArgs;
__device__ __forceinline__ KArgs* opaque_k(KArgs* p) { asm volatile("" : "+s"(p)); return p; }
struct Frame {
    LAS unsigned char* lds;
    int tid, lane, wave, vcu, G;
    unsigned char* ws;
};

namespace pg8 {
constexpr int BM = 256, BK = 64, HALF = 128, HTB = HALF * BK * 2, STAGE_BYTES = 8 * HTB, NXCD = 8, WGM = 8;
__device__ __forceinline__ int lds_byte(int r, int c) { const int st = (r >> 4) * 2 + (c >> 5), rr = r & 15, cc = c & 31, ob = rr * 64 + cc * 2; return st * 1024 + (ob ^ (((ob >> 9) & 1) << 5)); }
__device__ __forceinline__ void stage_rc(int b, int& R, int& C) { const int st = b / 1024, sb = b % 1024, swz = sb ^ (((sb >> 9) & 1) << 5); R = (st >> 1) * 16 + swz / 64; C = (st & 1) * 32 + (swz % 64) / 2; }

struct Unit { int pm, pn; size_t a_off, b_off; int ui, e, nrows; };

struct StaticOrder {
    int nM, nN, nwg, G, c, K;
    __device__ void init(int M, int N, int K_, int G_, int c_) { nM = M / BM; nN = N / BM; nwg = nM * nN; G = G_; c = c_; K = K_; }
    __device__ __forceinline__ bool next(int i, Unit& u) const {
        const long L = (long)i * G + c; if (L >= nwg) return false;
        int wgid = (int)L; { const int q = nwg / NXCD, r = nwg % NXCD, xcd = wgid % NXCD, off = wgid / NXCD; wgid = (xcd < r ? xcd * (q + 1) : r * (q + 1) + (xcd - r) * q) + off; }
        const int nig = WGM * nN, gid = wgid / nig, fm = gid * WGM, gsz = (nM - fm) < WGM ? (nM - fm) : WGM;
        u.pm = fm + ((wgid % nig) % gsz); u.pn = (wgid % nig) / gsz;
        u.a_off = (size_t)u.pm * BM * K * 2; u.b_off = (size_t)u.pn * BM * K * 2; u.ui = i; u.e = 0; u.nrows = BM;
        return true;
    }
    __device__ __forceinline__ unsigned row_off(const Unit&, int) const { return 0u; }
};

struct SplitK2Order {
    StaticOrder base;
    __device__ void init(int M, int N, int K_, int G_, int c_) { base.init(M, N, K_, G_, c_); }
    __device__ __forceinline__ bool next(int i, Unit& u) const {
        const long L = (long)i * base.G + base.c; if (L >= 2 * base.nwg) return false;
        StaticOrder b2 = base; b2.G = 1; b2.c = 0;
        const int kh = (int)(L & 1); if (!b2.next((int)(L >> 1), u)) return false;
        u.a_off += (size_t)kh * base.K; u.b_off += (size_t)kh * base.K; u.ui = i; u.e = kh; return true;
    }
    __device__ __forceinline__ unsigned row_off(const Unit&, int) const { return 0u; }
};
struct PPOrder {
    StaticOrder base; size_t a_layer, b_layer;
    __device__ void init(int M, int N, int K_, int G_, int c_, size_t a_layer_, size_t b_layer_) { base.init(M, N, K_, G_, c_); a_layer = a_layer_; b_layer = b_layer_; }
    __device__ __forceinline__ bool next(int i, Unit& u) const {
        const long L = (long)i * base.G + base.c; if (L >= 4L * base.nwg) return false;
        const int ll = (int)(L / base.nwg); StaticOrder b2 = base; b2.G = 1; b2.c = 0;
        if (!b2.next((int)(L - (long)ll * base.nwg), u)) return false;
        u.a_off += (size_t)ll * a_layer; u.b_off += (size_t)ll * b_layer; u.ui = i; u.e = ll; return true;
    }
    __device__ __forceinline__ unsigned row_off(const Unit&, int) const { return 0u; }
};
constexpr int MOE_MAXU = 4;
struct MoeOrder {
    const LAS int* pre;
    const LAS int* cnt;
    const LAS int* ptab;
    int nct, G, c, K, brows;
    unsigned rshift_mask;
    unsigned rbytes;
    __device__ __forceinline__ bool decode(int i, int& e, int& rt, int& ct) const {
        if (i >= MOE_MAXU) return false;
        const int L = i * G + c, total = pre[32] * nct; if (L >= total) return false;
        const int rtg = L / nct; ct = L - rtg * nct; e = 0;
        for (int j = 1; j < 32; ++j) e = (pre[j] <= rtg) ? j : e;
        rt = rtg - pre[e]; return true;
    }
    __device__ __forceinline__ bool next(int i, Unit& u) const {
        int e, rt, ct; if (!decode(i, e, rt, ct)) return false;
        u.pm = rt; u.pn = ct; u.a_off = 0; u.b_off = ((size_t)e * brows + (size_t)ct * BM) * K * 2; u.ui = i; u.e = e;
        const int left = cnt[e] - rt * BM; u.nrows = left < BM ? left : BM; return true;
    }
    __device__ __forceinline__ unsigned row_off(const Unit& u, int r) const { const int p = ptab[u.ui * 256 + r]; return p < 0 ? 0u : ((unsigned)p & rshift_mask) * rbytes; }
};

template <class Epi, class Sched, bool GATHER>
__device__ __forceinline__ void gemm_phase(const int tid, LAS unsigned char* lds, const char* Abase, const char* Bbase, const int K, const Sched& S, const Epi& E, const int ntl = 0) {
    const int wid = __builtin_amdgcn_readfirstlane(tid >> 6), lane = tid & 63, wr = wid >> 2, wc = wid & 3, fr = lane & 15, fq = lane >> 4;
    const int nt = ntl ? ntl : K / BK;
    unsigned voff[2]; int RR[2]; unsigned CC2[2];
#pragma unroll
    for (int i = 0; i < 2; ++i) { int R, C; stage_rc(tid * 16 + i * 8192, R, C); voff[i] = (unsigned)(R * K + C) * 2u; RR[i] = R; CC2[i] = (unsigned)C * 2u; }
    const size_t kstep = (size_t)(BK * 2);
    const size_t hstep = (size_t)HALF * K * 2;
    const unsigned ldsw = (unsigned)wid * 1024u;
    const int aoff = lds_byte(wr * 64 + fr, fq * 8), boff = lds_byte(wc * 32 + fr, fq * 8);
#define PG8_SA(b, h) (((b) * 2 + (h)) * HTB)
#define PG8_SB(b, h) ((4 + (b) * 2 + (h)) * HTB)
#define PG8_STAGE_B(bufoff, gbase) do { _Pragma("unroll") for (int _i = 0; _i < 2; ++_i) \
        __builtin_amdgcn_global_load_lds((const unsigned*)((const char*)(gbase) + voff[_i]), (LAS unsigned*)(lds + (bufoff) + ldsw + _i * 8192), 16, 0, 0); } while (0)
#define PG8_STAGE_A(bufoff, gbase, ro, kb) do { _Pragma("unroll") for (int _i = 0; _i < 2; ++_i) { \
        if constexpr (GATHER) __builtin_amdgcn_global_load_lds((const unsigned*)(Abase + ((ro)[_i] + (unsigned)(kb))), (LAS unsigned*)(lds + (bufoff) + ldsw + _i * 8192), 16, 0, 0); \
        else __builtin_amdgcn_global_load_lds((const unsigned*)((const char*)(gbase) + voff[_i]), (LAS unsigned*)(lds + (bufoff) + ldsw + _i * 8192), 16, 0, 0); } } while (0)
#define PG8_LDA(dst, b, h) do { _Pragma("unroll") for (int m = 0; m < 4; ++m) _Pragma("unroll") for (int k = 0; k < 2; ++k) dst[m][k] = *(const LAS bf16x8*)(lds + PG8_SA(b, h) + aoff + m * 2048 + k * 1024); } while (0)
#define PG8_LDB(dst, b, h) do { _Pragma("unroll") for (int n = 0; n < 2; ++n) _Pragma("unroll") for (int k = 0; k < 2; ++k) dst[n][k] = *(const LAS bf16x8*)(lds + PG8_SB(b, h) + boff + n * 2048 + k * 1024); } while (0)
#define PG8_MMA(ai, bj, At, Bt) do { __builtin_amdgcn_s_setprio(1); _Pragma("unroll") for (int m = 0; m < 4; ++m) _Pragma("unroll") for (int n = 0; n < 2; ++n) _Pragma("unroll") for (int k = 0; k < 2; ++k) \
        acc[ai][bj][m][n] = __builtin_amdgcn_mfma_f32_16x16x32_bf16(Bt[n][k], At[m][k], acc[ai][bj][m][n], 0, 0, 0); __builtin_amdgcn_s_setprio(0); } while (0)
#define PG8_WAIT_V(n) asm volatile("s_waitcnt vmcnt(" #n ")" ::: "memory")
#define PG8_WAIT_L(n) asm volatile("s_waitcnt lgkmcnt(" #n ")" ::: "memory")
#define PG8_BAR __builtin_amdgcn_s_barrier()
#define PG8_SCHED __builtin_amdgcn_sched_barrier(0)
    Unit cur, nxt; int ui = 0;
    if (!S.next(0, cur)) return;
    f32x4 acc[2][2][4][2];
#pragma unroll
    for (int a = 0; a < 2; ++a)
#pragma unroll
        for (int b = 0; b < 2; ++b)
#pragma unroll
            for (int m = 0; m < 4; ++m)
#pragma unroll
                for (int n = 0; n < 2; ++n) acc[a][b][m][n] = (f32x4){0.f, 0.f, 0.f, 0.f};
    bf16x8 At[4][2], B0[2][2], B1[2][2];
    const char* cA = Abase + cur.a_off; const char* cB = Bbase + cur.b_off;
    unsigned cro0[2] = {0u, 0u}, cro1[2] = {0u, 0u}, nro0[2] = {0u, 0u}, nro1[2] = {0u, 0u};
    if constexpr (GATHER) {
#pragma unroll
        for (int i = 0; i < 2; ++i) { cro0[i] = S.row_off(cur, RR[i]) + CC2[i]; cro1[i] = S.row_off(cur, 128 + RR[i]) + CC2[i]; }
    }
    PG8_STAGE_B(PG8_SB(0, 0), cB); PG8_STAGE_A(PG8_SA(0, 0), cA, cro0, 0); PG8_STAGE_B(PG8_SB(0, 1), cB + hstep); PG8_STAGE_A(PG8_SA(0, 1), cA + hstep, cro1, 0);
    if (wr == 1) PG8_BAR;
    PG8_WAIT_V(4); PG8_BAR;
    PG8_STAGE_B(PG8_SB(1, 0), cB + kstep); PG8_STAGE_A(PG8_SA(1, 0), cA + kstep, cro0, kstep); PG8_STAGE_B(PG8_SB(1, 1), cB + hstep + kstep);
    PG8_WAIT_V(6); PG8_BAR;
    for (;;) {
        const bool has_next = S.next(ui + 1, nxt);
        const char* nA = has_next ? Abase + nxt.a_off : cA; const char* nB = has_next ? Bbase + nxt.b_off : cB;
        if constexpr (GATHER) {
#pragma unroll
            for (int i = 0; i < 2; ++i) { nro0[i] = has_next ? S.row_off(nxt, RR[i]) + CC2[i] : cro0[i]; nro1[i] = has_next ? S.row_off(nxt, 128 + RR[i]) + CC2[i] : cro1[i]; }
        }
        for (int t = 0; t < nt; t += 2) {
            const bool last = (t == nt - 2);
            const char* a1 = cA + (size_t)(t + 1) * kstep;
            const char* a2 = last ? nA : cA + (size_t)(t + 2) * kstep; const char* b2 = last ? nB : cB + (size_t)(t + 2) * kstep;
            const char* a3 = a2 + kstep; const char* b3 = b2 + kstep;
            unsigned r20[2], r21[2]; unsigned k1 = 0, k2 = 0, k3 = 0;
            if constexpr (GATHER) {
#pragma unroll
                for (int i = 0; i < 2; ++i) { r20[i] = last ? nro0[i] : cro0[i]; r21[i] = last ? nro1[i] : cro1[i]; }
                k1 = (unsigned)(t + 1) * 128u; k2 = last ? 0u : (unsigned)(t + 2) * 128u; k3 = k2 + 128u;
            } else { r20[0] = r20[1] = r21[0] = r21[1] = 0u; }
            PG8_LDB(B0, 0, 0); PG8_SCHED; PG8_LDA(At, 0, 0); PG8_STAGE_A(PG8_SA(1, 1), a1 + hstep, cro1, k1);
            PG8_WAIT_L(8); PG8_BAR; PG8_WAIT_L(0); PG8_MMA(0, 0, At, B0); PG8_BAR; PG8_SCHED;
            PG8_LDB(B1, 0, 1); PG8_STAGE_B(PG8_SB(0, 0), b2);
            PG8_BAR; PG8_WAIT_L(0); PG8_MMA(0, 1, At, B1); PG8_BAR;
            PG8_LDA(At, 0, 1); PG8_STAGE_A(PG8_SA(0, 0), a2, r20, k2);
            PG8_BAR; PG8_WAIT_L(0); PG8_MMA(1, 0, At, B0); PG8_BAR; PG8_SCHED;
            PG8_STAGE_B(PG8_SB(0, 1), b2 + hstep);
            PG8_WAIT_V(6); PG8_BAR; PG8_MMA(1, 1, At, B1); PG8_BAR;
            PG8_LDB(B0, 1, 0); PG8_SCHED; PG8_LDA(At, 1, 0); PG8_STAGE_A(PG8_SA(0, 1), a2 + hstep, r21, k2);
            PG8_WAIT_L(8); PG8_BAR; PG8_WAIT_L(0); PG8_MMA(0, 0, At, B0); PG8_BAR; PG8_SCHED;
            PG8_LDB(B1, 1, 1); PG8_STAGE_B(PG8_SB(1, 0), b3);
            PG8_BAR; PG8_WAIT_L(0); PG8_MMA(0, 1, At, B1); PG8_BAR;
            PG8_LDA(At, 1, 1); PG8_STAGE_A(PG8_SA(1, 0), a3, r20, k3);
            PG8_BAR; PG8_WAIT_L(0); PG8_MMA(1, 0, At, B0); PG8_BAR; PG8_SCHED;
            PG8_STAGE_B(PG8_SB(1, 1), b3 + hstep);
            PG8_WAIT_V(6); PG8_BAR; PG8_MMA(1, 1, At, B1); PG8_BAR;
        }
        E(acc, cur, wr, wc, fr, fq);
        if (!has_next) break;
#pragma unroll
        for (int a = 0; a < 2; ++a)
#pragma unroll
            for (int b = 0; b < 2; ++b)
#pragma unroll
                for (int m = 0; m < 4; ++m)
#pragma unroll
                    for (int n = 0; n < 2; ++n) acc[a][b][m][n] = (f32x4){0.f, 0.f, 0.f, 0.f};
        cur = nxt; cA = nA; cB = nB; ++ui;
        if constexpr (GATHER) {
#pragma unroll
            for (int i = 0; i < 2; ++i) { cro0[i] = nro0[i]; cro1[i] = nro1[i]; }
        }
    }
    PG8_WAIT_V(0);
    if (wr == 0) PG8_BAR;
    PG8_BAR;
#undef PG8_SA
#undef PG8_SB
#undef PG8_STAGE_A
#undef PG8_STAGE_B
#undef PG8_LDA
#undef PG8_LDB
#undef PG8_MMA
#undef PG8_WAIT_V
#undef PG8_WAIT_L
#undef PG8_BAR
#undef PG8_SCHED
}

#define EPI_ROWS_BEGIN _Pragma("unroll") for (int ai = 0; ai < 2; ++ai) _Pragma("unroll") for (int m = 0; m < 4; ++m) { const int rl = ai * HALF + wr * 64 + m * 16 + fr;
#define EPI_ROWS_END }
struct EpiStoreBf16 {
    bf16* O; int ldc; const float* rs;
    __device__ __forceinline__ void operator()(const f32x4 (&acc)[2][2][4][2], const Unit& u, int wr, int wc, int fr, int fq) const {
        EPI_ROWS_BEGIN bf16* rowp = O + (size_t)(u.pm * BM + rl) * ldc + u.pn * BM + wc * 32 + 8 * fq; const float sc = rs ? rs[u.pm * BM + rl] : 1.0f;
#pragma unroll
            for (int bj = 0; bj < 2; ++bj) { const f32x4 v0 = acc[ai][bj][m][0] * sc, v1 = acc[ai][bj][m][1] * sc;
                *(u32x4*)(rowp + bj * HALF) = (u32x4){pk2(v0[0], v0[1]), pk2(v0[2], v0[3]), pk2(v1[0], v1[1]), pk2(v1[2], v1[3])}; } EPI_ROWS_END
    }
};
struct EpiStoreBf16Split {
    bf16* O; int ldc; size_t half_stride; const float* rs;
    __device__ __forceinline__ void operator()(const f32x4 (&acc)[2][2][4][2], const Unit& u, int wr, int wc, int fr, int fq) const {
        EPI_ROWS_BEGIN bf16* rowp = O + (size_t)u.e * half_stride + (size_t)(u.pm * BM + rl) * ldc + u.pn * BM + wc * 32 + 8 * fq; const float sc = rs ? rs[u.pm * BM + rl] : 1.0f;
#pragma unroll
            for (int bj = 0; bj < 2; ++bj) { const f32x4 v0 = acc[ai][bj][m][0] * sc, v1 = acc[ai][bj][m][1] * sc;
                *(u32x4*)(rowp + bj * HALF) = (u32x4){pk2(v0[0], v0[1]), pk2(v0[2], v0[3]), pk2(v1[0], v1[1]), pk2(v1[2], v1[3])}; } EPI_ROWS_END
    }
};
struct EpiResid {
    bf16* X;
    __device__ __forceinline__ void operator()(const f32x4 (&acc)[2][2][4][2], const Unit& u, int wr, int wc, int fr, int fq) const {
#pragma unroll
        for (int ai = 0; ai < 2; ++ai) { bf16* base = X + (size_t)(u.pm * BM + ai * HALF + wr * 64 + fr) * D + u.pn * BM + wc * 32 + 8 * fq; u32x4 xv[4][2];
#pragma unroll
            for (int m = 0; m < 4; ++m)
#pragma unroll
                for (int bj = 0; bj < 2; ++bj) xv[m][bj] = *(const u32x4*)(base + (size_t)m * 16 * D + bj * HALF);
#pragma unroll
            for (int m = 0; m < 4; ++m)
#pragma unroll
                for (int bj = 0; bj < 2; ++bj) { const u32x2 lo = dn4(up4((u32x2){xv[m][bj].x, xv[m][bj].y}) + acc[ai][bj][m][0]), hi = dn4(up4((u32x2){xv[m][bj].z, xv[m][bj].w}) + acc[ai][bj][m][1]);
                    *(u32x4*)(base + (size_t)m * 16 * D + bj * HALF) = (u32x4){lo.x, lo.y, hi.x, hi.y}; }
            asm volatile("" ::: "memory"); }
    }
};
struct EpiGlu {
    bf16* X;
    __device__ __forceinline__ void operator()(const f32x4 (&acc)[2][2][4][2], const Unit& u, int wr, int wc, int fr, int fq) const {
#pragma unroll
        for (int ai = 0; ai < 2; ++ai) { u32x2 xv[4][2];
#pragma unroll
            for (int m = 0; m < 4; ++m)
#pragma unroll
                for (int bj = 0; bj < 2; ++bj) xv[m][bj] = *(const u32x2*)(X + (size_t)(u.pm * BM + ai * HALF + wr * 64 + m * 16 + fr) * D + 4 * fq + 16 * (8 * u.pn + 4 * bj + wc));
#pragma unroll
            for (int m = 0; m < 4; ++m)
#pragma unroll
                for (int bj = 0; bj < 2; ++bj) { const f32x4 a = acc[ai][bj][m][0], g = acc[ai][bj][m][1]; f32x4 x = up4(xv[m][bj]);
#pragma unroll
                    for (int j = 0; j < 4; ++j) x[j] += a[j] * sigmoidf_(g[j]);
                    *(u32x2*)(X + (size_t)(u.pm * BM + ai * HALF + wr * 64 + m * 16 + fr) * D + 4 * fq + 16 * (8 * u.pn + 4 * bj + wc)) = dn4(x); }
            asm volatile("" ::: "memory"); }
    }
};
struct EpiPle {
    const bf16* X; bf16* Xo; const bf16* PP; const float* bias; const float* rs;
    __device__ __forceinline__ void operator()(const f32x4 (&acc)[2][2][4][2], const Unit& u, int wr, int wc, int fr, int fq) const {
        const int col0 = u.pn * BM + wc * 32 + 8 * fq;
        f32x4 bv[2][2];
#pragma unroll
        for (int bj = 0; bj < 2; ++bj)
#pragma unroll
            for (int n = 0; n < 2; ++n) bv[bj][n] = *(const f32x4*)(bias + col0 + bj * HALF + n * 4);
#pragma unroll
        for (int ai = 0; ai < 2; ++ai) { const size_t ro = (size_t)(u.pm * BM + ai * HALF + wr * 64 + fr) * D + col0; u32x4 xv[4][2], pw[4][2]; float sc[4];
#pragma unroll
            for (int m = 0; m < 4; ++m) sc[m] = rs[u.pm * BM + ai * HALF + wr * 64 + m * 16 + fr];
#pragma unroll
            for (int m = 0; m < 4; ++m)
#pragma unroll
                for (int bj = 0; bj < 2; ++bj) { const size_t o = ro + (size_t)m * 16 * D + bj * HALF; xv[m][bj] = *(const u32x4*)(X + o); pw[m][bj] = *(const u32x4*)(PP + o); }
#pragma unroll
            for (int m = 0; m < 4; ++m)
#pragma unroll
                for (int bj = 0; bj < 2; ++bj) { const size_t o = ro + (size_t)m * 16 * D + bj * HALF; u32x2 outw[2];
#pragma unroll
                    for (int n = 0; n < 2; ++n) { const f32x4 v = acc[ai][bj][m][n] * sc[m] + bv[bj][n];
                        f32x4 x = up4(n ? (u32x2){xv[m][bj].z, xv[m][bj].w} : (u32x2){xv[m][bj].x, xv[m][bj].y}); const f32x4 pq = up4(n ? (u32x2){pw[m][bj].z, pw[m][bj].w} : (u32x2){pw[m][bj].x, pw[m][bj].y});
#pragma unroll
                        for (int j = 0; j < 4; ++j) x[j] += sigmoidf_(v[j]) * pq[j];
                        outw[n] = dn4(x); }
                    *(u32x4*)(Xo + o) = (u32x4){outw[0].x, outw[0].y, outw[1].x, outw[1].y}; }
            asm volatile("" ::: "memory"); }
    }
};
struct EpiMoeH {
    bf16* H; const float* comb; const LAS int* ptab;
    __device__ __forceinline__ void operator()(const f32x4 (&acc)[2][2][4][2], const Unit& u, int wr, int wc, int fr, int fq) const {
        EPI_ROWS_BEGIN const int pair = ptab[u.ui * 256 + rl];
            if (pair >= 0) { const float cb = comb[pair]; bf16* rowp = H + (size_t)pair * 512 + 4 * fq;
#pragma unroll
                for (int bj = 0; bj < 2; ++bj) { const f32x4 g = acc[ai][bj][m][0], up = acc[ai][bj][m][1]; u32x2 w;
                    w.x = pk2(siluf_(g[0]) * up[0] * cb, siluf_(g[1]) * up[1] * cb); w.y = pk2(siluf_(g[2]) * up[2] * cb, siluf_(g[3]) * up[3] * cb);
                    *(u32x2*)(rowp + 16 * (8 * u.pn + 4 * bj + wc)) = w; } } EPI_ROWS_END
    }
};
struct EpiMoeY {
    bf16* Y; const LAS int* ptab;
    __device__ __forceinline__ void operator()(const f32x4 (&acc)[2][2][4][2], const Unit& u, int wr, int wc, int fr, int fq) const {
        EPI_ROWS_BEGIN const int pair = ptab[u.ui * 256 + rl];
            if (pair >= 0) { bf16* rowp = Y + (size_t)pair * D + u.pn * BM + wc * 32 + 4 * fq;
#pragma unroll
                for (int bj = 0; bj < 2; ++bj)
#pragma unroll
                    for (int n = 0; n < 2; ++n) { const f32x4 v = acc[ai][bj][m][n]; u32x2 w; w.x = pk2(v[0], v[1]); w.y = pk2(v[2], v[3]); *(u32x2*)(rowp + bj * HALF + n * 16) = w; } } EPI_ROWS_END
    }
};
}

namespace fg {
constexpr int TM = 256, TN = 256, BK = 32, STG = 49152, NSTG = 3, MAXU = 6;
struct Tables { const LAS int* cnt; const LAS int* preU; const LAS int* ptab; const LAS int* utab; const LAS float* ctab; unsigned* flags; int stride, c0; };
__device__ __forceinline__ bool decode(const Tables& tb, int i, int& e, int& rt, int& ct) {
    if (i >= MAXU || tb.c0 < 0) return false;
    const int L = i * tb.stride + tb.c0; if (L >= tb.preU[32]) return false;
    e = 0;
    for (int j = 1; j < 32; ++j) e = (tb.preU[j] <= L) ? j : e;
    const int nrt = (tb.cnt[e] + 255) >> 8, r = L - tb.preU[e]; ct = r / nrt; rt = r - ct * nrt; return true;
}
template <int MODE, int DRY = 0>
__device__ __forceinline__ void fgemm_phase(const int tid, LAS unsigned char* lds, const Tables& tb, const char* Abase, const float* W1l, const float* W3l, bf16* Out, const int ub, const int ue) {
    constexpr int K = MODE == 0 ? 2048 : 512, NT = K / BK, LDN = MODE == 0 ? 512 : 2048;
    constexpr unsigned RBYTES = MODE == 0 ? 4096u : 1024u;
    const int wid = __builtin_amdgcn_readfirstlane(tid >> 6), lane = tid & 63, wr = wid >> 2, wc = wid & 3, fr = lane & 15, fq = lane >> 4;
    const unsigned ldsw = (unsigned)wid * 1024u;
    const int bc0 = 4 * lane, bc1 = (4 * lane) ^ 16;
    const int aoff = wr * 8192 + ((fr * 64 + fq * 16) ^ (((fr >> 3) & 1) << 5));
    const int bfo = 16384 + ((8 * fq) * 256 + ((wc * 64 + 2 * fr) ^ ((fq & 1) << 4))) * 4;
    const int nunits = ue;
    if (ue <= ub) return;
    const int total = (ue - ub) * NT;
    f32x4 acc[8][4];
#pragma unroll
    for (int m = 0; m < 8; ++m)
#pragma unroll
        for (int n = 0; n < 4; ++n) acc[m][n] = (f32x4){0.f, 0.f, 0.f, 0.f};
    int su = ub, skt = 0, ns = 0, sb3 = 0; unsigned s_aro[2]; const float* s_b0; const float* s_b1;
#define FG_BSRC(bc_, e_, ct_) (MODE == 0 ? ((((bc_) >> 5) & 1) ? W3l : W1l) + (size_t)(e_) * 2048 * 512 + (size_t)wid * 512 + (ct_) * 128 + 32 * ((bc_) >> 6) + ((bc_) & 31) \
                                         : W1l + (size_t)(e_) * 512 * 2048 + (size_t)wid * 2048 + (ct_) * 256 + (bc_))
#define FG_LOAD_UNIT(u_) do { const int e_ = tb.utab[3 * (u_)], ct_ = tb.utab[3 * (u_) + 2]; \
        if (MODE == 1 && tb.flags) {     \
            unsigned* fl_ = tb.flags + (e_ * 32 + tb.utab[3 * (u_) + 1]) * 16; unsigned sp_ = 0; \
            while (__hip_atomic_load(fl_, __ATOMIC_RELAXED, __HIP_MEMORY_SCOPE_AGENT) < 4u) { __builtin_amdgcn_s_sleep(4); if (++sp_ > (1u << 22)) break; } \
            __builtin_amdgcn_fence(__ATOMIC_ACQUIRE, "agent"); } \
        _Pragma("unroll") for (int i_ = 0; i_ < 2; ++i_) { const int b_ = i_ * 8192 + tid * 16, st_ = b_ >> 10, sb_ = b_ & 1023, swz_ = sb_ ^ (((sb_ >> 9) & 1) << 5); \
            const int p_ = tb.ptab[(u_) * 256 + st_ * 16 + swz_ / 64]; \
            s_aro[i_] = (p_ < 0 ? 0u : (MODE == 0 ? ((unsigned)p_ & 8191u) : (unsigned)p_) * RBYTES) + (unsigned)(swz_ % 64); } \
        s_b0 = FG_BSRC(bc0, e_, ct_); s_b1 = FG_BSRC(bc1, e_, ct_); } while (0)
#define FG_STAGE() do { LAS unsigned char* st_ = lds + sb3 * STG; \
        _Pragma("unroll") for (int i_ = 0; i_ < 2; ++i_) \
            __builtin_amdgcn_global_load_lds((const unsigned*)(Abase + (s_aro[i_] + (unsigned)skt * 64u)), (LAS unsigned*)(st_ + ldsw + i_ * 8192), 16, 0, 0); \
        _Pragma("unroll") for (int r_ = 0; r_ < 4; ++r_) __builtin_amdgcn_global_load_lds((const unsigned*)(((r_ & 1) ? s_b1 : s_b0) + (size_t)(skt * 32 + r_ * 8) * LDN), (LAS unsigned*)(st_ + 16384 + r_ * 8192 + ldsw), 16, 0, 0); \
        ++ns; sb3 = (sb3 == NSTG - 1) ? 0 : sb3 + 1; if (++skt == NT) { skt = 0; ++su; if (su < nunits) FG_LOAD_UNIT(su); } } while (0)
    FG_LOAD_UNIT(ub);
    FG_STAGE(); if (ns < total) FG_STAGE();
    int s = 0, cb3 = 0;
    for (int u = ub; u < nunits; ++u) {
#pragma unroll 1
        for (int kt = 0; kt < NT; ++kt, ++s) {
            if (ns - 1 - s >= 1) asm volatile("s_waitcnt vmcnt(6)" ::: "memory"); else asm volatile("s_waitcnt vmcnt(0)" ::: "memory");
            __builtin_amdgcn_s_barrier(); asm volatile("" ::: "memory");
            const LAS unsigned char* st = lds + cb3 * STG; cb3 = (cb3 == NSTG - 1) ? 0 : cb3 + 1;
            if (DRY == 2) { if (ns < total) FG_STAGE(); continue; }
            bf16x8 Af[8], Bf[4];
            f32x2 vb[2][8];
#pragma unroll
            for (int p2 = 0; p2 < 2; ++p2) { const LAS float* bp = (const LAS float*)(st + bfo) + p2 * 32;
#pragma unroll
                for (int j = 0; j < 8; ++j) vb[p2][j] = *(const LAS f32x2*)(bp + j * 256); }
#pragma unroll
            for (int m = 0; m < 8; ++m) Af[m] = *(const LAS bf16x8*)(st + aoff + m * 1024);
            if (ns < total) FG_STAGE();
#pragma unroll
            for (int p2 = 0; p2 < 2; ++p2) { const f32x2* v = vb[p2];
                u32x4 w0, w1; w0.x = pk2(v[0].x, v[1].x); w0.y = pk2(v[2].x, v[3].x); w0.z = pk2(v[4].x, v[5].x); w0.w = pk2(v[6].x, v[7].x);
                w1.x = pk2(v[0].y, v[1].y); w1.y = pk2(v[2].y, v[3].y); w1.z = pk2(v[4].y, v[5].y); w1.w = pk2(v[6].y, v[7].y);
                Bf[2 * p2] = __builtin_bit_cast(bf16x8, w0); Bf[2 * p2 + 1] = __builtin_bit_cast(bf16x8, w1); }
            if (DRY == 1) {
#pragma unroll
                for (int m = 0; m < 8; ++m) asm volatile("" :: "v"(Af[m]));
#pragma unroll
                for (int n = 0; n < 4; ++n) asm volatile("" :: "v"(Bf[n]));
                continue; }
            __builtin_amdgcn_s_setprio(1);
#pragma unroll
            for (int m = 0; m < 8; ++m)
#pragma unroll
                for (int n = 0; n < 4; ++n) acc[m][n] = __builtin_amdgcn_mfma_f32_16x16x32_bf16(Bf[n], Af[m], acc[m][n], 0, 0, 0);
            __builtin_amdgcn_s_setprio(0);
        }
        if (DRY == 0) {
            const int ct = tb.utab[3 * u + 2];
#pragma unroll
            for (int m = 0; m < 8; ++m) { const int ri = u * 256 + wr * 128 + m * 16 + fr; const int pair = tb.ptab[ri];
                if (pair >= 0) {
                    if (MODE == 0) { const float cb = tb.ctab[ri]; bf16* rowp = Out + (size_t)pair * 512 + ct * 128 + wc * 32 + 8 * fq;
                        const f32x4 g0 = acc[m][0], g1 = acc[m][1], u0 = acc[m][2], u1 = acc[m][3]; u32x4 w;
                        w.x = pk2(siluf_(g0[0]) * u0[0] * cb, siluf_(g1[0]) * u1[0] * cb); w.y = pk2(siluf_(g0[1]) * u0[1] * cb, siluf_(g1[1]) * u1[1] * cb);
                        w.z = pk2(siluf_(g0[2]) * u0[2] * cb, siluf_(g1[2]) * u1[2] * cb); w.w = pk2(siluf_(g0[3]) * u0[3] * cb, siluf_(g1[3]) * u1[3] * cb);
                        *(u32x4*)rowp = w; }
                    else { bf16* rowp = Out + (size_t)pair * D + ct * 256 + wc * 64 + 8 * fq;
#pragma unroll
                        for (int p2 = 0; p2 < 2; ++p2) { const f32x4 a = acc[m][2 * p2], b = acc[m][2 * p2 + 1]; u32x4 w;
                            w.x = pk2(a[0], b[0]); w.y = pk2(a[1], b[1]); w.z = pk2(a[2], b[2]); w.w = pk2(a[3], b[3]); *(u32x4*)(rowp + 32 * p2) = w; } } } }
#pragma unroll
            for (int m = 0; m < 8; ++m)
#pragma unroll
                for (int n = 0; n < 4; ++n) acc[m][n] = (f32x4){0.f, 0.f, 0.f, 0.f};
        }
    }
    asm volatile("s_waitcnt vmcnt(0)" ::: "memory");
    __syncthreads();
#undef FG_LOAD_UNIT
#undef FG_STAGE
#undef FG_BSRC
}
}

__device__ __forceinline__ void tr_item(const float* W, int ld, int K, int N, int col0, bf16* WT, int mode, int row_off, int item, int lane, const float* gk = nullptr) {
    const int nblk = N / 64, kb = item / nblk, nb = item - kb * nblk, k0 = 32 * kb, n0 = 64 * nb;
    const int kg = lane >> 4, c4 = lane & 15;
    const float* src = W + (size_t)(k0 + 8 * kg) * ld + col0 + n0 + 4 * c4;
    f32x4 v[8];
#pragma unroll
    for (int q = 0; q < 8; ++q) v[q] = *(const f32x4*)(src + (size_t)q * ld);
    if (gk) {
#pragma unroll
        for (int q = 0; q < 8; ++q) v[q] = v[q] * gk[k0 + 8 * kg + q]; }
#pragma unroll
    for (int i = 0; i < 4; ++i) { const int n = n0 + 4 * c4 + i; const int row = mode == 1 ? (32 * (n >> 4) + (n & 15) + row_off) : mode == 2 ? ((n & ~31) + 16 * ((n >> 2) & 1) + 4 * ((n & 31) >> 3) + (n & 3) + row_off) : (n + row_off);
        u32x4 o; o.x = pk2(v[0][i], v[1][i]); o.y = pk2(v[2][i], v[3][i]); o.z = pk2(v[4][i], v[5][i]); o.w = pk2(v[6][i], v[7][i]);
        *(u32x4*)(WT + (size_t)row * K + k0 + 8 * kg) = o; }
}
__device__ __forceinline__ void wcomb_item(const float* win, const float* wg, bf16* WT, int item, int lane, const float* gk) {
    const int jb = item & 7, kb = item >> 3, j = jb * 64 + lane, k0 = kb * 8;
    float g[16];
#pragma unroll
    for (int r = 0; r < 16; ++r) g[r] = wg[r * 512 + j];
    float o[8];
#pragma unroll
    for (int q = 0; q < 8; ++q) { const float* wr_ = win + (size_t)(k0 + q) * EV_IN + 5120; float s = 0.f;
#pragma unroll
        for (int r = 0; r < 16; ++r) s += wr_[r] * g[r];
        o[q] = s * gk[k0 + q]; }
    u32x4 w; w.x = pk2(o[0], o[1]); w.y = pk2(o[2], o[3]); w.z = pk2(o[4], o[5]); w.w = pk2(o[6], o[7]);
    *(u32x4*)(WT + (size_t)(5120 + (j & ~31) + 16 * ((j >> 2) & 1) + 4 * ((j & 31) >> 3) + (j & 3)) * D + k0) = w;
}
template <bool SRC_BF16, bool ADDY, bool WRITE_RES, int OUT>
__device__ __forceinline__ void norm_row(const void* src, const bf16* y0, const bf16* y1, bf16* res, const float* g, bf16* xn, float* of32, float* rs_out, int lane) {
    f32x4 va[4], vb[4]; float ss = 0.f;
#pragma unroll
    for (int j = 0; j < 4; ++j) { const int col = 8 * lane + 512 * j;
        if (SRC_BF16) { const u32x4 w = *(const u32x4*)((const bf16*)src + col); va[j] = up4((u32x2){w.x, w.y}); vb[j] = up4((u32x2){w.z, w.w}); }
        else { va[j] = *(const f32x4*)((const float*)src + col); vb[j] = *(const f32x4*)((const float*)src + col + 4); }
        if (ADDY) { const u32x4 a = *(const u32x4*)(y0 + col), b = *(const u32x4*)(y1 + col);
            va[j] = va[j] + up4((u32x2){a.x, a.y}) + up4((u32x2){b.x, b.y}); vb[j] = vb[j] + up4((u32x2){a.z, a.w}) + up4((u32x2){b.z, b.w}); }
        if (WRITE_RES) { const u32x2 wl = dn4(va[j]), wh = dn4(vb[j]); *(u32x4*)(res + col) = (u32x4){wl.x, wl.y, wh.x, wh.y}; va[j] = up4(wl); vb[j] = up4(wh); }
        ss += ((va[j][0] * va[j][0] + va[j][1] * va[j][1]) + (va[j][2] * va[j][2] + va[j][3] * va[j][3])) + ((vb[j][0] * vb[j][0] + vb[j][1] * vb[j][1]) + (vb[j][2] * vb[j][2] + vb[j][3] * vb[j][3])); }
    const float rs = rsqrtf(wave_sum(ss) * (1.0f / D) + EPS);
    if (rs_out && lane == 0) *rs_out = rs;
    if (OUT != 0) {
#pragma unroll
        for (int j = 0; j < 4; ++j) { const int col = 8 * lane + 512 * j; const f32x4 oa = va[j] * rs * *(const f32x4*)(g + col), ob = vb[j] * rs * *(const f32x4*)(g + col + 4);
            if (OUT == 1) { const u32x2 wl = dn4(oa), wh = dn4(ob); *(u32x4*)(xn + col) = (u32x4){wl.x, wl.y, wh.x, wh.y}; } else { *(f32x4*)(of32 + col) = oa; *(f32x4*)(of32 + col + 4) = ob; } } }
}

__device__ __forceinline__ void p0_prologue(Frame& F, KArgs& A) {
    const int gw = F.vcu * NWAVES + F.wave, NGW = F.G * NWAVES, lane = F.lane;
    unsigned char* ws = F.ws;
    constexpr int I_WIN = (D / 32) * (5120 / 64);
    constexpr int I_WC = (D / 8) * 8;
    constexpr int I_WOUT = (D / 32) * (D / 64);
    constexpr int I_ODW = (D / 32) * (1024 / 64);
    constexpr int I_GLU = (1024 / 32) * (2048 / 64);
    constexpr int I_PLEG = I_WOUT;
    constexpr int I_PLEP = (256 / 32) * (D / 64);
    constexpr int I_W1 = (D / 32) * (512 / 64);
    constexpr int I_W2 = (512 / 32) * (D / 64);
    constexpr int N_DENSE = 2 * (I_WIN + I_WC + I_WOUT + I_ODW + 2 * I_GLU) + 4 * (I_PLEG + I_PLEP);
    for (int it = gw; it < N_DENSE; it += NGW) {
        int r = it;
        if (r < 2 * I_WIN) { const int e = r / I_WIN; tr_item(A.in[6] + (size_t)e * D * EV_IN, EV_IN, D, 5120, 0, (bf16*)(ws + WS_WIN + e * SZ_WIN), 2, 0, r % I_WIN, lane, A.in[2] + (size_t)(2 * e) * D); continue; } r -= 2 * I_WIN;
        if (r < 2 * I_WC) { const int e = r / I_WC; wcomb_item(A.in[6] + (size_t)e * D * EV_IN, A.in[14] + (size_t)e * 16 * 512, (bf16*)(ws + WS_WIN + e * SZ_WIN), r % I_WC, lane, A.in[2] + (size_t)(2 * e) * D); continue; } r -= 2 * I_WC;
        if (r < 2 * I_WOUT) { const int e = r / I_WOUT; tr_item(A.in[17] + (size_t)e * D * D, D, D, D, 0, (bf16*)(ws + WS_WOUT + e * SZ_DD), 2, 0, r % I_WOUT, lane); continue; } r -= 2 * I_WOUT;
        if (r < 2 * I_ODW) { const int o = r / I_ODW; tr_item(A.in[18] + (size_t)o * D * 1024, 1024, D, 1024, 0, (bf16*)(ws + WS_ODWIN + o * SZ_ODWIN), 2, 0, r % I_ODW, lane, A.in[2] + (size_t)(2 * o + 1) * D); continue; } r -= 2 * I_ODW;
        if (r < 4 * I_GLU) { const int o = r / (2 * I_GLU), hf = (r / I_GLU) & 1; tr_item(A.in[27] + (size_t)o * 1024 * 4096, 4096, 1024, 2048, hf * 2048, (bf16*)(ws + WS_WGLU + o * SZ_WGLU), 1, hf * 16, r % I_GLU, lane); continue; } r -= 4 * I_GLU;
        if (r < 4 * I_PLEG) { const int l = r / I_PLEG; tr_item(A.in[35] + (size_t)l * D * D, D, D, D, 0, (bf16*)(ws + WS_PLEG + l * SZ_DD), 2, 0, r % I_PLEG, lane, A.in[4] + (size_t)l * D); continue; } r -= 4 * I_PLEG;
        { const int l = r / I_PLEP; tr_item(A.in[37] + (size_t)l * 256 * D, D, 256, D, 0, (bf16*)(ws + WS_PLEP + l * SZ_PLEP), 2, 0, r % I_PLEP, lane); }
    }
    for (int i = gw * 64 + lane; i < 4 * 16 * 4 * 48 * 40; i += NGW * 64) {
        const int k = i % 40, o = (i / 40) % 48, q = (i / (40 * 48)) & 3, t = (i / (40 * 48 * 4)) & 15, l = i / (40 * 48 * 64);
        unsigned hb = 0u, lb = 0u;
        if (o < 36 && k < 32) { const int kk = 512 * q + 32 * t + k;
            const float wv = o < 4 ? A.in[28][((size_t)l * D + kk) * 4 + o] : A.in[30][((size_t)l * D + kk) * 32 + (o - 4)];
            const float wf = wv * A.in[3][(size_t)l * D + kk]; hb = f2bf(wf); lb = f2bf(wf - bf2f(hb)); }
        bf16* img = (bf16*)(ws + WS_RTW) + (size_t)(l * 16 + t) * RTW_IMG + (q * 48 + o) * 40 + k;
        img[0] = (bf16)hb; img[4 * 48 * 40] = (bf16)lb;
    }
    { const float* p = A.in[1]; bf16* pb = (bf16*)(ws + WS_PB); const size_t n8 = (size_t)4 * T * 256 / 8;
        for (size_t i = (size_t)gw * 64 + lane; i < n8; i += (size_t)NGW * 64) { const f32x4 a = *(const f32x4*)(p + i * 8), b = *(const f32x4*)(p + i * 8 + 4);
            u32x4 w; w.x = pk2(a[0], a[1]); w.y = pk2(a[2], a[3]); w.z = pk2(b[0], b[1]); w.w = pk2(b[2], b[3]); *(u32x4*)(pb + i * 8) = w; } }
    for (int m = gw; m < T; m += NGW)
        norm_row<false, false, true, 0>(A.in[0] + (size_t)m * D, nullptr, nullptr, (bf16*)(ws + WS_XRES) + (size_t)m * D, nullptr, nullptr, nullptr, (float*)(ws + WS_RS) + m, lane);
}

__device__ __forceinline__ void lru_unit(Frame& F, KArgs& A, int e, int unit) {
    const int tid = F.tid, lane = F.lane, w = F.wave, b = unit >> 6, h = (unit >> 2) & 15, jq = unit & 3, n16 = lane & 15, kq = lane >> 4;
    LAS bf16* ZT = (LAS bf16*)F.lds;
    LAS bf16* XCB = ZT + 259 * 72;
    LAS float* aa = (LAS float*)(XCB + 256 * 72);
    LAS float* uu = aa + 4096;
    LAS bf16* GT = (LAS bf16*)(uu + 4096);
    LAS bf16* YT = GT + 4096;
    LAS float* sA = (LAS float*)(YT + 4096);
    LAS float* sH = sA + 512;
    LAS float* cin = sH + 512;
    LAS float* carry = cin + 512;
    LAS float* cw = carry + 16;
    const bf16* z = (const bf16*)(F.ws + WS_Z);
    bf16* ycat = (bf16*)(F.ws + WS_YCAT);
    float cwr[5][8];
    { const int c8 = tid & 7;
#pragma unroll
        for (int k = 0; k < 4; ++k) { const float* src = A.in[7] + ((size_t)e * 4 + k) * 1024 + h * 64 + c8 * 8; const f32x4 a = *(const f32x4*)src, b4 = *(const f32x4*)(src + 4);
            cwr[k][0] = a[0]; cwr[k][1] = a[1]; cwr[k][2] = a[2]; cwr[k][3] = a[3]; cwr[k][4] = b4[0]; cwr[k][5] = b4[1]; cwr[k][6] = b4[2]; cwr[k][7] = b4[3]; }
        const float* sb = A.in[8] + (size_t)e * 1024 + h * 64 + c8 * 8; const f32x4 a = *(const f32x4*)sb, b4 = *(const f32x4*)(sb + 4);
        cwr[4][0] = a[0]; cwr[4][1] = a[1]; cwr[4][2] = a[2]; cwr[4][3] = a[3]; cwr[4][4] = b4[0]; cwr[4][5] = b4[1]; cwr[4][6] = b4[2]; cwr[4][7] = b4[3]; }
    bf16x8 WAf[2], WXf[2];
    { const float* w_a = A.in[9] + ((size_t)(e * 16 + h) * 64) * 64 + jq * 16 + n16; const float* w_x = A.in[11] + ((size_t)(e * 16 + h) * 64) * 64 + jq * 16 + n16;
#pragma unroll
        for (int ks = 0; ks < 2; ++ks) { float va[8], vx[8];
#pragma unroll
            for (int j = 0; j < 8; ++j) { va[j] = w_a[(size_t)(32 * ks + 8 * kq + j) * 64]; vx[j] = w_x[(size_t)(32 * ks + 8 * kq + j) * 64]; }
            WAf[ks] = __builtin_bit_cast(bf16x8, (u32x4){pk2(va[0], va[1]), pk2(va[2], va[3]), pk2(va[4], va[5]), pk2(va[6], va[7])});
            WXf[ks] = __builtin_bit_cast(bf16x8, (u32x4){pk2(vx[0], vx[1]), pk2(vx[2], vx[3]), pk2(vx[4], vx[5]), pk2(vx[6], vx[7])}); } }
    float ba[4], bx[4], sp[4];
#pragma unroll
    for (int r = 0; r < 4; ++r) { const int ch = h * 64 + jq * 16 + 4 * kq + r; ba[r] = A.in[10][e * 1024 + ch]; bx[r] = A.in[12][e * 1024 + ch]; sp[r] = -8.0f * softplusf_(-A.in[13][e * 1024 + ch]); }
    u32x4 pz[4], pg;
#define LRU_PREFETCH(s0_) do { _Pragma("unroll") for (int r_ = 0; r_ < 4; ++r_) { const int piece = r_ * 512 + tid; pz[r_] = *(const u32x4*)(z + (size_t)(b * SEQ + (s0_) + (piece >> 3)) * ZW + h * 64 + (piece & 7) * 8); } \
        pg = *(const u32x4*)(z + (size_t)(b * SEQ + (s0_) + (tid >> 1)) * ZW + 1024 + h * 64 + jq * 16 + (tid & 1) * 8); } while (0)
    LRU_PREFETCH(0);
    const int tl = tid >> 1, half = tid & 1;
#pragma unroll 1
    for (int tb = 0; tb < 8; ++tb) {
        const int s0 = tb * 256;
        u32x4 halo = (u32x4){0u, 0u, 0u, 0u};
        if (tb > 0 && tid < 24) halo = *(const LAS u32x4*)(ZT + (256 + (tid >> 3)) * 72 + (tid & 7) * 8);
        LDS_BARRIER();
        if (tid < 24) *(LAS u32x4*)(ZT + (tid >> 3) * 72 + (tid & 7) * 8) = halo;
#pragma unroll
        for (int r = 0; r < 4; ++r) { const int piece = r * 512 + tid; *(LAS u32x4*)(ZT + (3 + (piece >> 3)) * 72 + (piece & 7) * 8) = pz[r]; }
        *(LAS u32x4*)(GT + (tid >> 1) * 16 + (tid & 1) * 8) = pg;
        if (tb < 7) LRU_PREFETCH(s0 + 256);
        LDS_BARRIER();
        { const int tg4 = tid >> 3, c8 = tid & 7; float xr[7][8];
#pragma unroll
            for (int r = 0; r < 7; ++r) { const u32x4 wv = *(const LAS u32x4*)(ZT + (4 * tg4 + r) * 72 + c8 * 8);
                xr[r][0] = lo16(wv.x); xr[r][1] = hi16(wv.x); xr[r][2] = lo16(wv.y); xr[r][3] = hi16(wv.y); xr[r][4] = lo16(wv.z); xr[r][5] = hi16(wv.z); xr[r][6] = lo16(wv.w); xr[r][7] = hi16(wv.w); }
#pragma unroll
            for (int i = 0; i < 4; ++i) { float accv[8];
#pragma unroll
                for (int q = 0; q < 8; ++q) { accv[q] = cwr[4][q];
#pragma unroll
                    for (int k = 0; k < 4; ++k) accv[q] += cwr[k][q] * xr[i + k][q]; }
                *(LAS u32x4*)(XCB + (4 * tg4 + i) * 72 + c8 * 8) = (u32x4){pk2(accv[0], accv[1]), pk2(accv[2], accv[3]), pk2(accv[4], accv[5]), pk2(accv[6], accv[7])}; } }
        LDS_BARRIER();
#pragma unroll
        for (int tt2 = 0; tt2 < 2; ++tt2) { const int tok = (2 * w + tt2) * 16 + n16; f32x4 da = (f32x4){0.f, 0.f, 0.f, 0.f}, dx = da;
#pragma unroll
            for (int ks = 0; ks < 2; ++ks) { const bf16x8 xf = *(const LAS bf16x8*)(XCB + tok * 72 + 32 * ks + 8 * kq);
                da = __builtin_amdgcn_mfma_f32_16x16x32_bf16(WAf[ks], xf, da, 0, 0, 0); dx = __builtin_amdgcn_mfma_f32_16x16x32_bf16(WXf[ks], xf, dx, 0, 0, 0); }
            const u32x2 xw = *(const LAS u32x2*)(XCB + tok * 72 + jq * 16 + 4 * kq); const float xo[4] = {lo16(xw.x), hi16(xw.x), lo16(xw.y), hi16(xw.y)};
            f32x4 av, uv;
#pragma unroll
            for (int r = 0; r < 4; ++r) { const float rg = sigmoidf_(da[r] + ba[r]), ig = sigmoidf_(dx[r] + bx[r]); const float la = rg * sp[r];
                av[r] = __expf(la); uv[r] = __builtin_amdgcn_sqrtf(fmaxf(one_minus_exp(2.0f * la), 0.f)) * ig * xo[r]; }
            *(LAS f32x4*)(aa + tok * 16 + 4 * kq) = av; *(LAS f32x4*)(uu + tok * 16 + 4 * kq) = uv; }
        LDS_BARRIER();
        const int ch = tid & 15, seg = tid >> 4;
        { float Ac = 1.f, Hh = 0.f;
#pragma unroll
            for (int q = 0; q < 8; ++q) { const float a = aa[(seg * 8 + q) * 16 + ch], u = uu[(seg * 8 + q) * 16 + ch]; Hh = a * Hh + u; Ac *= a; }
            sA[seg * 16 + ch] = Ac; sH[seg * 16 + ch] = Hh; }
        LDS_BARRIER();
        if (tid < 16) { float c = (tb == 0) ? 0.f : carry[tid];
#pragma unroll 4
            for (int sg = 0; sg < 32; ++sg) { cin[sg * 16 + tid] = c; c = sA[sg * 16 + tid] * c + sH[sg * 16 + tid]; }
            carry[tid] = c; }
        LDS_BARRIER();
        { float hh = cin[seg * 16 + ch];
#pragma unroll
            for (int q = 0; q < 8; ++q) { const int tq = seg * 8 + q; hh = aa[tq * 16 + ch] * hh + uu[tq * 16 + ch];
                YT[tq * 16 + ch] = (bf16)f2bf(hh * gelu_tanh(bf2f(GT[tq * 16 + ch]))); } }
        LDS_BARRIER();
        *(u32x4*)(ycat + (size_t)(b * SEQ + s0 + (tid >> 1)) * D + h * 64 + jq * 16 + (tid & 1) * 8) = *(const LAS u32x4*)(YT + (tid >> 1) * 16 + (tid & 1) * 8);
    }
#undef LRU_PREFETCH
    LDS_BARRIER();
}

__device__ __forceinline__ void gla_bcum(Frame& F, KArgs& A, int e, int h, size_t t0, LAS float* buf, int stride, LAS float* bl, LAS float* seg4) {
    const int tid = F.tid; const bf16* z = (const bf16*)(F.ws + WS_Z);
    { const int t = tid >> 3, d0 = (tid & 7) * 16; const bf16* zr = z + (t0 + t) * ZW + 5120 + h * 128 + d0; const float* bg = A.in[15] + e * 512 + h * 128 + d0;
#pragma unroll
        for (int c8 = 0; c8 < 2; ++c8) { const u32x4 w = *(const u32x4*)(zr + c8 * 8); LAS float* o = buf + t * stride + d0 + c8 * 8; const float* bb = bg + c8 * 8;
            o[0] = logsigmoidf_(lo16(w.x) + bb[0]) * 0.0625f; o[1] = logsigmoidf_(hi16(w.x) + bb[1]) * 0.0625f; o[2] = logsigmoidf_(lo16(w.y) + bb[2]) * 0.0625f; o[3] = logsigmoidf_(hi16(w.y) + bb[3]) * 0.0625f;
            o[4] = logsigmoidf_(lo16(w.z) + bb[4]) * 0.0625f; o[5] = logsigmoidf_(hi16(w.z) + bb[5]) * 0.0625f; o[6] = logsigmoidf_(lo16(w.w) + bb[6]) * 0.0625f; o[7] = logsigmoidf_(hi16(w.w) + bb[7]) * 0.0625f; } }
    __syncthreads();
    const int d = tid & 127, sg = tid >> 7; float v[16];
    { float run = 0.f;
#pragma unroll
        for (int j = 0; j < 16; ++j) { run += buf[(sg * 16 + j) * stride + d]; v[j] = run; }
        seg4[sg * 128 + d] = run; }
    __syncthreads();
    { float off = 0.f;
#pragma unroll
        for (int q = 0; q < 3; ++q) off += (q < sg) ? seg4[q * 128 + d] : 0.f;
#pragma unroll
        for (int j = 0; j < 16; ++j) buf[(sg * 16 + j) * stride + d] = v[j] + off;
        if (sg == 3) bl[d] = v[15] + off; }
    __syncthreads();
}
typedef short s16x4 __attribute__((ext_vector_type(4)));
__device__ __forceinline__ bf16x8 tr_frag(const LAS bf16* tile, int rs  , int row0, int col0, int lane) {
    const int g = lane >> 4, q = (lane & 15) >> 2, p = lane & 3;
    const LAS bf16* a0 = tile + (row0 + 8 * g + q) * rs + col0 + 4 * p;
    const s16x4 lo = __builtin_amdgcn_ds_read_tr16_b64_v4i16((LAS s16x4*)a0), hi = __builtin_amdgcn_ds_read_tr16_b64_v4i16((LAS s16x4*)(a0 + 4 * rs));
    return (bf16x8){lo[0], lo[1], lo[2], lo[3], hi[0], hi[1], hi[2], hi[3]};
}
__device__ __forceinline__ void gla_ds_unit(Frame& F, KArgs& A, int e, int unit) {
    const int tid = F.tid, lane = F.lane, w = F.wave, b = unit >> 7, h = (unit >> 5) & 3, c = unit & 31, bh = b * 4 + h; const size_t t0 = (size_t)b * SEQ + c * 64;
    const int n16 = lane & 15, kq = lane >> 4;
    LAS float* BC = (LAS float*)F.lds;
    LAS bf16* KE = (LAS bf16*)(F.lds + 33792);
    LAS bf16* VT = KE + 64 * 136;
    LAS float* BL = (LAS float*)(VT + 64 * 272);
    LAS float* SEG = BL + 128;
    const bf16* z = (const bf16*)(F.ws + WS_Z);
    gla_bcum(F, A, e, h, t0, BC, 132, BL, SEG);
    { const int t = tid >> 3, d0 = (tid & 7) * 16; const bf16* zr = z + (t0 + t) * ZW + 2560 + h * 128 + d0;
#pragma unroll
        for (int c8 = 0; c8 < 2; ++c8) { const u32x4 kw = *(const u32x4*)(zr + c8 * 8); const LAS float* bc = BC + t * 132 + d0 + c8 * 8; const LAS float* bl = BL + d0 + c8 * 8;
            const float kv[8] = {lo16(kw.x), hi16(kw.x), lo16(kw.y), hi16(kw.y), lo16(kw.z), hi16(kw.z), lo16(kw.w), hi16(kw.w)}; float ko[8];
#pragma unroll
            for (int j = 0; j < 8; ++j) ko[j] = kv[j] * __expf(bl[j] - bc[j]);
            *(LAS u32x4*)(KE + t * 136 + d0 + c8 * 8) = (u32x4){pk2(ko[0], ko[1]), pk2(ko[2], ko[3]), pk2(ko[4], ko[5]), pk2(ko[6], ko[7])}; }
        const int v0 = (tid & 7) * 32; const bf16* vr = z + (t0 + t) * ZW + 3072 + h * 256 + v0;
#pragma unroll
        for (int c8 = 0; c8 < 4; ++c8) *(LAS u32x4*)(VT + t * 272 + v0 + c8 * 8) = *(const u32x4*)(vr + c8 * 8); }
    if (tid < 128) ((float*)(F.ws + WS_DECAY))[(size_t)(bh * 32 + c) * 128 + tid] = __expf(BL[tid]);
    __syncthreads();
    f32x4 acc[2][8];
#pragma unroll
    for (int vb = 0; vb < 2; ++vb)
#pragma unroll
        for (int db = 0; db < 8; ++db) acc[vb][db] = (f32x4){0.f, 0.f, 0.f, 0.f};
#pragma unroll
    for (int ks = 0; ks < 2; ++ks) { bf16x8 af[2];
#pragma unroll
        for (int vb = 0; vb < 2; ++vb) af[vb] = tr_frag(VT, 272, 32 * ks, (2 * w + vb) * 16, lane);
#pragma unroll
        for (int db = 0; db < 8; ++db) { const bf16x8 bfr = tr_frag(KE, 136, 32 * ks, db * 16, lane);
#pragma unroll
            for (int vb = 0; vb < 2; ++vb) acc[vb][db] = __builtin_amdgcn_mfma_f32_16x16x32_bf16(af[vb], bfr, acc[vb][db], 0, 0, 0); } }
    bf16* ds = (bf16*)(F.ws + WS_DS) + (size_t)(bh * 32 + c) * 128 * 256;
#pragma unroll
    for (int db = 0; db < 8; ++db)
#pragma unroll
        for (int vb = 0; vb < 2; ++vb) *(u32x2*)(ds + (size_t)(db * 16 + n16) * 256 + (2 * w + vb) * 16 + 4 * kq) = dn4(acc[vb][db]);
    LDS_BARRIER();
}
__device__ __forceinline__ void gla_state_phase(Frame& F) {
    const bf16* ds = (const bf16*)(F.ws + WS_DS); bf16* sp = (bf16*)(F.ws + WS_SPREV); const float* dec = (const float*)(F.ws + WS_DECAY);
    for (int it = F.vcu * NTHR + F.tid; it < 16 * 128 * 32; it += F.G * NTHR) {
        const int bh = it >> 12, d = (it >> 5) & 127, v8 = it & 31; f32x4 sa = (f32x4){0.f, 0.f, 0.f, 0.f}, sb = sa;
#pragma unroll 1
        for (int c0 = 0; c0 < 32; c0 += 8) { u32x4 dv[8]; float dc[8];
#pragma unroll
            for (int j = 0; j < 8; ++j) { const size_t idx = ((size_t)(bh * 32 + c0 + j) * 128 + d) * 256 + v8 * 8; dv[j] = *(const u32x4*)(ds + idx); dc[j] = dec[(size_t)(bh * 32 + c0 + j) * 128 + d]; }
#pragma unroll
            for (int j = 0; j < 8; ++j) { const size_t idx = ((size_t)(bh * 32 + c0 + j) * 128 + d) * 256 + v8 * 8;
                *(u32x4*)(sp + idx) = (u32x4){pk2(sa[0], sa[1]), pk2(sa[2], sa[3]), pk2(sb[0], sb[1]), pk2(sb[2], sb[3])};
                sa = sa * dc[j] + up4((u32x2){dv[j].x, dv[j].y}); sb = sb * dc[j] + up4((u32x2){dv[j].z, dv[j].w}); } }
    }
}
__device__ __forceinline__ void gla_out_unit(Frame& F, KArgs& A, int e, int unit) {
    const int tid = F.tid, lane = F.lane, w = F.wave, b = unit >> 7, h = (unit >> 5) & 3, c = unit & 31, bh = b * 4 + h; const size_t t0 = (size_t)b * SEQ + c * 64;
    const int n16 = lane & 15, kq = lane >> 4;
    LAS float* BC = (LAS float*)F.lds;
    LAS bf16* ATT = (LAS bf16*)F.lds;
    LAS bf16* QS = (LAS bf16*)(F.lds + 33792);
    LAS bf16* KS = QS + 64 * 136;
    LAS bf16* VT = KS + 64 * 136;
    LAS bf16* SB = VT + 64 * 272;
    LAS float* RSS = (LAS float*)(SB + 64 * 272);
    LAS float* BL = RSS + 512;
    LAS float* SEG = BL + 128;
    const bf16* z = (const bf16*)(F.ws + WS_Z);
    const bf16* spg = (const bf16*)(F.ws + WS_SPREV) + (size_t)(bh * 32 + c) * 128 * 256;
    gla_bcum(F, A, e, h, t0, BC, 132, BL, SEG);
    u32x4 sb2[4];
    { const int t = tid >> 3, d0 = (tid & 7) * 16; const bf16* qr = z + (t0 + t) * ZW + 2048 + h * 128 + d0; const bf16* kr = z + (t0 + t) * ZW + 2560 + h * 128 + d0;
#pragma unroll
        for (int c8 = 0; c8 < 2; ++c8) { const u32x4 qw = *(const u32x4*)(qr + c8 * 8), kw = *(const u32x4*)(kr + c8 * 8); const LAS float* bc = BC + t * 132 + d0 + c8 * 8;
            const float qv[8] = {lo16(qw.x), hi16(qw.x), lo16(qw.y), hi16(qw.y), lo16(qw.z), hi16(qw.z), lo16(qw.w), hi16(qw.w)};
            const float kv[8] = {lo16(kw.x), hi16(kw.x), lo16(kw.y), hi16(kw.y), lo16(kw.z), hi16(kw.z), lo16(kw.w), hi16(kw.w)};
            float qo[8], ko[8];
#pragma unroll
            for (int j = 0; j < 8; ++j) { const float bcv = bc[j]; qo[j] = qv[j] * 0.08838834764831845f * __expf(bcv); ko[j] = kv[j] * __expf(-bcv); }
            *(LAS u32x4*)(QS + t * 136 + d0 + c8 * 8) = (u32x4){pk2(qo[0], qo[1]), pk2(qo[2], qo[3]), pk2(qo[4], qo[5]), pk2(qo[6], qo[7])};
            *(LAS u32x4*)(KS + t * 136 + d0 + c8 * 8) = (u32x4){pk2(ko[0], ko[1]), pk2(ko[2], ko[3]), pk2(ko[4], ko[5]), pk2(ko[6], ko[7])}; }
        const int v0 = (tid & 7) * 32; const bf16* vr = z + (t0 + t) * ZW + 3072 + h * 256 + v0; const bf16* sr = spg + (size_t)t * 256 + v0;
#pragma unroll
        for (int c8 = 0; c8 < 4; ++c8) { *(LAS u32x4*)(VT + t * 272 + v0 + c8 * 8) = *(const u32x4*)(vr + c8 * 8); *(LAS u32x4*)(SB + t * 272 + v0 + c8 * 8) = *(const u32x4*)(sr + c8 * 8); }
#pragma unroll
        for (int c8 = 0; c8 < 4; ++c8) sb2[c8] = *(const u32x4*)(sr + (size_t)64 * 256 + c8 * 8); }
    LDS_BARRIER();
    { const int ib = w >> 1;
#pragma unroll
        for (int jj = 0; jj < 2; ++jj) { const int jb = (w & 1) * 2 + jj; f32x4 d = (f32x4){0.f, 0.f, 0.f, 0.f};
            if (jb <= ib) {
#pragma unroll
                for (int ks = 0; ks < 4; ++ks) { const bf16x8 kf = *(const LAS bf16x8*)(KS + (16 * jb + n16) * 136 + 32 * ks + 8 * kq), qf = *(const LAS bf16x8*)(QS + (16 * ib + n16) * 136 + 32 * ks + 8 * kq);
                    d = __builtin_amdgcn_mfma_f32_16x16x32_bf16(kf, qf, d, 0, 0, 0); }
#pragma unroll
                for (int r = 0; r < 4; ++r) if (16 * jb + 4 * kq + r > 16 * ib + n16) d[r] = 0.f; }
            *(LAS u32x2*)(ATT + (16 * ib + n16) * 72 + 16 * jb + 4 * kq) = (u32x2){pk2(d[0], d[1]), pk2(d[2], d[3])}; } }
    __syncthreads();
    f32x4 acc[2][4];
#pragma unroll
    for (int vb = 0; vb < 2; ++vb)
#pragma unroll
        for (int ib = 0; ib < 4; ++ib) acc[vb][ib] = (f32x4){0.f, 0.f, 0.f, 0.f};
#pragma unroll
    for (int ks = 0; ks < 2; ++ks) { bf16x8 af[2];
#pragma unroll
        for (int vb = 0; vb < 2; ++vb) af[vb] = tr_frag(VT, 272, 32 * ks, (2 * w + vb) * 16, lane);
#pragma unroll
        for (int ib = 0; ib < 4; ++ib) if (32 * ks <= 16 * ib + 15) { const bf16x8 bfr = *(const LAS bf16x8*)(ATT + (16 * ib + n16) * 72 + 32 * ks + 8 * kq);
#pragma unroll
            for (int vb = 0; vb < 2; ++vb) acc[vb][ib] = __builtin_amdgcn_mfma_f32_16x16x32_bf16(af[vb], bfr, acc[vb][ib], 0, 0, 0); } }
#pragma unroll
    for (int half = 0; half < 2; ++half) {
        if (half == 1) { LDS_BARRIER();
            const int t = tid >> 3, v0 = (tid & 7) * 32;
#pragma unroll
            for (int c8 = 0; c8 < 4; ++c8) *(LAS u32x4*)(SB + t * 272 + v0 + c8 * 8) = sb2[c8];
            LDS_BARRIER(); }
#pragma unroll
        for (int ks = 0; ks < 2; ++ks) { bf16x8 af[2];
#pragma unroll
            for (int vb = 0; vb < 2; ++vb) af[vb] = tr_frag(SB, 272, 32 * ks, (2 * w + vb) * 16, lane);
#pragma unroll
            for (int ib = 0; ib < 4; ++ib) { const bf16x8 bfr = *(const LAS bf16x8*)(QS + (16 * ib + n16) * 136 + 64 * half + 32 * ks + 8 * kq);
#pragma unroll
                for (int vb = 0; vb < 2; ++vb) acc[vb][ib] = __builtin_amdgcn_mfma_f32_16x16x32_bf16(af[vb], bfr, acc[vb][ib], 0, 0, 0); } } }
#pragma unroll
    for (int ib = 0; ib < 4; ++ib) { float ss = 0.f;
#pragma unroll
        for (int vb = 0; vb < 2; ++vb)
#pragma unroll
            for (int r = 0; r < 4; ++r) ss += acc[vb][ib][r] * acc[vb][ib][r];
        ss += shx(ss, 16, lane); ss += shx(ss, 32, lane);
        if (kq == 0) RSS[w * 64 + 16 * ib + n16] = ss; }
    u32x2 gwv[4][2]; f32x4 hnv[2];
#pragma unroll
    for (int vb = 0; vb < 2; ++vb) { const int v = (2 * w + vb) * 16 + 4 * kq; hnv[vb] = *(const f32x4*)(A.in[16] + e * 1024 + h * 256 + v);
#pragma unroll
        for (int ib = 0; ib < 4; ++ib) gwv[ib][vb] = *(const u32x2*)(z + (t0 + 16 * ib + n16) * ZW + 4096 + h * 256 + v); }
    LDS_BARRIER();
#pragma unroll
    for (int ib = 0; ib < 4; ++ib) { float tot = 0.f;
#pragma unroll
        for (int ww = 0; ww < 8; ++ww) tot += RSS[ww * 64 + 16 * ib + n16];
        const float rs = rsqrtf(tot * (1.0f / 256.0f) + EPS); const size_t t = t0 + 16 * ib + n16;
#pragma unroll
        for (int vb = 0; vb < 2; ++vb) { const int v = (2 * w + vb) * 16 + 4 * kq; const f32x4 hn = hnv[vb]; const u32x2 gw = gwv[ib][vb];
            const f32x4 o = acc[vb][ib];
            const float y0 = o[0] * rs * hn[0] * siluf_(lo16(gw.x)), y1 = o[1] * rs * hn[1] * siluf_(hi16(gw.x)), y2 = o[2] * rs * hn[2] * siluf_(lo16(gw.y)), y3 = o[3] * rs * hn[3] * siluf_(hi16(gw.y));
            *(u32x2*)((bf16*)(F.ws + WS_YCAT) + t * D + 1024 + h * 256 + v) = (u32x2){pk2(y0, y1), pk2(y2, y3)}; } }
    LDS_BARRIER();
}

__device__ __forceinline__ void s5_unit(Frame& F, KArgs& A, int o, int unit) {
    const int tid = F.tid, lane = F.lane, w = F.wave, b = unit >> 6, g = unit & 63;
    LAS unsigned* U = (LAS unsigned*)F.lds;
    LAS float* XBall = (LAS float*)(F.lds + 65536);
    LAS float* EE = XBall + 8 * 2560;
    const bf16* u = (const bf16*)(F.ws + WS_U);
#pragma unroll
    for (int r = 0; r < 8; ++r) { const int piece = r * 512 + tid, tok = piece >> 1, hf = piece & 1; const size_t o_ = (size_t)(b * SEQ + tok) * 1024 + g * 16 + hf * 8;
        const u32x4 p0 = *(const u32x4*)(u + o_), p1 = *(const u32x4*)(u + (size_t)T * 1024 + o_);
        *(LAS u32x4*)(U + tok * 8 + hf * 4) = (u32x4){pk2(lo16(p0.x) + lo16(p1.x), hi16(p0.x) + hi16(p1.x)), pk2(lo16(p0.y) + lo16(p1.y), hi16(p0.y) + hi16(p1.y)),
                                                     pk2(lo16(p0.z) + lo16(p1.z), hi16(p0.z) + hi16(p1.z)), pk2(lo16(p0.w) + lo16(p1.w), hi16(p0.w) + hi16(p1.w))}; }
    const int n16 = lane & 15, kq = lane >> 4;
    const size_t gbase = (size_t)(o * 64 + g) * 64;
    const float dt = expf(A.in[21][o * 64 + g]);
    float ab_re, ab_im;
    { const float lr = fminf(A.in[19][gbase + lane], -1e-4f), li = A.in[20][gbase + lane]; const float mag = expf(lr * dt); ab_re = mag * cosf(li * dt); ab_im = mag * sinf(li * dt); }
    bf16x8 Bb[8];
#pragma unroll
    for (int f = 0; f < 4; ++f) { const int p = 16 * f + n16; const float lr = fminf(A.in[19][gbase + p], -1e-4f), li = A.in[20][gbase + p];
        const float mag = expf(lr * dt), are = mag * cosf(li * dt), aim = mag * sinf(li * dt), den = lr * lr + li * li;
        const float cre = ((are - 1.0f) * lr + aim * li) / den, cim = (aim * lr - (are - 1.0f) * li) / den;
        u32x4 wr_ = (u32x4){0u, 0u, 0u, 0u}, wi_ = (u32x4){0u, 0u, 0u, 0u};
        if (kq < 2) { const float* br = A.in[22] + (gbase + p) * 16 + kq * 8; const float* bi = A.in[23] + (gbase + p) * 16 + kq * 8; float vr[8], vi[8];
#pragma unroll
            for (int j = 0; j < 8; ++j) { vr[j] = cre * br[j] - cim * bi[j]; vi[j] = cre * bi[j] + cim * br[j]; }
            wr_ = (u32x4){pk2(vr[0], vr[1]), pk2(vr[2], vr[3]), pk2(vr[4], vr[5]), pk2(vr[6], vr[7])}; wi_ = (u32x4){pk2(vi[0], vi[1]), pk2(vi[2], vi[3]), pk2(vi[4], vi[5]), pk2(vi[6], vi[7])}; }
        Bb[f] = __builtin_bit_cast(bf16x8, wr_); Bb[4 + f] = __builtin_bit_cast(bf16x8, wi_); }
    bf16x8 Ct[4];
#pragma unroll
    for (int ks = 0; ks < 4; ++ks) { const int k0 = 32 * ks + 8 * kq; const float* src = (k0 < 64 ? A.in[24] : A.in[25]) + (gbase / 64 * 16 + n16) * 64 + (k0 & 63); const float sg = k0 < 64 ? 1.0f : -1.0f;
        const u32x4 wv = (u32x4){pk2(sg * src[0], sg * src[1]), pk2(sg * src[2], sg * src[3]), pk2(sg * src[4], sg * src[5]), pk2(sg * src[6], sg * src[7])}; Ct[ks] = __builtin_bit_cast(bf16x8, wv); }
    const f32x4 dsk = *(const f32x4*)(A.in[26] + o * 1024 + g * 16 + kq * 4);
    __syncthreads();
    LAS float* xb = XBall + w * 2560;
    const f32x4 z4 = (f32x4){0.f, 0.f, 0.f, 0.f};
#define S5_BU(tok0) { bf16x8 Uf = (bf16x8){0, 0, 0, 0, 0, 0, 0, 0}; if (kq < 2) Uf = __builtin_bit_cast(bf16x8, *(const LAS u32x4*)(U + ((tok0) + n16) * 8 + kq * 4)); \
        _Pragma("unroll") for (int f = 0; f < 8; ++f) { const f32x4 d = __builtin_amdgcn_mfma_f32_16x16x32_bf16(Uf, Bb[f], z4, 0, 0, 0); \
            *(LAS f32x4*)(xb + (16 * f + n16) * 20 + 4 * kq) = d; } }
#define S5_READ_BU() f32x4 br4[4], bi4[4]; _Pragma("unroll") for (int j = 0; j < 4; ++j) { br4[j] = *(const LAS f32x4*)(xb + lane * 20 + 4 * j); bi4[j] = *(const LAS f32x4*)(xb + (64 + lane) * 20 + 4 * j); }
    float hr = 0.f, hi = 0.f;
    for (int sub = 0; sub < 16; ++sub) { const int tok0 = w * 256 + sub * 16;
        S5_BU(tok0)
        S5_READ_BU()
#pragma unroll
        for (int t = 0; t < 16; ++t) { const float br = br4[t >> 2][t & 3], bi = bi4[t >> 2][t & 3]; const float nr = ab_re * hr - ab_im * hi + br, ni = ab_re * hi + ab_im * hr + bi; hr = nr; hi = ni; } }
    EE[(w * 64 + lane) * 2] = hr; EE[(w * 64 + lane) * 2 + 1] = hi;
    float pr = ab_re, pi = ab_im;
#pragma unroll
    for (int sq = 0; sq < 8; ++sq) { const float nr = pr * pr - pi * pi, ni = 2.0f * pr * pi; pr = nr; pi = ni; }
    __syncthreads();
    hr = 0.f; hi = 0.f;
    for (int sg = 0; sg < w; ++sg) { const float er = EE[(sg * 64 + lane) * 2], ei = EE[(sg * 64 + lane) * 2 + 1]; const float nr = pr * hr - pi * hi + er, ni = pr * hi + pi * hr + ei; hr = nr; hi = ni; }
    for (int sub = 0; sub < 16; ++sub) { const int tok0 = w * 256 + sub * 16;
        S5_BU(tok0)
        S5_READ_BU()
        asm volatile("s_waitcnt lgkmcnt(0)" ::: "memory");
#pragma unroll
        for (int t = 0; t < 16; ++t) { const float br = br4[t >> 2][t & 3], bi = bi4[t >> 2][t & 3]; const float nr = ab_re * hr - ab_im * hi + br, ni = ab_re * hi + ab_im * hr + bi; hr = nr; hi = ni;
            xb[t * 132 + lane] = hr; xb[t * 132 + 64 + lane] = hi; }
        f32x4 y = z4;
#pragma unroll
        for (int ks = 0; ks < 4; ++ks) { const f32x4 h0 = *(const LAS f32x4*)(xb + n16 * 132 + 32 * ks + 8 * kq), h1 = *(const LAS f32x4*)(xb + n16 * 132 + 32 * ks + 8 * kq + 4);
            const u32x4 hw = (u32x4){pk2(h0[0], h0[1]), pk2(h0[2], h0[3]), pk2(h1[0], h1[1]), pk2(h1[2], h1[3])};
            y = __builtin_amdgcn_mfma_f32_16x16x32_bf16(Ct[ks], __builtin_bit_cast(bf16x8, hw), y, 0, 0, 0); }
        const int tok = tok0 + n16; const u32x2 uw = *(const LAS u32x2*)(U + tok * 8 + kq * 2);
        const float y0 = y[0] + dsk[0] * lo16(uw.x), y1 = y[1] + dsk[1] * hi16(uw.x), y2 = y[2] + dsk[2] * lo16(uw.y), y3 = y[3] + dsk[3] * hi16(uw.y);
        u32x2 ow; ow.x = pk2(gelu_tanh(y0), gelu_tanh(y1)); ow.y = pk2(gelu_tanh(y2), gelu_tanh(y3));
        *(u32x2*)((bf16*)(F.ws + WS_YS5) + (size_t)(b * SEQ + tok) * 1024 + g * 16 + kq * 4) = ow; }
#undef S5_BU
#undef S5_READ_BU
    LDS_BARRIER();
}

__device__ __forceinline__ void router_unit(Frame& F, KArgs& A, int l, int unit, const bool dry, const bf16* xres) {
    const int tid = F.tid, lane = F.lane, w = F.wave, tok0 = unit * 32, tg = w >> 2, kc = w & 3, n16 = lane & 15, kq = lane >> 4;
    LAS float* RED = (LAS float*)F.lds;
    LAS float* SSQ = (LAS float*)(F.lds + 5 * RTW_IMG * 2);
    LAS float* RS = SSQ + 128;
    const float* gn = A.in[3] + (size_t)l * D;
    const char* rimg = (const char*)(F.ws + WS_RTW) + (size_t)l * 16 * RTW_IMG * 2;
    f32x4 acc[3]; float ssq = 0.f;
#pragma unroll
    for (int nf = 0; nf < 3; ++nf) acc[nf] = (f32x4){0.f, 0.f, 0.f, 0.f};
    const bf16* xrow = xres + (size_t)(tok0 + tg * 16 + n16) * D + kc * 512 + 8 * kq;
    u32x4 xv[16];
#pragma unroll
    for (int s16 = 0; s16 < 16; ++s16) xv[s16] = *(const u32x4*)(xrow + 32 * s16);
#define RT_DMA(s_) do { const char* src_ = rimg + (size_t)(s_) * (RTW_IMG * 2) + lane * 16; LAS unsigned char* dst_ = F.lds + ((s_) % 5) * (RTW_IMG * 2); \
        _Pragma("unroll") for (int r_ = 0; r_ < 4; ++r_) { int pc_ = r_ * 8 + w; pc_ = pc_ < 30 ? pc_ : 29; \
            __builtin_amdgcn_global_load_lds((const unsigned*)(src_ + pc_ * 1024), (LAS unsigned*)(dst_ + pc_ * 1024), 16, 0, 0); } } while (0)
#define RT_DMA2(s_, b_) do { const char* src_ = rimg + (size_t)(s_) * (RTW_IMG * 2) + lane * 16; LAS unsigned char* dst_ = F.lds + (b_) * (RTW_IMG * 2); \
        _Pragma("unroll") for (int r_ = 0; r_ < 4; ++r_) { int pc_ = r_ * 8 + w; pc_ = pc_ < 30 ? pc_ : 29; \
            __builtin_amdgcn_global_load_lds((const unsigned*)(src_ + pc_ * 1024), (LAS unsigned*)(dst_ + pc_ * 1024), 16, 0, 0); } } while (0)
    RT_DMA(0); RT_DMA(1); RT_DMA(2); RT_DMA(3);
    int rb = 0;
#pragma unroll 1
    for (int so = 0; so < 4; ++so) {
#pragma unroll
        for (int sj = 0; sj < 4; ++sj) { const int s16 = 4 * so + sj;
            if (so < 3 || sj == 0) asm volatile("s_waitcnt vmcnt(12)" ::: "memory"); else if (sj == 1) asm volatile("s_waitcnt vmcnt(8)" ::: "memory");
            else if (sj == 2) asm volatile("s_waitcnt vmcnt(4)" ::: "memory"); else asm volatile("s_waitcnt vmcnt(0)" ::: "memory");
            __builtin_amdgcn_s_barrier(); asm volatile("" ::: "memory");
            if (so < 3) RT_DMA2(s16 + 4, rb == 0 ? 4 : rb - 1);
            const LAS bf16* WH = (const LAS bf16*)(F.lds + rb * (RTW_IMG * 2)); const LAS bf16* WL = WH + 4 * 48 * 40;
            rb = rb == 4 ? 0 : rb + 1;
            const u32x4 xw = xv[sj];
            { const float x0 = lo16(xw.x), x1 = hi16(xw.x), x2 = lo16(xw.y), x3 = hi16(xw.y), x4 = lo16(xw.z), x5 = hi16(xw.z), x6 = lo16(xw.w), x7 = hi16(xw.w);
              ssq += ((x0 * x0 + x1 * x1) + (x2 * x2 + x3 * x3)) + ((x4 * x4 + x5 * x5) + (x6 * x6 + x7 * x7)); }
            const bf16x8 xf = __builtin_bit_cast(bf16x8, xw);
#pragma unroll
            for (int nf = 0; nf < 3; ++nf) { const bf16x8 wh = *(const LAS bf16x8*)(WH + (kc * 48 + nf * 16 + n16) * 40 + 8 * kq), wl = *(const LAS bf16x8*)(WL + (kc * 48 + nf * 16 + n16) * 40 + 8 * kq);
                acc[nf] = __builtin_amdgcn_mfma_f32_16x16x32_bf16(wh, xf, acc[nf], 0, 0, 0); acc[nf] = __builtin_amdgcn_mfma_f32_16x16x32_bf16(wl, xf, acc[nf], 0, 0, 0); }
            asm volatile("s_waitcnt lgkmcnt(0)" ::: "memory");
        }
#pragma unroll
        for (int i = 0; i < 12; ++i) xv[i] = xv[i + 4];
    }
#undef RT_DMA2
#undef RT_DMA
    __syncthreads();
    ssq += shx(ssq, 16, tid & 63); ssq += shx(ssq, 32, tid & 63);
#pragma unroll
    for (int nf = 0; nf < 3; ++nf)
#pragma unroll
        for (int r = 0; r < 4; ++r) RED[((tg * 4 + kc) * 48 + nf * 16 + 4 * kq + r) * 16 + n16] = acc[nf][r];
    if (kq == 0) SSQ[(tg * 4 + kc) * 16 + n16] = ssq;
    __syncthreads();
    if (tid < 32) {
        const int tg2 = tid >> 4, tk = tid & 15, token = tok0 + tid;
        float lgt[36];
#pragma unroll
        for (int o = 0; o < 36; ++o) lgt[o] = (RED[((tg2 * 4 + 0) * 48 + o) * 16 + tk] + RED[((tg2 * 4 + 1) * 48 + o) * 16 + tk]) + (RED[((tg2 * 4 + 2) * 48 + o) * 16 + tk] + RED[((tg2 * 4 + 3) * 48 + o) * 16 + tk]);
        const float sq = (SSQ[(tg2 * 4 + 0) * 16 + tk] + SSQ[(tg2 * 4 + 1) * 16 + tk]) + (SSQ[(tg2 * 4 + 2) * 16 + tk] + SSQ[(tg2 * 4 + 3) * 16 + tk]);
        const float rs = rsqrtf(sq * (1.0f / D) + EPS); RS[tid] = rs;
        const float* brg = A.in[29] + l * 4; const float* bre = A.in[31] + l * 32;
        float lg[4];
#pragma unroll
        for (int j = 0; j < 4; ++j) lg[j] = lgt[j] * rs + brg[j];
        int gs = 0; float mx = lg[0];
#pragma unroll
        for (int j = 1; j < 4; ++j) if (lg[j] > mx) { mx = lg[j]; gs = j; }
        float sum = 0.f;
#pragma unroll
        for (int j = 0; j < 4; ++j) sum += expf(lg[j] - mx);
        const float gate_g = 1.0f / sum;
        float le[8];
#pragma unroll
        for (int j = 0; j < 8; ++j) { const float a = gs == 0 ? lgt[4 + j] : gs == 1 ? lgt[12 + j] : gs == 2 ? lgt[20 + j] : lgt[28 + j]; le[j] = a * rs + bre[gs * 8 + j]; }
        int i1 = 0; float m1 = le[0];
#pragma unroll
        for (int j = 1; j < 8; ++j) if (le[j] > m1) { m1 = le[j]; i1 = j; }
        int i2 = (i1 == 0) ? 1 : 0; float m2 = le[i2];
#pragma unroll
        for (int j = 0; j < 8; ++j) if (j != i1 && le[j] > m2) { m2 = le[j]; i2 = j; }
        const float e2 = expf(m2 - m1), w1 = 1.0f / (1.0f + e2), w2 = e2 / (1.0f + e2);
        float* comb = (float*)(F.ws + (dry ? WS_DS : WS_COMB)); int* list = (int*)(F.ws + (dry ? WS_DS + 4 * MiB : WS_LIST)); unsigned* cnt = dry ? (unsigned*)(F.ws + WS_DS + 8 * MiB) : (unsigned*)(F.ws + WS_CTL) + CW_CNT + l * 32 * 16;
        const int ea = gs * 8 + i1, eb = gs * 8 + i2;
        comb[token] = gate_g * w1; comb[T + token] = gate_g * w2;
        LAS unsigned* HIST = (LAS unsigned*)(RS + 32); LAS unsigned* BASE = HIST + 32;
        HIST[tid] = 0u; asm volatile("s_waitcnt lgkmcnt(0)" ::: "memory");
        const unsigned ra = atomicAdd((unsigned*)(HIST + ea), 1u), rb = atomicAdd((unsigned*)(HIST + eb), 1u);
        asm volatile("s_waitcnt lgkmcnt(0)" ::: "memory");
        { const unsigned n = HIST[tid]; BASE[tid] = n ? atomicAdd(cnt + tid * 16, n) : 0u; }
        asm volatile("s_waitcnt vmcnt(0) lgkmcnt(0)" ::: "memory");
        unsigned pa = BASE[ea] + ra, pb = BASE[eb] + rb;
        if (dry) { pa &= 8191u; pb &= 8191u; }
        list[ea * 8192 + pa] = token; list[eb * 8192 + pb] = T + token;
    }
    __syncthreads();
    { u32x4 raw[4][4];
#pragma unroll
        for (int rr = 0; rr < 4; ++rr)
#pragma unroll
            for (int j = 0; j < 4; ++j) raw[rr][j] = *(const u32x4*)(xres + (size_t)(tok0 + w * 4 + rr) * D + 8 * lane + 512 * j);
#pragma unroll
        for (int rr = 0; rr < 4; ++rr) { const int row = w * 4 + rr; const float rs = RS[row]; const size_t t = (size_t)(tok0 + row);
#pragma unroll
            for (int j = 0; j < 4; ++j) { const int col = 8 * lane + 512 * j; const u32x4 r4 = raw[rr][j];
                const f32x4 oa = up4((u32x2){r4.x, r4.y}) * rs * *(const f32x4*)(gn + col), ob = up4((u32x2){r4.z, r4.w}) * rs * *(const f32x4*)(gn + col + 4);
                const u32x2 wl = dn4(oa), wh = dn4(ob);
                *(u32x4*)((bf16*)(F.ws + (dry ? WS_DS + 16 * MiB : WS_XN)) + t * D + col) = (u32x4){wl.x, wl.y, wh.x, wh.y}; } } }
    __syncthreads();
}

__device__ __forceinline__ void moe_prepare(Frame& F, int l, int nct, pg8::MoeOrder& S) {
    LAS int* cntl = (LAS int*)(F.lds + EXTRA_OFF); LAS int* pre = cntl + 64; LAS int* ptab = cntl + 128;
    const unsigned* cnt = (const unsigned*)(F.ws + WS_CTL) + CW_CNT + l * 32 * 16; const int* list = (const int*)(F.ws + WS_LIST);
    if (F.tid < 32) { const unsigned c = __hip_atomic_load(cnt + F.tid * 16, __ATOMIC_RELAXED, __HIP_MEMORY_SCOPE_AGENT); cntl[F.tid] = (int)(c > 8192u ? 8192u : c); }
    __syncthreads();
    if (F.tid == 0) { int s = 0; for (int e = 0; e < 32; ++e) { pre[e] = s; s += (cntl[e] + 255) >> 8; } pre[32] = s; }
    __syncthreads();
    S.pre = pre; S.cnt = cntl; S.ptab = ptab; S.nct = nct; S.G = F.G; S.c = F.vcu;
    for (int ui = 0; ui < pg8::MOE_MAXU; ++ui) { int e, rt, ct;
        if (S.decode(ui, e, rt, ct) && F.tid < 256) { const int pos = rt * 256 + F.tid; ptab[ui * 256 + F.tid] = pos < cntl[e] ? list[e * 8192 + pos] : -1; } }
    __syncthreads();
}

__device__ __forceinline__ void moe_prepare2(Frame& F, int l, int nct, fg::Tables& tb, const bool merged) {
    LAS int* cntl = (LAS int*)(F.lds + EXTRA_OFF); LAS int* pre = cntl + 64; LAS int* utab = cntl + 100; LAS int* ptab = cntl + 128; LAS float* ctab = (LAS float*)(ptab + fg::MAXU * 256);
    const unsigned* cnt = (const unsigned*)(F.ws + WS_CTL) + CW_CNT + l * 32 * 16; const int* list = (const int*)(F.ws + WS_LIST); const float* comb = (const float*)(F.ws + WS_COMB);
    __syncthreads();
    if (F.tid < 32) { const unsigned c = __hip_atomic_load(cnt + F.tid * 16, __ATOMIC_RELAXED, __HIP_MEMORY_SCOPE_AGENT); cntl[F.tid] = (int)(c > 8192u ? 8192u : c); }
    __syncthreads();
    if (F.tid == 0) { int s = 0; for (int e = 0; e < 32; ++e) { pre[e] = s; s += ((cntl[e] + 255) >> 8) * nct; } pre[32] = s; }
    __syncthreads();
    tb.cnt = cntl; tb.preU = pre; tb.ptab = ptab; tb.utab = utab; tb.ctab = ctab;
    tb.flags = merged ? (unsigned*)(F.ws + WS_CTL) + CW_FLAG + l * 32 * 32 * 16 : nullptr;
    const int ucu = (F.G == 256) ? ((F.vcu & 7) * 32 + (F.vcu >> 3)) : F.vcu;
    tb.stride = F.G; tb.c0 = ucu;
    if (merged) { const int n2 = pre[32] >> 1; const int h = n2 > F.G ? (n2 - F.G < F.G / 2 ? n2 - F.G : F.G / 2) : 0; tb.stride = F.G - h; tb.c0 = ucu - h; }
    int nu = 0;
    for (int ui = 0; ui < fg::MAXU; ++ui) { int e, rt, ct;
        if (fg::decode(tb, ui, e, rt, ct)) { ++nu;
            if (F.tid < 256) { const int pos = rt * 256 + F.tid; const int pr = pos < cntl[e] ? list[e * 8192 + pos] : -1; ptab[ui * 256 + F.tid] = pr; ctab[ui * 256 + F.tid] = pr >= 0 ? comb[pr] : 0.f; }
            if (F.tid == 0) { utab[3 * ui] = e; utab[3 * ui + 1] = rt; utab[3 * ui + 2] = ct; } } }
    if (F.tid == 0) utab[3 * fg::MAXU] = nu;
    __syncthreads();
}

constexpr int PH_LAYER0 = 2, PH_PER_LAYER = 12, PH_FINAL = PH_LAYER0 + DEPTH * PH_PER_LAYER, PH_END = PH_FINAL + 1;

__global__ void __launch_bounds__(NTHR, 2) mk_fwd(Args args) {
    extern __shared__ __attribute__((aligned(16))) unsigned char lds_raw[];
    Frame F;
    F.lds = (LAS unsigned char*)lds_raw;
    F.tid = threadIdx.x; F.lane = F.tid & 63; F.wave = __builtin_amdgcn_readfirstlane(F.tid >> 6);
    F.G = gridDim.x; { const int bx = blockIdx.x; F.vcu = (F.G % 8 == 0) ? (bx % 8) * (F.G / 8) + bx / 8 : bx; }
    F.ws = args.ws;
    volatile LAS unsigned* MISC = (volatile LAS unsigned*)(F.lds + MISC_OFF);
    if (F.tid < 64) MISC[F.tid] = 0u;
    __syncthreads();
    const int lo = args.ph_lo, hi = args.ph_hi;
    const bool multi = (hi - lo) > 1;
    XcdBarrier bar; bar.bar = (unsigned*)(args.ws + WS_CTL) + CW_BAR; bar.x = 0; bar.st = MISC + 8;
    if (multi) bar = xcd_barrier_post((unsigned*)(args.ws + WS_CTL) + CW_BAR, MISC + 8);
#ifndef MK_REP_P0
#define MK_REP_P0 1
#endif
#ifndef MK_REP_EV
#define MK_REP_EV 1
#endif
#ifndef MK_REP_S5
#define MK_REP_S5 1
#endif
#ifndef MK_REP_MOE
#define MK_REP_MOE 1
#endif
#ifndef MK_MOE_DRY
#define MK_MOE_DRY 0
#endif
#ifndef MK_REP_RT
#define MK_REP_RT 1
#endif
#ifndef MK_REP_G
#define MK_REP_G 1
#endif
#ifndef MK_MASK
#define MK_MASK 0xffffffffu
#endif
#define ON(b) ((MK_MASK >> (b)) & 1u)
#define IN(k) (lo <= (k) && (k) < hi)
#define SEAM(k) do { if (multi && (k) + 1 < hi) xcd_barrier(bar, F.wave == 0 && lane_now() == 0); } while (0)
    LAS unsigned char* ring = F.lds;
#define PHASE_ENTER KArgs& args = *opaque_k((KArgs*)__builtin_amdgcn_kernarg_segment_ptr()); Frame P = F; P.vcu = opaque_s(F.vcu); P.G = opaque_s(F.G); const int PBX = opaque_s((int)blockIdx.x); (void)PBX; P.tid = opaque_v(F.wave * 64 + lane_now()); P.lane = P.tid & 63; P.wave = __builtin_amdgcn_readfirstlane(P.tid >> 6); P.ws = opaque_p(F.ws); unsigned char* ws = P.ws; (void)ws;

    if (ON(0) && IN(0)) { for (int rep = 0; rep < MK_REP_P0; ++rep) { PHASE_ENTER p0_prologue(P, args); SEAM(0); } }
    if (multi && lo == 0) {
        if (F.tid == 0) { unsigned base = 0; for (unsigned j = 0; j < 16; ++j) { const unsigned cj = xb_ld(&bar.bar[XB_XCNT(j)]); base += (j < bar.x) ? cj : 0u; } MISC[11] = base + MISC[10]; }
        __syncthreads();
        F.vcu = __builtin_amdgcn_readfirstlane((int)MISC[11]);
    }
    if (ON(1) && IN(1)) {
        PHASE_ENTER
        pg8::PPOrder S; S.init(T, D, 256, P.G, PBX, (size_t)T * 256 * 2, SZ_PLEP);
        pg8::EpiStoreBf16Split E{(bf16*)(ws + WS_PP), D, (size_t)T * D, nullptr};
        pg8::gemm_phase<pg8::EpiStoreBf16Split, pg8::PPOrder, false>(P.tid, ring, (const char*)(ws + WS_PB), (const char*)(ws + WS_PLEP), 256, S, E);
        SEAM(1);
    }
    for (int l = 0; l < DEPTH; ++l) {
        const int pb = PH_LAYER0 + l * PH_PER_LAYER, eo = l >> 1;
        const size_t xcur = WS_XRES + (size_t)(l & 1) * T * D * 2, xnxt = WS_XRES + (size_t)((l + 1) & 1) * T * D * 2;
        if (ON(2) && l > 0 && IN(pb + 0)) {
            PHASE_ENTER
            const int gw = P.vcu * NWAVES + P.wave, NGW = P.G * NWAVES;
            for (int m = gw; m < T; m += NGW) norm_row<true, false, false, 0>((const bf16*)(ws + xcur) + (size_t)m * D, nullptr, nullptr, nullptr, nullptr, nullptr, nullptr, (float*)(ws + WS_RS) + m, P.lane);
            SEAM(pb + 0);
        }
        if ((l & 1) == 0) {
            if (ON(3) && IN(pb + 1)) for (int rep = 0; rep < MK_REP_G; ++rep) {
                PHASE_ENTER
                pg8::StaticOrder S; S.init(T, ZW, D, P.G, PBX);
                pg8::EpiStoreBf16 E{(bf16*)(ws + WS_Z), ZW, (const float*)(ws + WS_RS)};
                pg8::gemm_phase<pg8::EpiStoreBf16, pg8::StaticOrder, false>(P.tid, ring, (const char*)(ws + xcur), (const char*)(ws + WS_WIN) + (size_t)eo * SZ_WIN, D, S, E);
                SEAM(pb + 1);
            }
            if (IN(pb + 2)) for (int rep = 0; rep < MK_REP_EV; ++rep) {
                if (ON(4)) { PHASE_ENTER for (int u = P.vcu; u < 256; u += P.G) lru_unit(P, args, eo, u); }
                if (ON(17)) { PHASE_ENTER for (int u = P.vcu; u < 512; u += P.G) gla_ds_unit(P, args, eo, u); }
                SEAM(pb + 2);
            }
            if (ON(5) && IN(pb + 3)) for (int rep = 0; rep < MK_REP_EV; ++rep) { PHASE_ENTER gla_state_phase(P); SEAM(pb + 3); }
            if (ON(6) && IN(pb + 4)) for (int rep = 0; rep < MK_REP_EV; ++rep) { PHASE_ENTER for (int u = P.vcu; u < 512; u += P.G) gla_out_unit(P, args, eo, u); SEAM(pb + 4); }
            if (ON(7) && IN(pb + 5)) {
                PHASE_ENTER
                pg8::StaticOrder S; S.init(T, D, D, P.G, PBX);
                pg8::EpiResid E{(bf16*)(ws + xcur)};
                pg8::gemm_phase<pg8::EpiResid, pg8::StaticOrder, false>(P.tid, ring, (const char*)(ws + WS_YCAT), (const char*)(ws + WS_WOUT) + (size_t)eo * SZ_DD, D, S, E);
                SEAM(pb + 5);
            }
        } else {
            if (ON(8) && IN(pb + 1)) for (int rep = 0; rep < MK_REP_G; ++rep) {
                PHASE_ENTER
                pg8::SplitK2Order S; S.init(T, 1024, D, P.G, PBX);
                pg8::EpiStoreBf16Split E{(bf16*)(ws + WS_U), 1024, (size_t)T * 1024, (const float*)(ws + WS_RS)};
                pg8::gemm_phase<pg8::EpiStoreBf16Split, pg8::SplitK2Order, false>(P.tid, ring, (const char*)(ws + xcur), (const char*)(ws + WS_ODWIN) + (size_t)eo * SZ_ODWIN, D, S, E, D / 128);
                SEAM(pb + 1);
            }
            if (ON(9) && IN(pb + 2)) for (int rep = 0; rep < MK_REP_S5; ++rep) { PHASE_ENTER for (int u = P.vcu; u < 256; u += P.G) s5_unit(P, args, eo, u); SEAM(pb + 2); }
            if (ON(10) && IN(pb + 3)) {
                PHASE_ENTER
                pg8::StaticOrder S; S.init(T, 4096, 1024, P.G, PBX);
                pg8::EpiGlu E{(bf16*)(ws + xcur)};
                pg8::gemm_phase<pg8::EpiGlu, pg8::StaticOrder, false>(P.tid, ring, (const char*)(ws + WS_YS5), (const char*)(ws + WS_WGLU) + (size_t)eo * SZ_WGLU, 1024, S, E);
                SEAM(pb + 3);
            }
        }
        if (ON(11) && IN(pb + 6)) for (int rep = 0; rep < MK_REP_RT; ++rep) { PHASE_ENTER for (int u = P.vcu; u < 256; u += P.G) router_unit(P, args, l, u, rep + 1 < MK_REP_RT, (const bf16*)(ws + xcur)); SEAM(pb + 6); }
        if (ON(12) && IN(pb + 7)) {
            PHASE_ENTER
            unsigned* flags = (unsigned*)(ws + WS_CTL) + CW_FLAG + l * 32 * 32 * 16;
            {
                fg::Tables tb; moe_prepare2(P, l, 4, tb, false);
                const int nu2 = __builtin_amdgcn_readfirstlane(tb.utab[3 * fg::MAXU]);
#pragma unroll 1
                for (int ui = 0; ui < nu2; ++ui) {
                    fg::fgemm_phase<0>(opaque_v(P.tid), ring, tb, (const char*)(ws + WS_XN), args.in[32] + (size_t)l * 32 * D * 512, args.in[33] + (size_t)l * 32 * D * 512, (bf16*)(ws + WS_H), ui, ui + 1);
                    if (P.tid == 0) { __builtin_amdgcn_fence(__ATOMIC_RELEASE, "agent"); asm volatile("s_waitcnt vmcnt(0)" ::: "memory");
                        __hip_atomic_fetch_add(flags + (tb.utab[3 * ui] * 32 + tb.utab[3 * ui + 1]) * 16, 1u, __ATOMIC_RELAXED, __HIP_MEMORY_SCOPE_AGENT); }
                }
            }
            {
                Frame Q = P; Q.tid = opaque_v(P.tid);
                fg::Tables tb; moe_prepare2(Q, l, 8, tb, true);
                const int nu3 = __builtin_amdgcn_readfirstlane(tb.utab[3 * fg::MAXU]);
                fg::fgemm_phase<1>(Q.tid, ring, tb, (const char*)(ws + WS_H), args.in[34] + (size_t)l * 32 * 512 * D, nullptr, (bf16*)(ws + WS_Y), 0, nu3);
            }
            SEAM(pb + 8);
        }
        if (ON(14) && IN(pb + 9)) {
            PHASE_ENTER
            const int gw = P.vcu * NWAVES + P.wave, NGW = P.G * NWAVES;
            for (int m = gw; m < T; m += NGW) { bf16* xr = (bf16*)(ws + xcur) + (size_t)m * D;
                norm_row<true, true, true, 0>(xr, (const bf16*)(ws + WS_Y) + (size_t)m * D, (const bf16*)(ws + WS_Y) + (size_t)(T + m) * D, xr, nullptr, nullptr, nullptr, (float*)(ws + WS_RS) + m, P.lane); }
            SEAM(pb + 9);
        }
        if (ON(15) && IN(pb + 10)) {
            PHASE_ENTER
            pg8::StaticOrder S; S.init(T, D, D, P.G, PBX);
            pg8::EpiPle E{(const bf16*)(ws + xcur), (bf16*)(ws + xnxt), (const bf16*)(ws + WS_PP) + (size_t)l * T * D, args.in[36] + (size_t)l * D, (const float*)(ws + WS_RS)};
            pg8::gemm_phase<pg8::EpiPle, pg8::StaticOrder, false>(P.tid, ring, (const char*)(ws + xcur), (const char*)(ws + WS_PLEG) + (size_t)l * SZ_DD, D, S, E);
            SEAM(pb + 10);
        }
    }
    if (ON(16) && IN(PH_FINAL)) {
        PHASE_ENTER
        const int gw = P.vcu * NWAVES + P.wave, NGW = P.G * NWAVES;
        for (int m = gw; m < T; m += NGW) norm_row<true, false, false, 2>((const bf16*)(ws + WS_XRES + (size_t)(DEPTH & 1) * T * D * 2) + (size_t)m * D, nullptr, nullptr, nullptr, args.in[5], nullptr, args.out + (size_t)m * D, nullptr, P.lane);
    }
#undef IN
#undef ON
#undef SEAM
#undef PHASE_ENTER
}

static bool phase_exists(int k) {
    if (k < PH_LAYER0 || k >= PH_FINAL) return true;
    const int l = (k - PH_LAYER0) / PH_PER_LAYER, r = (k - PH_LAYER0) % PH_PER_LAYER;
    if (r == 0) return l > 0;
    if (r == 11) return false;
    if (l & 1) return !(r == 4 || r == 5);
    return true;
}
extern "C" void kernel_launch(void* const* d_in, const int* in_sizes, int n_in, void* d_out, int out_size, void* d_ws, size_t ws_size, hipStream_t stream) {
    static int grid = 0;
    if (grid == 0) {
        if (n_in != 38 || out_size != T * D || ws_size < WS_END) { fprintf(stderr, "kernel_launch: unexpected problem (n_in %d, out %d, ws %zu < %zu)\n", n_in, out_size, ws_size, (size_t)WS_END); grid = -1; return; }
        int dev = 0, cus = 0, per_cu = 0;
        if (hipGetDevice(&dev) != hipSuccess || hipDeviceGetAttribute(&cus, hipDeviceAttributeMultiprocessorCount, dev) != hipSuccess) { grid = -1; return; }
        if (hipFuncSetAttribute((const void*)mk_fwd, hipFuncAttributeMaxDynamicSharedMemorySize, LDS_BYTES) != hipSuccess) { fprintf(stderr, "kernel_launch: hipFuncSetAttribute failed\n"); grid = -1; return; }
        if (hipOccupancyMaxActiveBlocksPerMultiprocessor(&per_cu, (const void*)mk_fwd, NTHR, LDS_BYTES) != hipSuccess || per_cu < 1) fprintf(stderr, "kernel_launch: occupancy query says %d\n", per_cu);
        (void)hipGetLastError();
        grid = cus;
    }
    if (grid < 0) return;
    (void)hipMemsetAsync((char*)d_ws + WS_CTL, 0, CTL_BYTES, stream);
    Args a{};
    for (int i = 0; i < 38; ++i) a.in[i] = (const float*)d_in[i];
    a.out = (float*)d_out; a.ws = (unsigned char*)d_ws;
#if MK_PER_PHASE
    for (int k = 0; k < PH_END; ++k) { if (!phase_exists(k)) continue; a.ph_lo = k; a.ph_hi = k + 1; hipLaunchKernelGGL(mk_fwd, dim3(grid), dim3(NTHR), LDS_BYTES, stream, a); }
#else
    (void)phase_exists;
    a.ph_lo = 0; a.ph_hi = PH_END;
    hipLaunchKernelGGL(mk_fwd, dim3(grid), dim3(NTHR), LDS_BYTES, stream, a);
#endif
    const hipError_t le = hipPeekAtLastError();
    if (le != hipSuccess) fprintf(stderr, "kernel_launch: launch failed: %s\n", hipGetErrorName(le));
}
```

```cpp
#include <hip/hip_runtime.h>
#include <cstdio>
#include <cstdint>

#ifndef MK_PER_PHASE
#define MK_PER_PHASE 0
#endif

#define GAS __attribute__((address_space(1)))
#define LAS __attribute__((address_space(3)))
typedef unsigned short bf16;
typedef short bf16x8 __attribute__((ext_vector_type(8)));
typedef float f32x4 __attribute__((ext_vector_type(4)));
typedef float f32x2 __attribute__((ext_vector_type(2)));
typedef unsigned u32x4 __attribute__((ext_vector_type(4)));
typedef unsigned u32x2 __attribute__((ext_vector_type(2)));

constexpr int T = 8192, D = 2048, SEQ = 2048, NB = 4, DEPTH = 4;
constexpr int ZW = 5632;
constexpr int EV_IN = 5136;
constexpr float EPS = 1e-6f;
constexpr int NWAVES = 8, NTHR = 512;

constexpr size_t MiB = 1u << 20;
constexpr size_t WS_CTL = 0, CTL_BYTES = 1 * MiB;
constexpr size_t WS_WIN = 1 * MiB;
constexpr size_t SZ_WIN = (size_t)ZW * D * 2;
constexpr size_t WS_WOUT = WS_WIN + 2 * SZ_WIN;
constexpr size_t SZ_DD = (size_t)D * D * 2;
constexpr size_t WS_ODWIN = WS_WOUT + 2 * SZ_DD;
constexpr size_t SZ_ODWIN = (size_t)1024 * D * 2;
constexpr size_t WS_WGLU = WS_ODWIN + 2 * SZ_ODWIN;
constexpr size_t SZ_WGLU = (size_t)4096 * 1024 * 2;
constexpr size_t WS_PLEG = WS_WGLU + 2 * SZ_WGLU;
constexpr size_t WS_PLEP = WS_PLEG + 4 * SZ_DD;
constexpr size_t SZ_PLEP = (size_t)D * 256 * 2;
constexpr size_t WS_W13 = WS_PLEP + 4 * SZ_PLEP;
constexpr size_t WS_RTW = WS_W13;
constexpr int RTW_IMG = 2 * 4 * 48 * 40;
constexpr size_t SZ_W13 = (size_t)1024 * D * 2;
constexpr size_t WS_W2 = WS_W13 + 128 * SZ_W13;
constexpr size_t SZ_W2 = (size_t)D * 512 * 2;
constexpr size_t WS_XRES = WS_W2 + 128 * SZ_W2;
constexpr size_t WS_XN = WS_XRES + (size_t)T * D * 4;
constexpr size_t WS_Z = WS_XN + (size_t)T * D * 2;
constexpr size_t WS_YCAT = WS_Z + (size_t)T * ZW * 2;
constexpr size_t WS_DS = WS_YCAT + (size_t)T * D * 2;
constexpr size_t SZ_DS = (size_t)16 * 32 * 128 * 256 * 4;
constexpr size_t WS_SPREV = WS_DS + SZ_DS;
constexpr size_t WS_DECAY = WS_SPREV + SZ_DS;
constexpr size_t WS_U = WS_DECAY + (size_t)16 * 32 * 128 * 4;
constexpr size_t WS_YS5 = WS_U + (size_t)2 * T * 1024 * 2;
constexpr size_t WS_PB = WS_YS5 + (size_t)T * 1024 * 2;
constexpr size_t WS_PP = WS_PB + (size_t)4 * T * 256 * 2;
constexpr size_t WS_H = WS_PP + (size_t)4 * T * D * 2;
constexpr size_t WS_Y = WS_H + (size_t)2 * T * 512 * 2;
constexpr size_t WS_LIST = WS_Y + (size_t)2 * T * D * 2;
constexpr size_t WS_COMB = WS_LIST + (size_t)32 * 8192 * 4;
constexpr size_t WS_RS = WS_COMB + (size_t)2 * T * 4;
constexpr size_t WS_END = WS_RS + (size_t)T * 4;
constexpr int CW_BAR = 4096;
constexpr int CW_FLAG = 32768;
constexpr int CW_CNT = 16384;

constexpr int LDS_BYTES = 163840;
constexpr int EXTRA_OFF = 147456;
constexpr int MISC_OFF = LDS_BYTES - 256;

__device__ __forceinline__ float bf2f(unsigned b) { return __uint_as_float(b << 16); }
__device__ __forceinline__ unsigned f2bf(float f) { unsigned u = __float_as_uint(f); return (u + 0x7fffu + ((u >> 16) & 1u)) >> 16; }
typedef __bf16 bf16x2_t __attribute__((ext_vector_type(2)));
__device__ __forceinline__ unsigned pk2(float lo, float hi) { const bf16x2_t r = __builtin_convertvector((f32x2){lo, hi}, bf16x2_t); return __builtin_bit_cast(unsigned, r); }
__device__ __forceinline__ float lo16(unsigned w) { return __uint_as_float(w << 16); }
__device__ __forceinline__ float hi16(unsigned w) { return __uint_as_float(w & 0xffff0000u); }
__device__ __forceinline__ f32x4 up4(u32x2 w) { return (f32x4){lo16(w.x), hi16(w.x), lo16(w.y), hi16(w.y)}; }
__device__ __forceinline__ u32x2 dn4(f32x4 v) { u32x2 w; w.x = pk2(v[0], v[1]); w.y = pk2(v[2], v[3]); return w; }
__device__ __forceinline__ float sigmoidf_(float x) { return __builtin_amdgcn_rcpf(1.0f + __expf(-x)); }
__device__ __forceinline__ float one_minus_exp(float t) { const float ser = -t * (1.0f + 0.5f * t * (1.0f + (1.0f / 3.0f) * t * (1.0f + 0.25f * t))); return t > -0.03125f ? ser : 1.0f - __expf(t); }
__device__ __forceinline__ float siluf_(float x) { return x * sigmoidf_(x); }
__device__ __forceinline__ float gelu_tanh(float x) { return x * sigmoidf_(1.5957691216f * (x + 0.044715f * x * x * x)); }
__device__ __forceinline__ float softplusf_(float x) { return fmaxf(x, 0.f) + log1pf(__expf(-fabsf(x))); }
__device__ __forceinline__ float logsigmoidf_(float x) { return fminf(x, 0.f) - __logf(1.0f + __expf(-fabsf(x))); }
__device__ __forceinline__ float dpp_f(float v, const int ctrl_sel) {
    const int i = __builtin_bit_cast(int, v);
    int r;
    if (ctrl_sel == 0) r = __builtin_amdgcn_update_dpp(0, i, 0xB1, 0xF, 0xF, false);
    else if (ctrl_sel == 1) r = __builtin_amdgcn_update_dpp(0, i, 0x4E, 0xF, 0xF, false);
    else if (ctrl_sel == 2) r = __builtin_amdgcn_update_dpp(0, i, 0x141, 0xF, 0xF, false);
    else r = __builtin_amdgcn_update_dpp(0, i, 0x140, 0xF, 0xF, false);
    return __builtin_bit_cast(float, r);
}
__device__ __forceinline__ float shx(float v, int mask, int lane) { return __builtin_bit_cast(float, __builtin_amdgcn_ds_bpermute((lane ^ mask) << 2, __builtin_bit_cast(int, v))); }
__device__ __forceinline__ float wave_sum(float v) {
    v += dpp_f(v, 0); v += dpp_f(v, 1); v += dpp_f(v, 2); v += dpp_f(v, 3);
    const int i = __builtin_bit_cast(int, v);
    const float r0 = __builtin_bit_cast(float, __builtin_amdgcn_readlane(i, 0)), r1 = __builtin_bit_cast(float, __builtin_amdgcn_readlane(i, 16));
    const float r2 = __builtin_bit_cast(float, __builtin_amdgcn_readlane(i, 32)), r3 = __builtin_bit_cast(float, __builtin_amdgcn_readlane(i, 48));
    return (r0 + r1) + (r2 + r3);
}
#define LDS_WAIT() asm volatile("s_waitcnt lgkmcnt(0)" ::: "memory")
#define LDS_BARRIER() do { asm volatile("s_waitcnt lgkmcnt(0)" ::: "memory"); __builtin_amdgcn_s_barrier(); asm volatile("" ::: "memory"); } while (0)
__device__ __forceinline__ int opaque_v(int v) { asm volatile("" : "+v"(v)); return v; }
__device__ __forceinline__ int lane_now() { int z = 0; asm volatile("" : "+s"(z)); return (int)__builtin_amdgcn_mbcnt_hi(~0u, __builtin_amdgcn_mbcnt_lo(~0u, (unsigned)z)); }
__device__ __forceinline__ int opaque_s(int v) { v = __builtin_amdgcn_readfirstlane(v); asm volatile("" : "+s"(v)); return v; }
__device__ __forceinline__ unsigned char* opaque_p(unsigned char* p) { __attribute__((address_space(1))) unsigned char* g = (__attribute__((address_space(1))) unsigned char*)p; asm volatile("" : "+s"(g)); return (unsigned char*)g; }

#define XB_TMO      128
#define XB_XCNT(j)  (256  + 64 * (j))
#define XB_XSUB(j)  (1280 + 64 * (j))
#define XB_XGEN(j)  (2304 + 64 * (j))
#define XB_TOP      3328
#define XB_TOPGEN   3392
#define XCD_BAR_WORDS 3456
#define XB_SPIN_CAP (1u << 18)
__device__ __forceinline__ unsigned xb_ld(unsigned* p)              { return __hip_atomic_load(p, __ATOMIC_RELAXED, __HIP_MEMORY_SCOPE_AGENT); }
__device__ __forceinline__ unsigned xb_add(unsigned* p, unsigned v) { return __hip_atomic_fetch_add(p, v, __ATOMIC_RELAXED, __HIP_MEMORY_SCOPE_AGENT); }
__device__ __forceinline__ unsigned xb_xcc_id() { return (unsigned)__builtin_amdgcn_s_getreg((3 << 11) | 20) & 0xFu; }
#define XB_SPIN(cond, bar) do { unsigned _sp = 0; while (cond) { __builtin_amdgcn_s_sleep(1); \
    if ((++_sp & 255u) == 0u) { if (xb_ld(&(bar)[XB_TMO])) break; if (_sp > XB_SPIN_CAP) { atomicAdd(&(bar)[XB_TMO], 1u); break; } } } } while (0)
struct XcdBarrier { unsigned* bar; unsigned x; volatile LAS unsigned* st; };
__device__ __forceinline__ XcdBarrier xcd_barrier_post(unsigned* bar, volatile LAS unsigned* st) {
    XcdBarrier b; b.bar = bar; b.x = xb_xcc_id(); b.st = st;
    if (threadIdx.x == 0) st[2] = xb_add(&bar[XB_XCNT(b.x)], 1u);
    return b;
}
__device__ __forceinline__ unsigned long long xcd_barrier_complete(unsigned* bar, unsigned x) {
    const unsigned G = gridDim.x * gridDim.y * gridDim.z;
    unsigned sum, cnt, mine, sp = 0u;
    for (;;) {
        sum = 0u; cnt = 0u; mine = 0u;
#pragma unroll 1
        for (unsigned j = 0; j < 16; ++j) { const unsigned c = xb_ld(&bar[XB_XCNT(j)]); sum += c; cnt += (c > 0u) ? 1u : 0u; mine = (j == x) ? c : mine; }
        if (sum == G) break;
        __builtin_amdgcn_s_sleep(1);
        if ((++sp & 255u) == 0u) { if (xb_ld(&bar[XB_TMO])) break; if (sp > XB_SPIN_CAP) { atomicAdd(&bar[XB_TMO], 1u); break; } }
    }
    const unsigned nloc = mine > 0u ? mine : 1u, nx = cnt > 0u ? cnt : 1u;
    return ((unsigned long long)nx << 32) | nloc;
}
__device__ __forceinline__ void xcd_barrier_leader(unsigned* bar, unsigned x, volatile LAS unsigned* st) {
    __builtin_amdgcn_s_waitcnt(0);
    unsigned nloc = st[0], nx = st[1];
    if (nloc == 0u) { const unsigned long long r = xcd_barrier_complete(bar, x); nloc = (unsigned)r; nx = (unsigned)(r >> 32); st[0] = nloc; st[1] = nx; }
    const unsigned old = xb_add(&bar[XB_XSUB(x)], 1u);
    const unsigned gen = old / nloc;
    if (old + 1u == (gen + 1u) * nloc) {
        __builtin_amdgcn_fence(__ATOMIC_RELEASE, "agent");
        asm volatile("s_waitcnt vmcnt(0)" ::: "memory");
        const unsigned og = xb_add(&bar[XB_TOP], 1u);
        const unsigned tg = og / nx;
        if (og + 1u == (tg + 1u) * nx) xb_add(&bar[XB_TOPGEN], 1u);
        else XB_SPIN(xb_ld(&bar[XB_TOPGEN]) == tg, bar);
        __builtin_amdgcn_fence(__ATOMIC_ACQUIRE, "agent");
        xb_add(&bar[XB_XGEN(x)], 1u);
        asm volatile("s_waitcnt vmcnt(0)" ::: "memory");
    } else {
        XB_SPIN(xb_ld(&bar[XB_XGEN(x)]) == gen, bar);
        __builtin_amdgcn_fence(__ATOMIC_ACQUIRE, "agent");
        asm volatile("s_waitcnt vmcnt(0)" ::: "memory");
    }
}
__device__ __forceinline__ void xcd_barrier(const XcdBarrier& b, const bool leader) {
    asm volatile("s_waitcnt vmcnt(0)" ::: "memory");
    __syncthreads();
    if (leader) xcd_barrier_leader(b.bar, b.x, b.st);
    __syncthreads();
}

struct Args { const float* in[38]; float* out; unsigned char* ws; int ph_lo, ph_hi; };
typedef const Args __attribute__((address_space(4))) KArgs;
__device__ __forceinline__ KArgs* opaque_k(KArgs* p) { asm volatile("" : "+s"(p)); return p; }
struct Frame {
    LAS unsigned char* lds;
    int tid, lane, wave, vcu, G;
    unsigned char* ws;
};

namespace pg8 {
constexpr int BM = 256, BK = 64, HALF = 128, HTB = HALF * BK * 2, STAGE_BYTES = 8 * HTB, NXCD = 8, WGM = 8;
__device__ __forceinline__ int lds_byte(int r, int c) { const int st = (r >> 4) * 2 + (c >> 5), rr = r & 15, cc = c & 31, ob = rr * 64 + cc * 2; return st * 1024 + (ob ^ (((ob >> 9) & 1) << 5)); }
__device__ __forceinline__ void stage_rc(int b, int& R, int& C) { const int st = b / 1024, sb = b % 1024, swz = sb ^ (((sb >> 9) & 1) << 5); R = (st >> 1) * 16 + swz / 64; C = (st & 1) * 32 + (swz % 64) / 2; }

struct Unit { int pm, pn; size_t a_off, b_off; int ui, e, nrows; };

struct StaticOrder {
    int nM, nN, nwg, G, c, K;
    __device__ void init(int M, int N, int K_, int G_, int c_) { nM = M / BM; nN = N / BM; nwg = nM * nN; G = G_; c = c_; K = K_; }
    __device__ __forceinline__ bool next(int i, Unit& u) const {
        const long L = (long)i * G + c; if (L >= nwg) return false;
        int wgid = (int)L; { const int q = nwg / NXCD, r = nwg % NXCD, xcd = wgid % NXCD, off = wgid / NXCD; wgid = (xcd < r ? xcd * (q + 1) : r * (q + 1) + (xcd - r) * q) + off; }
        const int nig = WGM * nN, gid = wgid / nig, fm = gid * WGM, gsz = (nM - fm) < WGM ? (nM - fm) : WGM;
        u.pm = fm + ((wgid % nig) % gsz); u.pn = (wgid % nig) / gsz;
        u.a_off = (size_t)u.pm * BM * K * 2; u.b_off = (size_t)u.pn * BM * K * 2; u.ui = i; u.e = 0; u.nrows = BM;
        return true;
    }
    __device__ __forceinline__ unsigned row_off(const Unit&, int) const { return 0u; }
};

struct SplitK2Order {
    StaticOrder base;
    __device__ void init(int M, int N, int K_, int G_, int c_) { base.init(M, N, K_, G_, c_); }
    __device__ __forceinline__ bool next(int i, Unit& u) const {
        const long L = (long)i * base.G + base.c; if (L >= 2 * base.nwg) return false;
        StaticOrder b2 = base; b2.G = 1; b2.c = 0;
        const int kh = (int)(L & 1); if (!b2.next((int)(L >> 1), u)) return false;
        u.a_off += (size_t)kh * base.K; u.b_off += (size_t)kh * base.K; u.ui = i; u.e = kh; return true;
    }
    __device__ __forceinline__ unsigned row_off(const Unit&, int) const { return 0u; }
};
struct PPOrder {
    StaticOrder base; size_t a_layer, b_layer;
    __device__ void init(int M, int N, int K_, int G_, int c_, size_t a_layer_, size_t b_layer_) { base.init(M, N, K_, G_, c_); a_layer = a_layer_; b_layer = b_layer_; }
    __device__ __forceinline__ bool next(int i, Unit& u) const {
        const long L = (long)i * base.G + base.c; if (L >= 4L * base.nwg) return false;
        const int ll = (int)(L / base.nwg); StaticOrder b2 = base; b2.G = 1; b2.c = 0;
        if (!b2.next((int)(L - (long)ll * base.nwg), u)) return false;
        u.a_off += (size_t)ll * a_layer; u.b_off += (size_t)ll * b_layer; u.ui = i; u.e = ll; return true;
    }
    __device__ __forceinline__ unsigned row_off(const Unit&, int) const { return 0u; }
};
constexpr int MOE_MAXU = 4;
struct MoeOrder {
    const LAS int* pre;
    const LAS int* cnt;
    const LAS int* ptab;
    int nct, G, c, K, brows;
    unsigned rshift_mask;
    unsigned rbytes;
    __device__ __forceinline__ bool decode(int i, int& e, int& rt, int& ct) const {
        if (i >= MOE_MAXU) return false;
        const int L = i * G + c, total = pre[32] * nct; if (L >= total) return false;
        const int rtg = L / nct; ct = L - rtg * nct; e = 0;
        for (int j = 1; j < 32; ++j) e = (pre[j] <= rtg) ? j : e;
        rt = rtg - pre[e]; return true;
    }
    __device__ __forceinline__ bool next(int i, Unit& u) const {
        int e, rt, ct; if (!decode(i, e, rt, ct)) return false;
        u.pm = rt; u.pn = ct; u.a_off = 0; u.b_off = ((size_t)e * brows + (size_t)ct * BM) * K * 2; u.ui = i; u.e = e;
        const int left = cnt[e] - rt * BM; u.nrows = left < BM ? left : BM; return true;
    }
    __device__ __forceinline__ unsigned row_off(const Unit& u, int r) const { const int p = ptab[u.ui * 256 + r]; return p < 0 ? 0u : ((unsigned)p & rshift_mask) * rbytes; }
};

template <class Epi, class Sched, bool GATHER>
__device__ __forceinline__ void gemm_phase(const int tid, LAS unsigned char* lds, const char* Abase, const char* Bbase, const int K, const Sched& S, const Epi& E, const int ntl = 0) {
    const int wid = __builtin_amdgcn_readfirstlane(tid >> 6), lane = tid & 63, wr = wid >> 2, wc = wid & 3, fr = lane & 15, fq = lane >> 4;
    const int nt = ntl ? ntl : K / BK;
    unsigned voff[2]; int RR[2]; unsigned CC2[2];
#pragma unroll
    for (int i = 0; i < 2; ++i) { int R, C; stage_rc(tid * 16 + i * 8192, R, C); voff[i] = (unsigned)(R * K + C) * 2u; RR[i] = R; CC2[i] = (unsigned)C * 2u; }
    const size_t kstep = (size_t)(BK * 2);
    const size_t hstep = (size_t)HALF * K * 2;
    const unsigned ldsw = (unsigned)wid * 1024u;
    const int aoff = lds_byte(wr * 64 + fr, fq * 8), boff = lds_byte(wc * 32 + fr, fq * 8);
#define PG8_SA(b, h) (((b) * 2 + (h)) * HTB)
#define PG8_SB(b, h) ((4 + (b) * 2 + (h)) * HTB)
#define PG8_STAGE_B(bufoff, gbase) do { _Pragma("unroll") for (int _i = 0; _i < 2; ++_i) \
        __builtin_amdgcn_global_load_lds((const unsigned*)((const char*)(gbase) + voff[_i]), (LAS unsigned*)(lds + (bufoff) + ldsw + _i * 8192), 16, 0, 0); } while (0)
#define PG8_STAGE_A(bufoff, gbase, ro, kb) do { _Pragma("unroll") for (int _i = 0; _i < 2; ++_i) { \
        if constexpr (GATHER) __builtin_amdgcn_global_load_lds((const unsigned*)(Abase + ((ro)[_i] + (unsigned)(kb))), (LAS unsigned*)(lds + (bufoff) + ldsw + _i * 8192), 16, 0, 0); \
        else __builtin_amdgcn_global_load_lds((const unsigned*)((const char*)(gbase) + voff[_i]), (LAS unsigned*)(lds + (bufoff) + ldsw + _i * 8192), 16, 0, 0); } } while (0)
#define PG8_LDA(dst, b, h) do { _Pragma("unroll") for (int m = 0; m < 4; ++m) _Pragma("unroll") for (int k = 0; k < 2; ++k) dst[m][k] = *(const LAS bf16x8*)(lds + PG8_SA(b, h) + aoff + m * 2048 + k * 1024); } while (0)
#define PG8_LDB(dst, b, h) do { _Pragma("unroll") for (int n = 0; n < 2; ++n) _Pragma("unroll") for (int k = 0; k < 2; ++k) dst[n][k] = *(const LAS bf16x8*)(lds + PG8_SB(b, h) + boff + n * 2048 + k * 1024); } while (0)
#define PG8_MMA(ai, bj, At, Bt) do { __builtin_amdgcn_s_setprio(1); _Pragma("unroll") for (int m = 0; m < 4; ++m) _Pragma("unroll") for (int n = 0; n < 2; ++n) _Pragma("unroll") for (int k = 0; k < 2; ++k) \
        acc[ai][bj][m][n] = __builtin_amdgcn_mfma_f32_16x16x32_bf16(Bt[n][k], At[m][k], acc[ai][bj][m][n], 0, 0, 0); __builtin_amdgcn_s_setprio(0); } while (0)
#define PG8_WAIT_V(n) asm volatile("s_waitcnt vmcnt(" #n ")" ::: "memory")
#define PG8_WAIT_L(n) asm volatile("s_waitcnt lgkmcnt(" #n ")" ::: "memory")
#define PG8_BAR __builtin_amdgcn_s_barrier()
#define PG8_SCHED __builtin_amdgcn_sched_barrier(0)
    Unit cur, nxt; int ui = 0;
    if (!S.next(0, cur)) return;
    f32x4 acc[2][2][4][2];
#pragma unroll
    for (int a = 0; a < 2; ++a)
#pragma unroll
        for (int b = 0; b < 2; ++b)
#pragma unroll
            for (int m = 0; m < 4; ++m)
#pragma unroll
                for (int n = 0; n < 2; ++n) acc[a][b][m][n] = (f32x4){0.f, 0.f, 0.f, 0.f};
    bf16x8 At[4][2], B0[2][2], B1[2][2];
    const char* cA = Abase + cur.a_off; const char* cB = Bbase + cur.b_off;
    unsigned cro0[2] = {0u, 0u}, cro1[2] = {0u, 0u}, nro0[2] = {0u, 0u}, nro1[2] = {0u, 0u};
    if constexpr (GATHER) {
#pragma unroll
        for (int i = 0; i < 2; ++i) { cro0[i] = S.row_off(cur, RR[i]) + CC2[i]; cro1[i] = S.row_off(cur, 128 + RR[i]) + CC2[i]; }
    }
    PG8_STAGE_B(PG8_SB(0, 0), cB); PG8_STAGE_A(PG8_SA(0, 0), cA, cro0, 0); PG8_STAGE_B(PG8_SB(0, 1), cB + hstep); PG8_STAGE_A(PG8_SA(0, 1), cA + hstep, cro1, 0);
    if (wr == 1) PG8_BAR;
    PG8_WAIT_V(4); PG8_BAR;
    PG8_STAGE_B(PG8_SB(1, 0), cB + kstep); PG8_STAGE_A(PG8_SA(1, 0), cA + kstep, cro0, kstep); PG8_STAGE_B(PG8_SB(1, 1), cB + hstep + kstep);
    PG8_WAIT_V(6); PG8_BAR;
    for (;;) {
        const bool has_next = S.next(ui + 1, nxt);
        const char* nA = has_next ? Abase + nxt.a_off : cA; const char* nB = has_next ? Bbase + nxt.b_off : cB;
        if constexpr (GATHER) {
#pragma unroll
            for (int i = 0; i < 2; ++i) { nro0[i] = has_next ? S.row_off(nxt, RR[i]) + CC2[i] : cro0[i]; nro1[i] = has_next ? S.row_off(nxt, 128 + RR[i]) + CC2[i] : cro1[i]; }
        }
        for (int t = 0; t < nt; t += 2) {
            const bool last = (t == nt - 2);
            const char* a1 = cA + (size_t)(t + 1) * kstep;
            const char* a2 = last ? nA : cA + (size_t)(t + 2) * kstep; const char* b2 = last ? nB : cB + (size_t)(t + 2) * kstep;
            const char* a3 = a2 + kstep; const char* b3 = b2 + kstep;
            unsigned r20[2], r21[2]; unsigned k1 = 0, k2 = 0, k3 = 0;
            if constexpr (GATHER) {
#pragma unroll
                for (int i = 0; i < 2; ++i) { r20[i] = last ? nro0[i] : cro0[i]; r21[i] = last ? nro1[i] : cro1[i]; }
                k1 = (unsigned)(t + 1) * 128u; k2 = last ? 0u : (unsigned)(t + 2) * 128u; k3 = k2 + 128u;
            } else { r20[0] = r20[1] = r21[0] = r21[1] = 0u; }
            PG8_LDB(B0, 0, 0); PG8_SCHED; PG8_LDA(At, 0, 0); PG8_STAGE_A(PG8_SA(1, 1), a1 + hstep, cro1, k1);
            PG8_WAIT_L(8); PG8_BAR; PG8_WAIT_L(0); PG8_MMA(0, 0, At, B0); PG8_BAR; PG8_SCHED;
            PG8_LDB(B1, 0, 1); PG8_STAGE_B(PG8_SB(0, 0), b2);
            PG8_BAR; PG8_WAIT_L(0); PG8_MMA(0, 1, At, B1); PG8_BAR;
            PG8_LDA(At, 0, 1); PG8_STAGE_A(PG8_SA(0, 0), a2, r20, k2);
            PG8_BAR; PG8_WAIT_L(0); PG8_MMA(1, 0, At, B0); PG8_BAR; PG8_SCHED;
            PG8_STAGE_B(PG8_SB(0, 1), b2 + hstep);
            PG8_WAIT_V(6); PG8_BAR; PG8_MMA(1, 1, At, B1); PG8_BAR;
            PG8_LDB(B0, 1, 0); PG8_SCHED; PG8_LDA(At, 1, 0); PG8_STAGE_A(PG8_SA(0, 1), a2 + hstep, r21, k2);
            PG8_WAIT_L(8); PG8_BAR; PG8_WAIT_L(0); PG8_MMA(0, 0, At, B0); PG8_BAR; PG8_SCHED;
            PG8_LDB(B1, 1, 1); PG8_STAGE_B(PG8_SB(1, 0), b3);
            PG8_BAR; PG8_WAIT_L(0); PG8_MMA(0, 1, At, B1); PG8_BAR;
            PG8_LDA(At, 1, 1); PG8_STAGE_A(PG8_SA(1, 0), a3, r20, k3);
            PG8_BAR; PG8_WAIT_L(0); PG8_MMA(1, 0, At, B0); PG8_BAR; PG8_SCHED;
            PG8_STAGE_B(PG8_SB(1, 1), b3 + hstep);
            PG8_WAIT_V(6); PG8_BAR; PG8_MMA(1, 1, At, B1); PG8_BAR;
        }
        E(acc, cur, wr, wc, fr, fq);
        if (!has_next) break;
#pragma unroll
        for (int a = 0; a < 2; ++a)
#pragma unroll
            for (int b = 0; b < 2; ++b)
#pragma unroll
                for (int m = 0; m < 4; ++m)
#pragma unroll
                    for (int n = 0; n < 2; ++n) acc[a][b][m][n] = (f32x4){0.f, 0.f, 0.f, 0.f};
        cur = nxt; cA = nA; cB = nB; ++ui;
        if constexpr (GATHER) {
#pragma unroll
            for (int i = 0; i < 2; ++i) { cro0[i] = nro0[i]; cro1[i] = nro1[i]; }
        }
    }
    PG8_WAIT_V(0);
    if (wr == 0) PG8_BAR;
    PG8_BAR;
#undef PG8_SA
#undef PG8_SB
#undef PG8_STAGE_A
#undef PG8_STAGE_B
#undef PG8_LDA
#undef PG8_LDB
#undef PG8_MMA
#undef PG8_WAIT_V
#undef PG8_WAIT_L
#undef PG8_BAR
#undef PG8_SCHED
}

#define EPI_ROWS_BEGIN _Pragma("unroll") for (int ai = 0; ai < 2; ++ai) _Pragma("unroll") for (int m = 0; m < 4; ++m) { const int rl = ai * HALF + wr * 64 + m * 16 + fr;
#define EPI_ROWS_END }
struct EpiStoreBf16 {
    bf16* O; int ldc; const float* rs;
    __device__ __forceinline__ void operator()(const f32x4 (&acc)[2][2][4][2], const Unit& u, int wr, int wc, int fr, int fq) const {
        EPI_ROWS_BEGIN bf16* rowp = O + (size_t)(u.pm * BM + rl) * ldc + u.pn * BM + wc * 32 + 8 * fq; const float sc = rs ? rs[u.pm * BM + rl] : 1.0f;
#pragma unroll
            for (int bj = 0; bj < 2; ++bj) { const f32x4 v0 = acc[ai][bj][m][0] * sc, v1 = acc[ai][bj][m][1] * sc;
                *(u32x4*)(rowp + bj * HALF) = (u32x4){pk2(v0[0], v0[1]), pk2(v0[2], v0[3]), pk2(v1[0], v1[1]), pk2(v1[2], v1[3])}; } EPI_ROWS_END
    }
};
struct EpiStoreBf16Split {
    bf16* O; int ldc; size_t half_stride; const float* rs;
    __device__ __forceinline__ void operator()(const f32x4 (&acc)[2][2][4][2], const Unit& u, int wr, int wc, int fr, int fq) const {
        EPI_ROWS_BEGIN bf16* rowp = O + (size_t)u.e * half_stride + (size_t)(u.pm * BM + rl) * ldc + u.pn * BM + wc * 32 + 8 * fq; const float sc = rs ? rs[u.pm * BM + rl] : 1.0f;
#pragma unroll
            for (int bj = 0; bj < 2; ++bj) { const f32x4 v0 = acc[ai][bj][m][0] * sc, v1 = acc[ai][bj][m][1] * sc;
                *(u32x4*)(rowp + bj * HALF) = (u32x4){pk2(v0[0], v0[1]), pk2(v0[2], v0[3]), pk2(v1[0], v1[1]), pk2(v1[2], v1[3])}; } EPI_ROWS_END
    }
};
struct EpiResid {
    bf16* X;
    __device__ __forceinline__ void operator()(const f32x4 (&acc)[2][2][4][2], const Unit& u, int wr, int wc, int fr, int fq) const {
#pragma unroll
        for (int ai = 0; ai < 2; ++ai) { bf16* base = X + (size_t)(u.pm * BM + ai * HALF + wr * 64 + fr) * D + u.pn * BM + wc * 32 + 8 * fq; u32x4 xv[4][2];
#pragma unroll
            for (int m = 0; m < 4; ++m)
#pragma unroll
                for (int bj = 0; bj < 2; ++bj) xv[m][bj] = *(const u32x4*)(base + (size_t)m * 16 * D + bj * HALF);
#pragma unroll
            for (int m = 0; m < 4; ++m)
#pragma unroll
                for (int bj = 0; bj < 2; ++bj) { const u32x2 lo = dn4(up4((u32x2){xv[m][bj].x, xv[m][bj].y}) + acc[ai][bj][m][0]), hi = dn4(up4((u32x2){xv[m][bj].z, xv[m][bj].w}) + acc[ai][bj][m][1]);
                    *(u32x4*)(base + (size_t)m * 16 * D + bj * HALF) = (u32x4){lo.x, lo.y, hi.x, hi.y}; }
            asm volatile("" ::: "memory"); }
    }
};
struct EpiGlu {
    bf16* X;
    __device__ __forceinline__ void operator()(const f32x4 (&acc)[2][2][4][2], const Unit& u, int wr, int wc, int fr, int fq) const {
#pragma unroll
        for (int ai = 0; ai < 2; ++ai) { u32x2 xv[4][2];
#pragma unroll
            for (int m = 0; m < 4; ++m)
#pragma unroll
                for (int bj = 0; bj < 2; ++bj) xv[m][bj] = *(const u32x2*)(X + (size_t)(u.pm * BM + ai * HALF + wr * 64 + m * 16 + fr) * D + 4 * fq + 16 * (8 * u.pn + 4 * bj + wc));
#pragma unroll
            for (int m = 0; m < 4; ++m)
#pragma unroll
                for (int bj = 0; bj < 2; ++bj) { const f32x4 a = acc[ai][bj][m][0], g = acc[ai][bj][m][1]; f32x4 x = up4(xv[m][bj]);
#pragma unroll
                    for (int j = 0; j < 4; ++j) x[j] += a[j] * sigmoidf_(g[j]);
                    *(u32x2*)(X + (size_t)(u.pm * BM + ai * HALF + wr * 64 + m * 16 + fr) * D + 4 * fq + 16 * (8 * u.pn + 4 * bj + wc)) = dn4(x); }
            asm volatile("" ::: "memory"); }
    }
};
struct EpiPle {
    const bf16* X; bf16* Xo; const bf16* PP; const float* bias; const float* rs;
    __device__ __forceinline__ void operator()(const f32x4 (&acc)[2][2][4][2], const Unit& u, int wr, int wc, int fr, int fq) const {
        const int col0 = u.pn * BM + wc * 32 + 8 * fq;
        f32x4 bv[2][2];
#pragma unroll
        for (int bj = 0; bj < 2; ++bj)
#pragma unroll
            for (int n = 0; n < 2; ++n) bv[bj][n] = *(const f32x4*)(bias + col0 + bj * HALF + n * 4);
#pragma unroll
        for (int ai = 0; ai < 2; ++ai) { const size_t ro = (size_t)(u.pm * BM + ai * HALF + wr * 64 + fr) * D + col0; u32x4 xv[4][2], pw[4][2]; float sc[4];
#pragma unroll
            for (int m = 0; m < 4; ++m) sc[m] = rs[u.pm * BM + ai * HALF + wr * 64 + m * 16 + fr];
#pragma unroll
            for (int m = 0; m < 4; ++m)
#pragma unroll
                for (int bj = 0; bj < 2; ++bj) { const size_t o = ro + (size_t)m * 16 * D + bj * HALF; xv[m][bj] = *(const u32x4*)(X + o); pw[m][bj] = *(const u32x4*)(PP + o); }
#pragma unroll
            for (int m = 0; m < 4; ++m)
#pragma unroll
                for (int bj = 0; bj < 2; ++bj) { const size_t o = ro + (size_t)m * 16 * D + bj * HALF; u32x2 outw[2];
#pragma unroll
                    for (int n = 0; n < 2; ++n) { const f32x4 v = acc[ai][bj][m][n] * sc[m] + bv[bj][n];
                        f32x4 x = up4(n ? (u32x2){xv[m][bj].z, xv[m][bj].w} : (u32x2){xv[m][bj].x, xv[m][bj].y}); const f32x4 pq = up4(n ? (u32x2){pw[m][bj].z, pw[m][bj].w} : (u32x2){pw[m][bj].x, pw[m][bj].y});
#pragma unroll
                        for (int j = 0; j < 4; ++j) x[j] += sigmoidf_(v[j]) * pq[j];
                        outw[n] = dn4(x); }
                    *(u32x4*)(Xo + o) = (u32x4){outw[0].x, outw[0].y, outw[1].x, outw[1].y}; }
            asm volatile("" ::: "memory"); }
    }
};
struct EpiMoeH {
    bf16* H; const float* comb; const LAS int* ptab;
    __device__ __forceinline__ void operator()(const f32x4 (&acc)[2][2][4][2], const Unit& u, int wr, int wc, int fr, int fq) const {
        EPI_ROWS_BEGIN const int pair = ptab[u.ui * 256 + rl];
            if (pair >= 0) { const float cb = comb[pair]; bf16* rowp = H + (size_t)pair * 512 + 4 * fq;
#pragma unroll
                for (int bj = 0; bj < 2; ++bj) { const f32x4 g = acc[ai][bj][m][0], up = acc[ai][bj][m][1]; u32x2 w;
                    w.x = pk2(siluf_(g[0]) * up[0] * cb, siluf_(g[1]) * up[1] * cb); w.y = pk2(siluf_(g[2]) * up[2] * cb, siluf_(g[3]) * up[3] * cb);
                    *(u32x2*)(rowp + 16 * (8 * u.pn + 4 * bj + wc)) = w; } } EPI_ROWS_END
    }
};
struct EpiMoeY {
    bf16* Y; const LAS int* ptab;
    __device__ __forceinline__ void operator()(const f32x4 (&acc)[2][2][4][2], const Unit& u, int wr, int wc, int fr, int fq) const {
        EPI_ROWS_BEGIN const int pair = ptab[u.ui * 256 + rl];
            if (pair >= 0) { bf16* rowp = Y + (size_t)pair * D + u.pn * BM + wc * 32 + 4 * fq;
#pragma unroll
                for (int bj = 0; bj < 2; ++bj)
#pragma unroll
                    for (int n = 0; n < 2; ++n) { const f32x4 v = acc[ai][bj][m][n]; u32x2 w; w.x = pk2(v[0], v[1]); w.y = pk2(v[2], v[3]); *(u32x2*)(rowp + bj * HALF + n * 16) = w; } } EPI_ROWS_END
    }
};
}

namespace fg {
constexpr int TM = 256, TN = 256, BK = 32, STG = 49152, NSTG = 3, MAXU = 6;
struct Tables { const LAS int* cnt; const LAS int* preU; const LAS int* ptab; const LAS int* utab; const LAS float* ctab; unsigned* flags; int stride, c0; };
__device__ __forceinline__ bool decode(const Tables& tb, int i, int& e, int& rt, int& ct) {
    if (i >= MAXU || tb.c0 < 0) return false;
    const int L = i * tb.stride + tb.c0; if (L >= tb.preU[32]) return false;
    e = 0;
    for (int j = 1; j < 32; ++j) e = (tb.preU[j] <= L) ? j : e;
    const int nrt = (tb.cnt[e] + 255) >> 8, r = L - tb.preU[e]; ct = r / nrt; rt = r - ct * nrt; return true;
}
template <int MODE, int DRY = 0>
__device__ __forceinline__ void fgemm_phase(const int tid, LAS unsigned char* lds, const Tables& tb, const char* Abase, const float* W1l, const float* W3l, bf16* Out, const int ub, const int ue) {
    constexpr int K = MODE == 0 ? 2048 : 512, NT = K / BK, LDN = MODE == 0 ? 512 : 2048;
    constexpr unsigned RBYTES = MODE == 0 ? 4096u : 1024u;
    const int wid = __builtin_amdgcn_readfirstlane(tid >> 6), lane = tid & 63, wr = wid >> 2, wc = wid & 3, fr = lane & 15, fq = lane >> 4;
    const unsigned ldsw = (unsigned)wid * 1024u;
    const int bc0 = 4 * lane, bc1 = (4 * lane) ^ 16;
    const int aoff = wr * 8192 + ((fr * 64 + fq * 16) ^ (((fr >> 3) & 1) << 5));
    const int bfo = 16384 + ((8 * fq) * 256 + ((wc * 64 + 2 * fr) ^ ((fq & 1) << 4))) * 4;
    const int nunits = ue;
    if (ue <= ub) return;
    const int total = (ue - ub) * NT;
    f32x4 acc[8][4];
#pragma unroll
    for (int m = 0; m < 8; ++m)
#pragma unroll
        for (int n = 0; n < 4; ++n) acc[m][n] = (f32x4){0.f, 0.f, 0.f, 0.f};
    int su = ub, skt = 0, ns = 0, sb3 = 0; unsigned s_aro[2]; const float* s_b0; const float* s_b1;
#define FG_BSRC(bc_, e_, ct_) (MODE == 0 ? ((((bc_) >> 5) & 1) ? W3l : W1l) + (size_t)(e_) * 2048 * 512 + (size_t)wid * 512 + (ct_) * 128 + 32 * ((bc_) >> 6) + ((bc_) & 31) \
                                         : W1l + (size_t)(e_) * 512 * 2048 + (size_t)wid * 2048 + (ct_) * 256 + (bc_))
#define FG_LOAD_UNIT(u_) do { const int e_ = tb.utab[3 * (u_)], ct_ = tb.utab[3 * (u_) + 2]; \
        if (MODE == 1 && tb.flags) {     \
            unsigned* fl_ = tb.flags + (e_ * 32 + tb.utab[3 * (u_) + 1]) * 16; unsigned sp_ = 0; \
            while (__hip_atomic_load(fl_, __ATOMIC_RELAXED, __HIP_MEMORY_SCOPE_AGENT) < 4u) { __builtin_amdgcn_s_sleep(4); if (++sp_ > (1u << 22)) break; } \
            __builtin_amdgcn_fence(__ATOMIC_ACQUIRE, "agent"); } \
        _Pragma("unroll") for (int i_ = 0; i_ < 2; ++i_) { const int b_ = i_ * 8192 + tid * 16, st_ = b_ >> 10, sb_ = b_ & 1023, swz_ = sb_ ^ (((sb_ >> 9) & 1) << 5); \
            const int p_ = tb.ptab[(u_) * 256 + st_ * 16 + swz_ / 64]; \
            s_aro[i_] = (p_ < 0 ? 0u : (MODE == 0 ? ((unsigned)p_ & 8191u) : (unsigned)p_) * RBYTES) + (unsigned)(swz_ % 64); } \
        s_b0 = FG_BSRC(bc0, e_, ct_); s_b1 = FG_BSRC(bc1, e_, ct_); } while (0)
#define FG_STAGE() do { LAS unsigned char* st_ = lds + sb3 * STG; \
        _Pragma("unroll") for (int i_ = 0; i_ < 2; ++i_) \
            __builtin_amdgcn_global_load_lds((const unsigned*)(Abase + (s_aro[i_] + (unsigned)skt * 64u)), (LAS unsigned*)(st_ + ldsw + i_ * 8192), 16, 0, 0); \
        _Pragma("unroll") for (int r_ = 0; r_ < 4; ++r_) __builtin_amdgcn_global_load_lds((const unsigned*)(((r_ & 1) ? s_b1 : s_b0) + (size_t)(skt * 32 + r_ * 8) * LDN), (LAS unsigned*)(st_ + 16384 + r_ * 8192 + ldsw), 16, 0, 0); \
        ++ns; sb3 = (sb3 == NSTG - 1) ? 0 : sb3 + 1; if (++skt == NT) { skt = 0; ++su; if (su < nunits) FG_LOAD_UNIT(su); } } while (0)
    FG_LOAD_UNIT(ub);
    FG_STAGE(); if (ns < total) FG_STAGE();
    int s = 0, cb3 = 0;
    for (int u = ub; u < nunits; ++u) {
#pragma unroll 1
        for (int kt = 0; kt < NT; ++kt, ++s) {
            if (ns - 1 - s >= 1) asm volatile("s_waitcnt vmcnt(6)" ::: "memory"); else asm volatile("s_waitcnt vmcnt(0)" ::: "memory");
            __builtin_amdgcn_s_barrier(); asm volatile("" ::: "memory");
            const LAS unsigned char* st = lds + cb3 * STG; cb3 = (cb3 == NSTG - 1) ? 0 : cb3 + 1;
            if (DRY == 2) { if (ns < total) FG_STAGE(); continue; }
            bf16x8 Af[8], Bf[4];
            f32x2 vb[2][8];
#pragma unroll
            for (int p2 = 0; p2 < 2; ++p2) { const LAS float* bp = (const LAS float*)(st + bfo) + p2 * 32;
#pragma unroll
                for (int j = 0; j < 8; ++j) vb[p2][j] = *(const LAS f32x2*)(bp + j * 256); }
#pragma unroll
            for (int m = 0; m < 8; ++m) Af[m] = *(const LAS bf16x8*)(st + aoff + m * 1024);
            if (ns < total) FG_STAGE();
#pragma unroll
            for (int p2 = 0; p2 < 2; ++p2) { const f32x2* v = vb[p2];
                u32x4 w0, w1; w0.x = pk2(v[0].x, v[1].x); w0.y = pk2(v[2].x, v[3].x); w0.z = pk2(v[4].x, v[5].x); w0.w = pk2(v[6].x, v[7].x);
                w1.x = pk2(v[0].y, v[1].y); w1.y = pk2(v[2].y, v[3].y); w1.z = pk2(v[4].y, v[5].y); w1.w = pk2(v[6].y, v[7].y);
                Bf[2 * p2] = __builtin_bit_cast(bf16x8, w0); Bf[2 * p2 + 1] = __builtin_bit_cast(bf16x8, w1); }
            if (DRY == 1) {
#pragma unroll
                for (int m = 0; m < 8; ++m) asm volatile("" :: "v"(Af[m]));
#pragma unroll
                for (int n = 0; n < 4; ++n) asm volatile("" :: "v"(Bf[n]));
                continue; }
            __builtin_amdgcn_s_setprio(1);
#pragma unroll
            for (int m = 0; m < 8; ++m)
#pragma unroll
                for (int n = 0; n < 4; ++n) acc[m][n] = __builtin_amdgcn_mfma_f32_16x16x32_bf16(Bf[n], Af[m], acc[m][n], 0, 0, 0);
            __builtin_amdgcn_s_setprio(0);
        }
        if (DRY == 0) {
            const int ct = tb.utab[3 * u + 2];
#pragma unroll
            for (int m = 0; m < 8; ++m) { const int ri = u * 256 + wr * 128 + m * 16 + fr; const int pair = tb.ptab[ri];
                if (pair >= 0) {
                    if (MODE == 0) { const float cb = tb.ctab[ri]; bf16* rowp = Out + (size_t)pair * 512 + ct * 128 + wc * 32 + 8 * fq;
                        const f32x4 g0 = acc[m][0], g1 = acc[m][1], u0 = acc[m][2], u1 = acc[m][3]; u32x4 w;
                        w.x = pk2(siluf_(g0[0]) * u0[0] * cb, siluf_(g1[0]) * u1[0] * cb); w.y = pk2(siluf_(g0[1]) * u0[1] * cb, siluf_(g1[1]) * u1[1] * cb);
                        w.z = pk2(siluf_(g0[2]) * u0[2] * cb, siluf_(g1[2]) * u1[2] * cb); w.w = pk2(siluf_(g0[3]) * u0[3] * cb, siluf_(g1[3]) * u1[3] * cb);
                        *(u32x4*)rowp = w; }
                    else { bf16* rowp = Out + (size_t)pair * D + ct * 256 + wc * 64 + 8 * fq;
#pragma unroll
                        for (int p2 = 0; p2 < 2; ++p2) { const f32x4 a = acc[m][2 * p2], b = acc[m][2 * p2 + 1]; u32x4 w;
                            w.x = pk2(a[0], b[0]); w.y = pk2(a[1], b[1]); w.z = pk2(a[2], b[2]); w.w = pk2(a[3], b[3]); *(u32x4*)(rowp + 32 * p2) = w; } } } }
#pragma unroll
            for (int m = 0; m < 8; ++m)
#pragma unroll
                for (int n = 0; n < 4; ++n) acc[m][n] = (f32x4){0.f, 0.f, 0.f, 0.f};
        }
    }
    asm volatile("s_waitcnt vmcnt(0)" ::: "memory");
    __syncthreads();
#undef FG_LOAD_UNIT
#undef FG_STAGE
#undef FG_BSRC
}
}

__device__ __forceinline__ void tr_item(const float* W, int ld, int K, int N, int col0, bf16* WT, int mode, int row_off, int item, int lane, const float* gk = nullptr) {
    const int nblk = N / 32, kb = item / nblk, nb = item - kb * nblk, k0 = 64 * kb, n0 = 32 * nb;
    const int kg = lane >> 3, c4 = lane & 7;
    const float* src = W + (size_t)(k0 + 8 * kg) * ld + col0 + n0 + 4 * c4;
    f32x4 v[8];
#pragma unroll
    for (int q = 0; q < 8; ++q) v[q] = *(const f32x4*)(src + (size_t)q * ld);
    if (gk) {
#pragma unroll
        for (int q = 0; q < 8; ++q) v[q] = v[q] * gk[k0 + 8 * kg + q]; }
#pragma unroll
    for (int i = 0; i < 4; ++i) { const int n = n0 + 4 * c4 + i; const int row = mode == 1 ? (32 * (n >> 4) + (n & 15) + row_off) : mode == 2 ? ((n & ~31) + 16 * ((n >> 2) & 1) + 4 * ((n & 31) >> 3) + (n & 3) + row_off) : (n + row_off);
        u32x4 o; o.x = pk2(v[0][i], v[1][i]); o.y = pk2(v[2][i], v[3][i]); o.z = pk2(v[4][i], v[5][i]); o.w = pk2(v[6][i], v[7][i]);
        *(u32x4*)(WT + (size_t)row * K + k0 + 8 * kg) = o; }
}
__device__ __forceinline__ void wcomb_item(const float* win, const float* wg, bf16* WT, int item, int lane, const float* gk) {
    const int jb = item & 7, kb = item >> 3, j = jb * 64 + lane, k0 = kb * 8;
    float g[16];
#pragma unroll
    for (int r = 0; r < 16; ++r) g[r] = wg[r * 512 + j];
    float o[8];
#pragma unroll
    for (int q = 0; q < 8; ++q) { const float* wr_ = win + (size_t)(k0 + q) * EV_IN + 5120; float s = 0.f;
#pragma unroll
        for (int r = 0; r < 16; ++r) s += wr_[r] * g[r];
        o[q] = s * gk[k0 + q]; }
    u32x4 w; w.x = pk2(o[0], o[1]); w.y = pk2(o[2], o[3]); w.z = pk2(o[4], o[5]); w.w = pk2(o[6], o[7]);
    *(u32x4*)(WT + (size_t)(5120 + (j & ~31) + 16 * ((j >> 2) & 1) + 4 * ((j & 31) >> 3) + (j & 3)) * D + k0) = w;
}
template <bool SRC_BF16, bool ADDY, bool WRITE_RES, int OUT>
__device__ __forceinline__ void norm_row(const void* src, const bf16* y0, const bf16* y1, bf16* res, const float* g, bf16* xn, float* of32, float* rs_out, int lane) {
    f32x4 va[4], vb[4]; float ss = 0.f;
#pragma unroll
    for (int j = 0; j < 4; ++j) { const int col = 8 * lane + 512 * j;
        if (SRC_BF16) { const u32x4 w = *(const u32x4*)((const bf16*)src + col); va[j] = up4((u32x2){w.x, w.y}); vb[j] = up4((u32x2){w.z, w.w}); }
        else { va[j] = *(const f32x4*)((const float*)src + col); vb[j] = *(const f32x4*)((const float*)src + col + 4); }
        if (ADDY) { const u32x4 a = *(const u32x4*)(y0 + col), b = *(const u32x4*)(y1 + col);
            va[j] = va[j] + up4((u32x2){a.x, a.y}) + up4((u32x2){b.x, b.y}); vb[j] = vb[j] + up4((u32x2){a.z, a.w}) + up4((u32x2){b.z, b.w}); }
        if (WRITE_RES) { const u32x2 wl = dn4(va[j]), wh = dn4(vb[j]); *(u32x4*)(res + col) = (u32x4){wl.x, wl.y, wh.x, wh.y}; va[j] = up4(wl); vb[j] = up4(wh); }
        ss += ((va[j][0] * va[j][0] + va[j][1] * va[j][1]) + (va[j][2] * va[j][2] + va[j][3] * va[j][3])) + ((vb[j][0] * vb[j][0] + vb[j][1] * vb[j][1]) + (vb[j][2] * vb[j][2] + vb[j][3] * vb[j][3])); }
    const float rs = rsqrtf(wave_sum(ss) * (1.0f / D) + EPS);
    if (rs_out && lane == 0) *rs_out = rs;
    if (OUT != 0) {
#pragma unroll
        for (int j = 0; j < 4; ++j) { const int col = 8 * lane + 512 * j; const f32x4 oa = va[j] * rs * *(const f32x4*)(g + col), ob = vb[j] * rs * *(const f32x4*)(g + col + 4);
            if (OUT == 1) { const u32x2 wl = dn4(oa), wh = dn4(ob); *(u32x4*)(xn + col) = (u32x4){wl.x, wl.y, wh.x, wh.y}; } else { *(f32x4*)(of32 + col) = oa; *(f32x4*)(of32 + col + 4) = ob; } } }
}

__device__ __forceinline__ void p0_prologue(Frame& F, KArgs& A) {
    const int gw = F.vcu * NWAVES + F.wave, NGW = F.G * NWAVES, lane = F.lane;
    unsigned char* ws = F.ws;
    constexpr int I_WIN = (D / 32) * (5120 / 64);
    constexpr int I_WC = (D / 8) * 8;
    constexpr int I_WOUT = (D / 32) * (D / 64);
    constexpr int I_ODW = (D / 32) * (1024 / 64);
    constexpr int I_GLU = (1024 / 32) * (2048 / 64);
    constexpr int I_PLEG = I_WOUT;
    constexpr int I_PLEP = (256 / 32) * (D / 64);
    constexpr int I_W1 = (D / 32) * (512 / 64);
    constexpr int I_W2 = (512 / 32) * (D / 64);
    constexpr int N_DENSE = 2 * (I_WIN + I_WC + I_WOUT + I_ODW + 2 * I_GLU) + 4 * (I_PLEG + I_PLEP);
    for (int it = gw; it < N_DENSE; it += NGW) {
        int r = it;
        if (r < 2 * I_WIN) { const int e = r / I_WIN; tr_item(A.in[6] + (size_t)e * D * EV_IN, EV_IN, D, 5120, 0, (bf16*)(ws + WS_WIN + e * SZ_WIN), 2, 0, r % I_WIN, lane, A.in[2] + (size_t)(2 * e) * D); continue; } r -= 2 * I_WIN;
        if (r < 2 * I_WC) { const int e = r / I_WC; wcomb_item(A.in[6] + (size_t)e * D * EV_IN, A.in[14] + (size_t)e * 16 * 512, (bf16*)(ws + WS_WIN + e * SZ_WIN), r % I_WC, lane, A.in[2] + (size_t)(2 * e) * D); continue; } r -= 2 * I_WC;
        if (r < 2 * I_WOUT) { const int e = r / I_WOUT; tr_item(A.in[17] + (size_t)e * D * D, D, D, D, 0, (bf16*)(ws + WS_WOUT + e * SZ_DD), 2, 0, r % I_WOUT, lane); continue; } r -= 2 * I_WOUT;
        if (r < 2 * I_ODW) { const int o = r / I_ODW; tr_item(A.in[18] + (size_t)o * D * 1024, 1024, D, 1024, 0, (bf16*)(ws + WS_ODWIN + o * SZ_ODWIN), 2, 0, r % I_ODW, lane, A.in[2] + (size_t)(2 * o + 1) * D); continue; } r -= 2 * I_ODW;
        if (r < 4 * I_GLU) { const int o = r / (2 * I_GLU), hf = (r / I_GLU) & 1; tr_item(A.in[27] + (size_t)o * 1024 * 4096, 4096, 1024, 2048, hf * 2048, (bf16*)(ws + WS_WGLU + o * SZ_WGLU), 1, hf * 16, r % I_GLU, lane); continue; } r -= 4 * I_GLU;
        if (r < 4 * I_PLEG) { const int l = r / I_PLEG; tr_item(A.in[35] + (size_t)l * D * D, D, D, D, 0, (bf16*)(ws + WS_PLEG + l * SZ_DD), 2, 0, r % I_PLEG, lane, A.in[4] + (size_t)l * D); continue; } r -= 4 * I_PLEG;
        { const int l = r / I_PLEP; tr_item(A.in[37] + (size_t)l * 256 * D, D, 256, D, 0, (bf16*)(ws + WS_PLEP + l * SZ_PLEP), 2, 0, r % I_PLEP, lane); }
    }
    for (int i = gw * 64 + lane; i < 4 * 16 * 4 * 48 * 40; i += NGW * 64) {
        const int k = i % 40, o = (i / 40) % 48, q = (i / (40 * 48)) & 3, t = (i / (40 * 48 * 4)) & 15, l = i / (40 * 48 * 64);
        unsigned hb = 0u, lb = 0u;
        if (o < 36 && k < 32) { const int kk = 512 * q + 32 * t + k;
            const float wv = o < 4 ? A.in[28][((size_t)l * D + kk) * 4 + o] : A.in[30][((size_t)l * D + kk) * 32 + (o - 4)];
            const float wf = wv * A.in[3][(size_t)l * D + kk]; hb = f2bf(wf); lb = f2bf(wf - bf2f(hb)); }
        bf16* img = (bf16*)(ws + WS_RTW) + (size_t)(l * 16 + t) * RTW_IMG + (q * 48 + o) * 40 + k;
        img[0] = (bf16)hb; img[4 * 48 * 40] = (bf16)lb;
    }
    { const float* p = A.in[1]; bf16* pb = (bf16*)(ws + WS_PB); const size_t n8 = (size_t)4 * T * 256 / 8;
        for (size_t i = (size_t)gw * 64 + lane; i < n8; i += (size_t)NGW * 64) { const f32x4 a = *(const f32x4*)(p + i * 8), b = *(const f32x4*)(p + i * 8 + 4);
            u32x4 w; w.x = pk2(a[0], a[1]); w.y = pk2(a[2], a[3]); w.z = pk2(b[0], b[1]); w.w = pk2(b[2], b[3]); *(u32x4*)(pb + i * 8) = w; } }
    for (int m = gw; m < T; m += NGW)
        norm_row<false, false, true, 0>(A.in[0] + (size_t)m * D, nullptr, nullptr, (bf16*)(ws + WS_XRES) + (size_t)m * D, nullptr, nullptr, nullptr, (float*)(ws + WS_RS) + m, lane);
}

__device__ __forceinline__ void lru_unit(Frame& F, KArgs& A, int e, int unit) {
    const int tid = F.tid, lane = F.lane, w = F.wave, b = unit >> 6, h = (unit >> 2) & 15, jq = unit & 3, n16 = lane & 15, kq = lane >> 4;
    LAS bf16* ZT = (LAS bf16*)F.lds;
    LAS bf16* XCB = ZT + 259 * 72;
    LAS float* aa = (LAS float*)(XCB + 256 * 72);
    LAS float* uu = aa + 4096;
    LAS bf16* GT = (LAS bf16*)(uu + 4096);
    LAS bf16* YT = GT + 4096;
    LAS float* sA = (LAS float*)(YT + 4096);
    LAS float* sH = sA + 512;
    LAS float* cin = sH + 512;
    LAS float* carry = cin + 512;
    LAS float* cw = carry + 16;
    const bf16* z = (const bf16*)(F.ws + WS_Z);
    bf16* ycat = (bf16*)(F.ws + WS_YCAT);
    float cwr[5][8];
    { const int c8 = tid & 7;
#pragma unroll
        for (int k = 0; k < 4; ++k) { const float* src = A.in[7] + ((size_t)e * 4 + k) * 1024 + h * 64 + c8 * 8; const f32x4 a = *(const f32x4*)src, b4 = *(const f32x4*)(src + 4);
            cwr[k][0] = a[0]; cwr[k][1] = a[1]; cwr[k][2] = a[2]; cwr[k][3] = a[3]; cwr[k][4] = b4[0]; cwr[k][5] = b4[1]; cwr[k][6] = b4[2]; cwr[k][7] = b4[3]; }
        const float* sb = A.in[8] + (size_t)e * 1024 + h * 64 + c8 * 8; const f32x4 a = *(const f32x4*)sb, b4 = *(const f32x4*)(sb + 4);
        cwr[4][0] = a[0]; cwr[4][1] = a[1]; cwr[4][2] = a[2]; cwr[4][3] = a[3]; cwr[4][4] = b4[0]; cwr[4][5] = b4[1]; cwr[4][6] = b4[2]; cwr[4][7] = b4[3]; }
    bf16x8 WAf[2], WXf[2];
    { const float* w_a = A.in[9] + ((size_t)(e * 16 + h) * 64) * 64 + jq * 16 + n16; const float* w_x = A.in[11] + ((size_t)(e * 16 + h) * 64) * 64 + jq * 16 + n16;
#pragma unroll
        for (int ks = 0; ks < 2; ++ks) { float va[8], vx[8];
#pragma unroll
            for (int j = 0; j < 8; ++j) { va[j] = w_a[(size_t)(32 * ks + 8 * kq + j) * 64]; vx[j] = w_x[(size_t)(32 * ks + 8 * kq + j) * 64]; }
            WAf[ks] = __builtin_bit_cast(bf16x8, (u32x4){pk2(va[0], va[1]), pk2(va[2], va[3]), pk2(va[4], va[5]), pk2(va[6], va[7])});
            WXf[ks] = __builtin_bit_cast(bf16x8, (u32x4){pk2(vx[0], vx[1]), pk2(vx[2], vx[3]), pk2(vx[4], vx[5]), pk2(vx[6], vx[7])}); } }
    float ba[4], bx[4], sp[4];
#pragma unroll
    for (int r = 0; r < 4; ++r) { const int ch = h * 64 + jq * 16 + 4 * kq + r; ba[r] = A.in[10][e * 1024 + ch]; bx[r] = A.in[12][e * 1024 + ch]; sp[r] = -8.0f * softplusf_(-A.in[13][e * 1024 + ch]); }
    u32x4 pz[4], pg;
#define LRU_PREFETCH(s0_) do { _Pragma("unroll") for (int r_ = 0; r_ < 4; ++r_) { const int piece = r_ * 512 + tid; pz[r_] = *(const u32x4*)(z + (size_t)(b * SEQ + (s0_) + (piece >> 3)) * ZW + h * 64 + (piece & 7) * 8); } \
        pg = *(const u32x4*)(z + (size_t)(b * SEQ + (s0_) + (tid >> 1)) * ZW + 1024 + h * 64 + jq * 16 + (tid & 1) * 8); } while (0)
    LRU_PREFETCH(0);
    const int tl = tid >> 1, half = tid & 1;
#pragma unroll 1
    for (int tb = 0; tb < 8; ++tb) {
        const int s0 = tb * 256;
        u32x4 halo = (u32x4){0u, 0u, 0u, 0u};
        if (tb > 0 && tid < 24) halo = *(const LAS u32x4*)(ZT + (256 + (tid >> 3)) * 72 + (tid & 7) * 8);
        LDS_BARRIER();
        if (tid < 24) *(LAS u32x4*)(ZT + (tid >> 3) * 72 + (tid & 7) * 8) = halo;
#pragma unroll
        for (int r = 0; r < 4; ++r) { const int piece = r * 512 + tid; *(LAS u32x4*)(ZT + (3 + (piece >> 3)) * 72 + (piece & 7) * 8) = pz[r]; }
        *(LAS u32x4*)(GT + (tid >> 1) * 16 + (tid & 1) * 8) = pg;
        if (tb < 7) LRU_PREFETCH(s0 + 256);
        LDS_BARRIER();
        { const int tg4 = tid >> 3, c8 = tid & 7; float xr[7][8];
#pragma unroll
            for (int r = 0; r < 7; ++r) { const u32x4 wv = *(const LAS u32x4*)(ZT + (4 * tg4 + r) * 72 + c8 * 8);
                xr[r][0] = lo16(wv.x); xr[r][1] = hi16(wv.x); xr[r][2] = lo16(wv.y); xr[r][3] = hi16(wv.y); xr[r][4] = lo16(wv.z); xr[r][5] = hi16(wv.z); xr[r][6] = lo16(wv.w); xr[r][7] = hi16(wv.w); }
#pragma unroll
            for (int i = 0; i < 4; ++i) { float accv[8];
#pragma unroll
                for (int q = 0; q < 8; ++q) { accv[q] = cwr[4][q];
#pragma unroll
                    for (int k = 0; k < 4; ++k) accv[q] += cwr[k][q] * xr[i + k][q]; }
                *(LAS u32x4*)(XCB + (4 * tg4 + i) * 72 + c8 * 8) = (u32x4){pk2(accv[0], accv[1]), pk2(accv[2], accv[3]), pk2(accv[4], accv[5]), pk2(accv[6], accv[7])}; } }
        LDS_BARRIER();
#pragma unroll
        for (int tt2 = 0; tt2 < 2; ++tt2) { const int tok = (2 * w + tt2) * 16 + n16; f32x4 da = (f32x4){0.f, 0.f, 0.f, 0.f}, dx = da;
#pragma unroll
            for (int ks = 0; ks < 2; ++ks) { const bf16x8 xf = *(const LAS bf16x8*)(XCB + tok * 72 + 32 * ks + 8 * kq);
                da = __builtin_amdgcn_mfma_f32_16x16x32_bf16(WAf[ks], xf, da, 0, 0, 0); dx = __builtin_amdgcn_mfma_f32_16x16x32_bf16(WXf[ks], xf, dx, 0, 0, 0); }
            const u32x2 xw = *(const LAS u32x2*)(XCB + tok * 72 + jq * 16 + 4 * kq); const float xo[4] = {lo16(xw.x), hi16(xw.x), lo16(xw.y), hi16(xw.y)};
            f32x4 av, uv;
#pragma unroll
            for (int r = 0; r < 4; ++r) { const float rg = sigmoidf_(da[r] + ba[r]), ig = sigmoidf_(dx[r] + bx[r]); const float la = rg * sp[r];
                av[r] = __expf(la); uv[r] = __builtin_amdgcn_sqrtf(fmaxf(one_minus_exp(2.0f * la), 0.f)) * ig * xo[r]; }
            *(LAS f32x4*)(aa + tok * 16 + 4 * kq) = av; *(LAS f32x4*)(uu + tok * 16 + 4 * kq) = uv; }
        LDS_BARRIER();
        const int ch = tid & 15, seg = tid >> 4;
        { float Ac = 1.f, Hh = 0.f;
#pragma unroll
            for (int q = 0; q < 8; ++q) { const float a = aa[(seg * 8 + q) * 16 + ch], u = uu[(seg * 8 + q) * 16 + ch]; Hh = a * Hh + u; Ac *= a; }
            sA[seg * 16 + ch] = Ac; sH[seg * 16 + ch] = Hh; }
        LDS_BARRIER();
        if (tid < 16) { float c = (tb == 0) ? 0.f : carry[tid];
#pragma unroll 4
            for (int sg = 0; sg < 32; ++sg) { cin[sg * 16 + tid] = c; c = sA[sg * 16 + tid] * c + sH[sg * 16 + tid]; }
            carry[tid] = c; }
        LDS_BARRIER();
        { float hh = cin[seg * 16 + ch];
#pragma unroll
            for (int q = 0; q < 8; ++q) { const int tq = seg * 8 + q; hh = aa[tq * 16 + ch] * hh + uu[tq * 16 + ch];
                YT[tq * 16 + ch] = (bf16)f2bf(hh * gelu_tanh(bf2f(GT[tq * 16 + ch]))); } }
        LDS_BARRIER();
        *(u32x4*)(ycat + (size_t)(b * SEQ + s0 + (tid >> 1)) * D + h * 64 + jq * 16 + (tid & 1) * 8) = *(const LAS u32x4*)(YT + (tid >> 1) * 16 + (tid & 1) * 8);
    }
#undef LRU_PREFETCH
    LDS_BARRIER();
}

__device__ __forceinline__ void gla_bcum(Frame& F, KArgs& A, int e, int h, size_t t0, LAS float* buf, int stride, LAS float* bl, LAS float* seg4) {
    const int tid = F.tid; const bf16* z = (const bf16*)(F.ws + WS_Z);
    { const int t = tid >> 3, d0 = (tid & 7) * 16; const bf16* zr = z + (t0 + t) * ZW + 5120 + h * 128 + d0; const float* bg = A.in[15] + e * 512 + h * 128 + d0;
#pragma unroll
        for (int c8 = 0; c8 < 2; ++c8) { const u32x4 w = *(const u32x4*)(zr + c8 * 8); LAS float* o = buf + t * stride + d0 + c8 * 8; const float* bb = bg + c8 * 8;
            o[0] = logsigmoidf_(lo16(w.x) + bb[0]) * 0.0625f; o[1] = logsigmoidf_(hi16(w.x) + bb[1]) * 0.0625f; o[2] = logsigmoidf_(lo16(w.y) + bb[2]) * 0.0625f; o[3] = logsigmoidf_(hi16(w.y) + bb[3]) * 0.0625f;
            o[4] = logsigmoidf_(lo16(w.z) + bb[4]) * 0.0625f; o[5] = logsigmoidf_(hi16(w.z) + bb[5]) * 0.0625f; o[6] = logsigmoidf_(lo16(w.w) + bb[6]) * 0.0625f; o[7] = logsigmoidf_(hi16(w.w) + bb[7]) * 0.0625f; } }
    __syncthreads();
    const int d = tid & 127, sg = tid >> 7; float v[16];
    { float run = 0.f;
#pragma unroll
        for (int j = 0; j < 16; ++j) { run += buf[(sg * 16 + j) * stride + d]; v[j] = run; }
        seg4[sg * 128 + d] = run; }
    __syncthreads();
    { float off = 0.f;
#pragma unroll
        for (int q = 0; q < 3; ++q) off += (q < sg) ? seg4[q * 128 + d] : 0.f;
#pragma unroll
        for (int j = 0; j < 16; ++j) buf[(sg * 16 + j) * stride + d] = v[j] + off;
        if (sg == 3) bl[d] = v[15] + off; }
    __syncthreads();
}
typedef short s16x4 __attribute__((ext_vector_type(4)));
__device__ __forceinline__ bf16x8 tr_frag(const LAS bf16* tile, int rs  , int row0, int col0, int lane) {
    const int g = lane >> 4, q = (lane & 15) >> 2, p = lane & 3;
    const LAS bf16* a0 = tile + (row0 + 8 * g + q) * rs + col0 + 4 * p;
    const s16x4 lo = __builtin_amdgcn_ds_read_tr16_b64_v4i16((LAS s16x4*)a0), hi = __builtin_amdgcn_ds_read_tr16_b64_v4i16((LAS s16x4*)(a0 + 4 * rs));
    return (bf16x8){lo[0], lo[1], lo[2], lo[3], hi[0], hi[1], hi[2], hi[3]};
}
__device__ __forceinline__ void gla_ds_unit(Frame& F, KArgs& A, int e, int unit) {
    const int tid = F.tid, lane = F.lane, w = F.wave, b = unit >> 7, h = (unit >> 5) & 3, c = unit & 31, bh = b * 4 + h; const size_t t0 = (size_t)b * SEQ + c * 64;
    const int n16 = lane & 15, kq = lane >> 4;
    LAS float* BC = (LAS float*)F.lds;
    LAS bf16* KE = (LAS bf16*)(F.lds + 33792);
    LAS bf16* VT = KE + 64 * 136;
    LAS float* BL = (LAS float*)(VT + 64 * 272);
    LAS float* SEG = BL + 128;
    const bf16* z = (const bf16*)(F.ws + WS_Z);
    gla_bcum(F, A, e, h, t0, BC, 132, BL, SEG);
    { const int t = tid >> 3, d0 = (tid & 7) * 16; const bf16* zr = z + (t0 + t) * ZW + 2560 + h * 128 + d0;
#pragma unroll
        for (int c8 = 0; c8 < 2; ++c8) { const u32x4 kw = *(const u32x4*)(zr + c8 * 8); const LAS float* bc = BC + t * 132 + d0 + c8 * 8; const LAS float* bl = BL + d0 + c8 * 8;
            const float kv[8] = {lo16(kw.x), hi16(kw.x), lo16(kw.y), hi16(kw.y), lo16(kw.z), hi16(kw.z), lo16(kw.w), hi16(kw.w)}; float ko[8];
#pragma unroll
            for (int j = 0; j < 8; ++j) ko[j] = kv[j] * __expf(bl[j] - bc[j]);
            *(LAS u32x4*)(KE + t * 136 + d0 + c8 * 8) = (u32x4){pk2(ko[0], ko[1]), pk2(ko[2], ko[3]), pk2(ko[4], ko[5]), pk2(ko[6], ko[7])}; }
        const int v0 = (tid & 7) * 32; const bf16* vr = z + (t0 + t) * ZW + 3072 + h * 256 + v0;
#pragma unroll
        for (int c8 = 0; c8 < 4; ++c8) *(LAS u32x4*)(VT + t * 272 + v0 + c8 * 8) = *(const u32x4*)(vr + c8 * 8); }
    if (tid < 128) ((float*)(F.ws + WS_DECAY))[(size_t)(bh * 32 + c) * 128 + tid] = __expf(BL[tid]);
    __syncthreads();
    f32x4 acc[2][8];
#pragma unroll
    for (int vb = 0; vb < 2; ++vb)
#pragma unroll
        for (int db = 0; db < 8; ++db) acc[vb][db] = (f32x4){0.f, 0.f, 0.f, 0.f};
#pragma unroll
    for (int ks = 0; ks < 2; ++ks) { bf16x8 af[2];
#pragma unroll
        for (int vb = 0; vb < 2; ++vb) af[vb] = tr_frag(VT, 272, 32 * ks, (2 * w + vb) * 16, lane);
#pragma unroll
        for (int db = 0; db < 8; ++db) { const bf16x8 bfr = tr_frag(KE, 136, 32 * ks, db * 16, lane);
#pragma unroll
            for (int vb = 0; vb < 2; ++vb) acc[vb][db] = __builtin_amdgcn_mfma_f32_16x16x32_bf16(af[vb], bfr, acc[vb][db], 0, 0, 0); } }
    bf16* ds = (bf16*)(F.ws + WS_DS) + (size_t)(bh * 32 + c) * 128 * 256;
#pragma unroll
    for (int db = 0; db < 8; ++db)
#pragma unroll
        for (int vb = 0; vb < 2; ++vb) *(u32x2*)(ds + (size_t)(db * 16 + n16) * 256 + (2 * w + vb) * 16 + 4 * kq) = dn4(acc[vb][db]);
    LDS_BARRIER();
}
__device__ __forceinline__ void gla_state_phase(Frame& F) {
    const bf16* ds = (const bf16*)(F.ws + WS_DS); bf16* sp = (bf16*)(F.ws + WS_SPREV); const float* dec = (const float*)(F.ws + WS_DECAY);
    for (int it = F.vcu * NTHR + F.tid; it < 16 * 128 * 32; it += F.G * NTHR) {
        const int bh = it >> 12, d = (it >> 5) & 127, v8 = it & 31; f32x4 sa = (f32x4){0.f, 0.f, 0.f, 0.f}, sb = sa;
#pragma unroll 1
        for (int c0 = 0; c0 < 32; c0 += 8) { u32x4 dv[8]; float dc[8];
#pragma unroll
            for (int j = 0; j < 8; ++j) { const size_t idx = ((size_t)(bh * 32 + c0 + j) * 128 + d) * 256 + v8 * 8; dv[j] = *(const u32x4*)(ds + idx); dc[j] = dec[(size_t)(bh * 32 + c0 + j) * 128 + d]; }
#pragma unroll
            for (int j = 0; j < 8; ++j) { const size_t idx = ((size_t)(bh * 32 + c0 + j) * 128 + d) * 256 + v8 * 8;
                *(u32x4*)(sp + idx) = (u32x4){pk2(sa[0], sa[1]), pk2(sa[2], sa[3]), pk2(sb[0], sb[1]), pk2(sb[2], sb[3])};
                sa = sa * dc[j] + up4((u32x2){dv[j].x, dv[j].y}); sb = sb * dc[j] + up4((u32x2){dv[j].z, dv[j].w}); } }
    }
}
__device__ __forceinline__ void gla_out_unit(Frame& F, KArgs& A, int e, int unit) {
    const int tid = F.tid, lane = F.lane, w = F.wave, b = unit >> 7, h = (unit >> 5) & 3, c = unit & 31, bh = b * 4 + h; const size_t t0 = (size_t)b * SEQ + c * 64;
    const int n16 = lane & 15, kq = lane >> 4;
    LAS float* BC = (LAS float*)F.lds;
    LAS bf16* ATT = (LAS bf16*)F.lds;
    LAS bf16* QS = (LAS bf16*)(F.lds + 33792);
    LAS bf16* KS = QS + 64 * 136;
    LAS bf16* VT = KS + 64 * 136;
    LAS bf16* SB = VT + 64 * 272;
    LAS float* RSS = (LAS float*)(SB + 64 * 272);
    LAS float* BL = RSS + 512;
    LAS float* SEG = BL + 128;
    const bf16* z = (const bf16*)(F.ws + WS_Z);
    const bf16* spg = (const bf16*)(F.ws + WS_SPREV) + (size_t)(bh * 32 + c) * 128 * 256;
    gla_bcum(F, A, e, h, t0, BC, 132, BL, SEG);
    u32x4 sb2[4];
    { const int t = tid >> 3, d0 = (tid & 7) * 16; const bf16* qr = z + (t0 + t) * ZW + 2048 + h * 128 + d0; const bf16* kr = z + (t0 + t) * ZW + 2560 + h * 128 + d0;
#pragma unroll
        for (int c8 = 0; c8 < 2; ++c8) { const u32x4 qw = *(const u32x4*)(qr + c8 * 8), kw = *(const u32x4*)(kr + c8 * 8); const LAS float* bc = BC + t * 132 + d0 + c8 * 8;
            const float qv[8] = {lo16(qw.x), hi16(qw.x), lo16(qw.y), hi16(qw.y), lo16(qw.z), hi16(qw.z), lo16(qw.w), hi16(qw.w)};
            const float kv[8] = {lo16(kw.x), hi16(kw.x), lo16(kw.y), hi16(kw.y), lo16(kw.z), hi16(kw.z), lo16(kw.w), hi16(kw.w)};
            float qo[8], ko[8];
#pragma unroll
            for (int j = 0; j < 8; ++j) { const float bcv = bc[j]; qo[j] = qv[j] * 0.08838834764831845f * __expf(bcv); ko[j] = kv[j] * __expf(-bcv); }
            *(LAS u32x4*)(QS + t * 136 + d0 + c8 * 8) = (u32x4){pk2(qo[0], qo[1]), pk2(qo[2], qo[3]), pk2(qo[4], qo[5]), pk2(qo[6], qo[7])};
            *(LAS u32x4*)(KS + t * 136 + d0 + c8 * 8) = (u32x4){pk2(ko[0], ko[1]), pk2(ko[2], ko[3]), pk2(ko[4], ko[5]), pk2(ko[6], ko[7])}; }
        const int v0 = (tid & 7) * 32; const bf16* vr = z + (t0 + t) * ZW + 3072 + h * 256 + v0; const bf16* sr = spg + (size_t)t * 256 + v0;
#pragma unroll
        for (int c8 = 0; c8 < 4; ++c8) { *(LAS u32x4*)(VT + t * 272 + v0 + c8 * 8) = *(const u32x4*)(vr + c8 * 8); *(LAS u32x4*)(SB + t * 272 + v0 + c8 * 8) = *(const u32x4*)(sr + c8 * 8); }
#pragma unroll
        for (int c8 = 0; c8 < 4; ++c8) sb2[c8] = *(const u32x4*)(sr + (size_t)64 * 256 + c8 * 8); }
    LDS_BARRIER();
    { const int ib = w >> 1;
#pragma unroll
        for (int jj = 0; jj < 2; ++jj) { const int jb = (w & 1) * 2 + jj; f32x4 d = (f32x4){0.f, 0.f, 0.f, 0.f};
            if (jb <= ib) {
#pragma unroll
                for (int ks = 0; ks < 4; ++ks) { const bf16x8 kf = *(const LAS bf16x8*)(KS + (16 * jb + n16) * 136 + 32 * ks + 8 * kq), qf = *(const LAS bf16x8*)(QS + (16 * ib + n16) * 136 + 32 * ks + 8 * kq);
                    d = __builtin_amdgcn_mfma_f32_16x16x32_bf16(kf, qf, d, 0, 0, 0); }
#pragma unroll
                for (int r = 0; r < 4; ++r) if (16 * jb + 4 * kq + r > 16 * ib + n16) d[r] = 0.f; }
            *(LAS u32x2*)(ATT + (16 * ib + n16) * 72 + 16 * jb + 4 * kq) = (u32x2){pk2(d[0], d[1]), pk2(d[2], d[3])}; } }
    __syncthreads();
    f32x4 acc[2][4];
#pragma unroll
    for (int vb = 0; vb < 2; ++vb)
#pragma unroll
        for (int ib = 0; ib < 4; ++ib) acc[vb][ib] = (f32x4){0.f, 0.f, 0.f, 0.f};
#pragma unroll
    for (int ks = 0; ks < 2; ++ks) { bf16x8 af[2];
#pragma unroll
        for (int vb = 0; vb < 2; ++vb) af[vb] = tr_frag(VT, 272, 32 * ks, (2 * w + vb) * 16, lane);
#pragma unroll
        for (int ib = 0; ib < 4; ++ib) if (32 * ks <= 16 * ib + 15) { const bf16x8 bfr = *(const LAS bf16x8*)(ATT + (16 * ib + n16) * 72 + 32 * ks + 8 * kq);
#pragma unroll
            for (int vb = 0; vb < 2; ++vb) acc[vb][ib] = __builtin_amdgcn_mfma_f32_16x16x32_bf16(af[vb], bfr, acc[vb][ib], 0, 0, 0); } }
#pragma unroll
    for (int half = 0; half < 2; ++half) {
        if (half == 1) { LDS_BARRIER();
            const int t = tid >> 3, v0 = (tid & 7) * 32;
#pragma unroll
            for (int c8 = 0; c8 < 4; ++c8) *(LAS u32x4*)(SB + t * 272 + v0 + c8 * 8) = sb2[c8];
            LDS_BARRIER(); }
#pragma unroll
        for (int ks = 0; ks < 2; ++ks) { bf16x8 af[2];
#pragma unroll
            for (int vb = 0; vb < 2; ++vb) af[vb] = tr_frag(SB, 272, 32 * ks, (2 * w + vb) * 16, lane);
#pragma unroll
            for (int ib = 0; ib < 4; ++ib) { const bf16x8 bfr = *(const LAS bf16x8*)(QS + (16 * ib + n16) * 136 + 64 * half + 32 * ks + 8 * kq);
#pragma unroll
                for (int vb = 0; vb < 2; ++vb) acc[vb][ib] = __builtin_amdgcn_mfma_f32_16x16x32_bf16(af[vb], bfr, acc[vb][ib], 0, 0, 0); } } }
#pragma unroll
    for (int ib = 0; ib < 4; ++ib) { float ss = 0.f;
#pragma unroll
        for (int vb = 0; vb < 2; ++vb)
#pragma unroll
            for (int r = 0; r < 4; ++r) ss += acc[vb][ib][r] * acc[vb][ib][r];
        ss += shx(ss, 16, lane); ss += shx(ss, 32, lane);
        if (kq == 0) RSS[w * 64 + 16 * ib + n16] = ss; }
    u32x2 gwv[4][2]; f32x4 hnv[2];
#pragma unroll
    for (int vb = 0; vb < 2; ++vb) { const int v = (2 * w + vb) * 16 + 4 * kq; hnv[vb] = *(const f32x4*)(A.in[16] + e * 1024 + h * 256 + v);
#pragma unroll
        for (int ib = 0; ib < 4; ++ib) gwv[ib][vb] = *(const u32x2*)(z + (t0 + 16 * ib + n16) * ZW + 4096 + h * 256 + v); }
    LDS_BARRIER();
#pragma unroll
    for (int ib = 0; ib < 4; ++ib) { float tot = 0.f;
#pragma unroll
        for (int ww = 0; ww < 8; ++ww) tot += RSS[ww * 64 + 16 * ib + n16];
        const float rs = rsqrtf(tot * (1.0f / 256.0f) + EPS); const size_t t = t0 + 16 * ib + n16;
#pragma unroll
        for (int vb = 0; vb < 2; ++vb) { const int v = (2 * w + vb) * 16 + 4 * kq; const f32x4 hn = hnv[vb]; const u32x2 gw = gwv[ib][vb];
            const f32x4 o = acc[vb][ib];
            const float y0 = o[0] * rs * hn[0] * siluf_(lo16(gw.x)), y1 = o[1] * rs * hn[1] * siluf_(hi16(gw.x)), y2 = o[2] * rs * hn[2] * siluf_(lo16(gw.y)), y3 = o[3] * rs * hn[3] * siluf_(hi16(gw.y));
            *(u32x2*)((bf16*)(F.ws + WS_YCAT) + t * D + 1024 + h * 256 + v) = (u32x2){pk2(y0, y1), pk2(y2, y3)}; } }
    LDS_BARRIER();
}

__device__ __forceinline__ void s5_unit(Frame& F, KArgs& A, int o, int unit) {
    const int tid = F.tid, lane = F.lane, w = F.wave, b = unit >> 6, g = unit & 63;
    LAS unsigned* U = (LAS unsigned*)F.lds;
    LAS float* XBall = (LAS float*)(F.lds + 65536);
    LAS float* EE = XBall + 8 * 2560;
    const bf16* u = (const bf16*)(F.ws + WS_U);
#pragma unroll
    for (int r = 0; r < 8; ++r) { const int piece = r * 512 + tid, tok = piece >> 1, hf = piece & 1; const size_t o_ = (size_t)(b * SEQ + tok) * 1024 + g * 16 + hf * 8;
        const u32x4 p0 = *(const u32x4*)(u + o_), p1 = *(const u32x4*)(u + (size_t)T * 1024 + o_);
        *(LAS u32x4*)(U + tok * 8 + hf * 4) = (u32x4){pk2(lo16(p0.x) + lo16(p1.x), hi16(p0.x) + hi16(p1.x)), pk2(lo16(p0.y) + lo16(p1.y), hi16(p0.y) + hi16(p1.y)),
                                                     pk2(lo16(p0.z) + lo16(p1.z), hi16(p0.z) + hi16(p1.z)), pk2(lo16(p0.w) + lo16(p1.w), hi16(p0.w) + hi16(p1.w))}; }
    const int n16 = lane & 15, kq = lane >> 4;
    const size_t gbase = (size_t)(o * 64 + g) * 64;
    const float dt = expf(A.in[21][o * 64 + g]);
    float ab_re, ab_im;
    { const float lr = fminf(A.in[19][gbase + lane], -1e-4f), li = A.in[20][gbase + lane]; const float mag = expf(lr * dt); ab_re = mag * cosf(li * dt); ab_im = mag * sinf(li * dt); }
    bf16x8 Bb[8];
#pragma unroll
    for (int f = 0; f < 4; ++f) { const int p = 16 * f + n16; const float lr = fminf(A.in[19][gbase + p], -1e-4f), li = A.in[20][gbase + p];
        const float mag = expf(lr * dt), are = mag * cosf(li * dt), aim = mag * sinf(li * dt), den = lr * lr + li * li;
        const float cre = ((are - 1.0f) * lr + aim * li) / den, cim = (aim * lr - (are - 1.0f) * li) / den;
        u32x4 wr_ = (u32x4){0u, 0u, 0u, 0u}, wi_ = (u32x4){0u, 0u, 0u, 0u};
        if (kq < 2) { const float* br = A.in[22] + (gbase + p) * 16 + kq * 8; const float* bi = A.in[23] + (gbase + p) * 16 + kq * 8; float vr[8], vi[8];
#pragma unroll
            for (int j = 0; j < 8; ++j) { vr[j] = cre * br[j] - cim * bi[j]; vi[j] = cre * bi[j] + cim * br[j]; }
            wr_ = (u32x4){pk2(vr[0], vr[1]), pk2(vr[2], vr[3]), pk2(vr[4], vr[5]), pk2(vr[6], vr[7])}; wi_ = (u32x4){pk2(vi[0], vi[1]), pk2(vi[2], vi[3]), pk2(vi[4], vi[5]), pk2(vi[6], vi[7])}; }
        Bb[f] = __builtin_bit_cast(bf16x8, wr_); Bb[4 + f] = __builtin_bit_cast(bf16x8, wi_); }
    bf16x8 Ct[4];
#pragma unroll
    for (int ks = 0; ks < 4; ++ks) { const int k0 = 32 * ks + 8 * kq; const float* src = (k0 < 64 ? A.in[24] : A.in[25]) + (gbase / 64 * 16 + n16) * 64 + (k0 & 63); const float sg = k0 < 64 ? 1.0f : -1.0f;
        const u32x4 wv = (u32x4){pk2(sg * src[0], sg * src[1]), pk2(sg * src[2], sg * src[3]), pk2(sg * src[4], sg * src[5]), pk2(sg * src[6], sg * src[7])}; Ct[ks] = __builtin_bit_cast(bf16x8, wv); }
    const f32x4 dsk = *(const f32x4*)(A.in[26] + o * 1024 + g * 16 + kq * 4);
    __syncthreads();
    LAS float* xb = XBall + w * 2560;
    const f32x4 z4 = (f32x4){0.f, 0.f, 0.f, 0.f};
#define S5_BU(tok0) { bf16x8 Uf = (bf16x8){0, 0, 0, 0, 0, 0, 0, 0}; if (kq < 2) Uf = __builtin_bit_cast(bf16x8, *(const LAS u32x4*)(U + ((tok0) + n16) * 8 + kq * 4)); \
        _Pragma("unroll") for (int f = 0; f < 8; ++f) { const f32x4 d = __builtin_amdgcn_mfma_f32_16x16x32_bf16(Uf, Bb[f], z4, 0, 0, 0); \
            *(LAS f32x4*)(xb + (16 * f + n16) * 20 + 4 * kq) = d; } }
#define S5_READ_BU() f32x4 br4[4], bi4[4]; _Pragma("unroll") for (int j = 0; j < 4; ++j) { br4[j] = *(const LAS f32x4*)(xb + lane * 20 + 4 * j); bi4[j] = *(const LAS f32x4*)(xb + (64 + lane) * 20 + 4 * j); }
    float hr = 0.f, hi = 0.f;
    for (int sub = 0; sub < 16; ++sub) { const int tok0 = w * 256 + sub * 16;
        S5_BU(tok0)
        S5_READ_BU()
#pragma unroll
        for (int t = 0; t < 16; ++t) { const float br = br4[t >> 2][t & 3], bi = bi4[t >> 2][t & 3]; const float nr = ab_re * hr - ab_im * hi + br, ni = ab_re * hi + ab_im * hr + bi; hr = nr; hi = ni; } }
    EE[(w * 64 + lane) * 2] = hr; EE[(w * 64 + lane) * 2 + 1] = hi;
    float pr = ab_re, pi = ab_im;
#pragma unroll
    for (int sq = 0; sq < 8; ++sq) { const float nr = pr * pr - pi * pi, ni = 2.0f * pr * pi; pr = nr; pi = ni; }
    __syncthreads();
    hr = 0.f; hi = 0.f;
    for (int sg = 0; sg < w; ++sg) { const float er = EE[(sg * 64 + lane) * 2], ei = EE[(sg * 64 + lane) * 2 + 1]; const float nr = pr * hr - pi * hi + er, ni = pr * hi + pi * hr + ei; hr = nr; hi = ni; }
    for (int sub = 0; sub < 16; ++sub) { const int tok0 = w * 256 + sub * 16;
        S5_BU(tok0)
        S5_READ_BU()
        asm volatile("s_waitcnt lgkmcnt(0)" ::: "memory");
#pragma unroll
        for (int t = 0; t < 16; ++t) { const float br = br4[t >> 2][t & 3], bi = bi4[t >> 2][t & 3]; const float nr = ab_re * hr - ab_im * hi + br, ni = ab_re * hi + ab_im * hr + bi; hr = nr; hi = ni;
            xb[t * 132 + lane] = hr; xb[t * 132 + 64 + lane] = hi; }
        f32x4 y = z4;
#pragma unroll
        for (int ks = 0; ks < 4; ++ks) { const f32x4 h0 = *(const LAS f32x4*)(xb + n16 * 132 + 32 * ks + 8 * kq), h1 = *(const LAS f32x4*)(xb + n16 * 132 + 32 * ks + 8 * kq + 4);
            const u32x4 hw = (u32x4){pk2(h0[0], h0[1]), pk2(h0[2], h0[3]), pk2(h1[0], h1[1]), pk2(h1[2], h1[3])};
            y = __builtin_amdgcn_mfma_f32_16x16x32_bf16(Ct[ks], __builtin_bit_cast(bf16x8, hw), y, 0, 0, 0); }
        const int tok = tok0 + n16; const u32x2 uw = *(const LAS u32x2*)(U + tok * 8 + kq * 2);
        const float y0 = y[0] + dsk[0] * lo16(uw.x), y1 = y[1] + dsk[1] * hi16(uw.x), y2 = y[2] + dsk[2] * lo16(uw.y), y3 = y[3] + dsk[3] * hi16(uw.y);
        u32x2 ow; ow.x = pk2(gelu_tanh(y0), gelu_tanh(y1)); ow.y = pk2(gelu_tanh(y2), gelu_tanh(y3));
        *(u32x2*)((bf16*)(F.ws + WS_YS5) + (size_t)(b * SEQ + tok) * 1024 + g * 16 + kq * 4) = ow; }
#undef S5_BU
#undef S5_READ_BU
    LDS_BARRIER();
}

__device__ __forceinline__ void router_unit(Frame& F, KArgs& A, int l, int unit, const bool dry, const bf16* xres) {
    const int tid = F.tid, lane = F.lane, w = F.wave, tok0 = unit * 32, tg = w >> 2, kc = w & 3, n16 = lane & 15, kq = lane >> 4;
    LAS float* RED = (LAS float*)F.lds;
    LAS float* SSQ = (LAS float*)(F.lds + 5 * RTW_IMG * 2);
    LAS float* RS = SSQ + 128;
    const float* gn = A.in[3] + (size_t)l * D;
    const char* rimg = (const char*)(F.ws + WS_RTW) + (size_t)l * 16 * RTW_IMG * 2;
    f32x4 acc[3]; float ssq = 0.f;
#pragma unroll
    for (int nf = 0; nf < 3; ++nf) acc[nf] = (f32x4){0.f, 0.f, 0.f, 0.f};
    const bf16* xrow = xres + (size_t)(tok0 + tg * 16 + n16) * D + kc * 512 + 8 * kq;
    u32x4 xv[16];
#pragma unroll
    for (int s16 = 0; s16 < 16; ++s16) xv[s16] = *(const u32x4*)(xrow + 32 * s16);
#define RT_DMA(s_) do { const char* src_ = rimg + (size_t)(s_) * (RTW_IMG * 2) + lane * 16; LAS unsigned char* dst_ = F.lds + ((s_) % 5) * (RTW_IMG * 2); \
        _Pragma("unroll") for (int r_ = 0; r_ < 4; ++r_) { int pc_ = r_ * 8 + w; pc_ = pc_ < 30 ? pc_ : 29; \
            __builtin_amdgcn_global_load_lds((const unsigned*)(src_ + pc_ * 1024), (LAS unsigned*)(dst_ + pc_ * 1024), 16, 0, 0); } } while (0)
#define RT_DMA2(s_, b_) do { const char* src_ = rimg + (size_t)(s_) * (RTW_IMG * 2) + lane * 16; LAS unsigned char* dst_ = F.lds + (b_) * (RTW_IMG * 2); \
        _Pragma("unroll") for (int r_ = 0; r_ < 4; ++r_) { int pc_ = r_ * 8 + w; pc_ = pc_ < 30 ? pc_ : 29; \
            __builtin_amdgcn_global_load_lds((const unsigned*)(src_ + pc_ * 1024), (LAS unsigned*)(dst_ + pc_ * 1024), 16, 0, 0); } } while (0)
    RT_DMA(0); RT_DMA(1); RT_DMA(2); RT_DMA(3);
    int rb = 0;
#pragma unroll 1
    for (int so = 0; so < 4; ++so) {
#pragma unroll
        for (int sj = 0; sj < 4; ++sj) { const int s16 = 4 * so + sj;
            if (so < 3 || sj == 0) asm volatile("s_waitcnt vmcnt(12)" ::: "memory"); else if (sj == 1) asm volatile("s_waitcnt vmcnt(8)" ::: "memory");
            else if (sj == 2) asm volatile("s_waitcnt vmcnt(4)" ::: "memory"); else asm volatile("s_waitcnt vmcnt(0)" ::: "memory");
            __builtin_amdgcn_s_barrier(); asm volatile("" ::: "memory");
            if (so < 3) RT_DMA2(s16 + 4, rb == 0 ? 4 : rb - 1);
            const LAS bf16* WH = (const LAS bf16*)(F.lds + rb * (RTW_IMG * 2)); const LAS bf16* WL = WH + 4 * 48 * 40;
            rb = rb == 4 ? 0 : rb + 1;
            const u32x4 xw = xv[sj];
            { const float x0 = lo16(xw.x), x1 = hi16(xw.x), x2 = lo16(xw.y), x3 = hi16(xw.y), x4 = lo16(xw.z), x5 = hi16(xw.z), x6 = lo16(xw.w), x7 = hi16(xw.w);
              ssq += ((x0 * x0 + x1 * x1) + (x2 * x2 + x3 * x3)) + ((x4 * x4 + x5 * x5) + (x6 * x6 + x7 * x7)); }
            const bf16x8 xf = __builtin_bit_cast(bf16x8, xw);
#pragma unroll
            for (int nf = 0; nf < 3; ++nf) { const bf16x8 wh = *(const LAS bf16x8*)(WH + (kc * 48 + nf * 16 + n16) * 40 + 8 * kq), wl = *(const LAS bf16x8*)(WL + (kc * 48 + nf * 16 + n16) * 40 + 8 * kq);
                acc[nf] = __builtin_amdgcn_mfma_f32_16x16x32_bf16(wh, xf, acc[nf], 0, 0, 0); acc[nf] = __builtin_amdgcn_mfma_f32_16x16x32_bf16(wl, xf, acc[nf], 0, 0, 0); }
            asm volatile("s_waitcnt lgkmcnt(0)" ::: "memory");
        }
#pragma unroll
        for (int i = 0; i < 12; ++i) xv[i] = xv[i + 4];
    }
#undef RT_DMA2
#undef RT_DMA
    __syncthreads();
    ssq += shx(ssq, 16, tid & 63); ssq += shx(ssq, 32, tid & 63);
#pragma unroll
    for (int nf = 0; nf < 3; ++nf)
#pragma unroll
        for (int r = 0; r < 4; ++r) RED[((tg * 4 + kc) * 48 + nf * 16 + 4 * kq + r) * 16 + n16] = acc[nf][r];
    if (kq == 0) SSQ[(tg * 4 + kc) * 16 + n16] = ssq;
    __syncthreads();
    if (tid < 32) {
        const int tg2 = tid >> 4, tk = tid & 15, token = tok0 + tid;
        float lgt[36];
#pragma unroll
        for (int o = 0; o < 36; ++o) lgt[o] = (RED[((tg2 * 4 + 0) * 48 + o) * 16 + tk] + RED[((tg2 * 4 + 1) * 48 + o) * 16 + tk]) + (RED[((tg2 * 4 + 2) * 48 + o) * 16 + tk] + RED[((tg2 * 4 + 3) * 48 + o) * 16 + tk]);
        const float sq = (SSQ[(tg2 * 4 + 0) * 16 + tk] + SSQ[(tg2 * 4 + 1) * 16 + tk]) + (SSQ[(tg2 * 4 + 2) * 16 + tk] + SSQ[(tg2 * 4 + 3) * 16 + tk]);
        const float rs = rsqrtf(sq * (1.0f / D) + EPS); RS[tid] = rs;
        const float* brg = A.in[29] + l * 4; const float* bre = A.in[31] + l * 32;
        float lg[4];
#pragma unroll
        for (int j = 0; j < 4; ++j) lg[j] = lgt[j] * rs + brg[j];
        int gs = 0; float mx = lg[0];
#pragma unroll
        for (int j = 1; j < 4; ++j) if (lg[j] > mx) { mx = lg[j]; gs = j; }
        float sum = 0.f;
#pragma unroll
        for (int j = 0; j < 4; ++j) sum += expf(lg[j] - mx);
        const float gate_g = 1.0f / sum;
        float le[8];
#pragma unroll
        for (int j = 0; j < 8; ++j) { const float a = gs == 0 ? lgt[4 + j] : gs == 1 ? lgt[12 + j] : gs == 2 ? lgt[20 + j] : lgt[28 + j]; le[j] = a * rs + bre[gs * 8 + j]; }
        int i1 = 0; float m1 = le[0];
#pragma unroll
        for (int j = 1; j < 8; ++j) if (le[j] > m1) { m1 = le[j]; i1 = j; }
        int i2 = (i1 == 0) ? 1 : 0; float m2 = le[i2];
#pragma unroll
        for (int j = 0; j < 8; ++j) if (j != i1 && le[j] > m2) { m2 = le[j]; i2 = j; }
        const float e2 = expf(m2 - m1), w1 = 1.0f / (1.0f + e2), w2 = e2 / (1.0f + e2);
        float* comb = (float*)(F.ws + (dry ? WS_DS : WS_COMB)); int* list = (int*)(F.ws + (dry ? WS_DS + 4 * MiB : WS_LIST)); unsigned* cnt = dry ? (unsigned*)(F.ws + WS_DS + 8 * MiB) : (unsigned*)(F.ws + WS_CTL) + CW_CNT + l * 32 * 16;
        const int ea = gs * 8 + i1, eb = gs * 8 + i2;
        comb[token] = gate_g * w1; comb[T + token] = gate_g * w2;
        LAS unsigned* HIST = (LAS unsigned*)(RS + 32); LAS unsigned* BASE = HIST + 32;
        HIST[tid] = 0u; asm volatile("s_waitcnt lgkmcnt(0)" ::: "memory");
        const unsigned ra = atomicAdd((unsigned*)(HIST + ea), 1u), rb = atomicAdd((unsigned*)(HIST + eb), 1u);
        asm volatile("s_waitcnt lgkmcnt(0)" ::: "memory");
        { const unsigned n = HIST[tid]; BASE[tid] = n ? atomicAdd(cnt + tid * 16, n) : 0u; }
        asm volatile("s_waitcnt vmcnt(0) lgkmcnt(0)" ::: "memory");
        unsigned pa = BASE[ea] + ra, pb = BASE[eb] + rb;
        if (dry) { pa &= 8191u; pb &= 8191u; }
        list[ea * 8192 + pa] = token; list[eb * 8192 + pb] = T + token;
    }
    __syncthreads();
    { u32x4 raw[4][4];
#pragma unroll
        for (int rr = 0; rr < 4; ++rr)
#pragma unroll
            for (int j = 0; j < 4; ++j) raw[rr][j] = *(const u32x4*)(xres + (size_t)(tok0 + w * 4 + rr) * D + 8 * lane + 512 * j);
#pragma unroll
        for (int rr = 0; rr < 4; ++rr) { const int row = w * 4 + rr; const float rs = RS[row]; const size_t t = (size_t)(tok0 + row);
#pragma unroll
            for (int j = 0; j < 4; ++j) { const int col = 8 * lane + 512 * j; const u32x4 r4 = raw[rr][j];
                const f32x4 oa = up4((u32x2){r4.x, r4.y}) * rs * *(const f32x4*)(gn + col), ob = up4((u32x2){r4.z, r4.w}) * rs * *(const f32x4*)(gn + col + 4);
                const u32x2 wl = dn4(oa), wh = dn4(ob);
                *(u32x4*)((bf16*)(F.ws + (dry ? WS_DS + 16 * MiB : WS_XN)) + t * D + col) = (u32x4){wl.x, wl.y, wh.x, wh.y}; } } }
    __syncthreads();
}

__device__ __forceinline__ void moe_prepare(Frame& F, int l, int nct, pg8::MoeOrder& S) {
    LAS int* cntl = (LAS int*)(F.lds + EXTRA_OFF); LAS int* pre = cntl + 64; LAS int* ptab = cntl + 128;
    const unsigned* cnt = (const unsigned*)(F.ws + WS_CTL) + CW_CNT + l * 32 * 16; const int* list = (const int*)(F.ws + WS_LIST);
    if (F.tid < 32) { const unsigned c = __hip_atomic_load(cnt + F.tid * 16, __ATOMIC_RELAXED, __HIP_MEMORY_SCOPE_AGENT); cntl[F.tid] = (int)(c > 8192u ? 8192u : c); }
    __syncthreads();
    if (F.tid == 0) { int s = 0; for (int e = 0; e < 32; ++e) { pre[e] = s; s += (cntl[e] + 255) >> 8; } pre[32] = s; }
    __syncthreads();
    S.pre = pre; S.cnt = cntl; S.ptab = ptab; S.nct = nct; S.G = F.G; S.c = F.vcu;
    for (int ui = 0; ui < pg8::MOE_MAXU; ++ui) { int e, rt, ct;
        if (S.decode(ui, e, rt, ct) && F.tid < 256) { const int pos = rt * 256 + F.tid; ptab[ui * 256 + F.tid] = pos < cntl[e] ? list[e * 8192 + pos] : -1; } }
    __syncthreads();
}

__device__ __forceinline__ void moe_prepare2(Frame& F, int l, int nct, fg::Tables& tb, const bool merged) {
    LAS int* cntl = (LAS int*)(F.lds + EXTRA_OFF); LAS int* pre = cntl + 64; LAS int* utab = cntl + 100; LAS int* ptab = cntl + 128; LAS float* ctab = (LAS float*)(ptab + fg::MAXU * 256);
    const unsigned* cnt = (const unsigned*)(F.ws + WS_CTL) + CW_CNT + l * 32 * 16; const int* list = (const int*)(F.ws + WS_LIST); const float* comb = (const float*)(F.ws + WS_COMB);
    __syncthreads();
    if (F.tid < 32) { const unsigned c = __hip_atomic_load(cnt + F.tid * 16, __ATOMIC_RELAXED, __HIP_MEMORY_SCOPE_AGENT); cntl[F.tid] = (int)(c > 8192u ? 8192u : c); }
    __syncthreads();
    if (F.tid == 0) { int s = 0; for (int e = 0; e < 32; ++e) { pre[e] = s; s += ((cntl[e] + 255) >> 8) * nct; } pre[32] = s; }
    __syncthreads();
    tb.cnt = cntl; tb.preU = pre; tb.ptab = ptab; tb.utab = utab; tb.ctab = ctab;
    tb.flags = merged ? (unsigned*)(F.ws + WS_CTL) + CW_FLAG + l * 32 * 32 * 16 : nullptr;
    const int ucu = (F.G == 256) ? ((F.vcu & 7) * 32 + (F.vcu >> 3)) : F.vcu;
    tb.stride = F.G; tb.c0 = ucu;
    if (merged) { const int n2 = pre[32] >> 1; const int h = n2 > F.G ? (n2 - F.G < F.G / 2 ? n2 - F.G : F.G / 2) : 0; tb.stride = F.G - h; tb.c0 = ucu - h; }
    int nu = 0;
    for (int ui = 0; ui < fg::MAXU; ++ui) { int e, rt, ct;
        if (fg::decode(tb, ui, e, rt, ct)) { ++nu;
            if (F.tid < 256) { const int pos = rt * 256 + F.tid; const int pr = pos < cntl[e] ? list[e * 8192 + pos] : -1; ptab[ui * 256 + F.tid] = pr; ctab[ui * 256 + F.tid] = pr >= 0 ? comb[pr] : 0.f; }
            if (F.tid == 0) { utab[3 * ui] = e; utab[3 * ui + 1] = rt; utab[3 * ui + 2] = ct; } } }
    if (F.tid == 0) utab[3 * fg::MAXU] = nu;
    __syncthreads();
}

constexpr int PH_LAYER0 = 2, PH_PER_LAYER = 12, PH_FINAL = PH_LAYER0 + DEPTH * PH_PER_LAYER, PH_END = PH_FINAL + 1;

__global__ void __launch_bounds__(NTHR, 2) mk_fwd(Args args) {
    extern __shared__ __attribute__((aligned(16))) unsigned char lds_raw[];
    Frame F;
    F.lds = (LAS unsigned char*)lds_raw;
    F.tid = threadIdx.x; F.lane = F.tid & 63; F.wave = __builtin_amdgcn_readfirstlane(F.tid >> 6);
    F.G = gridDim.x; { const int bx = blockIdx.x; F.vcu = (F.G % 8 == 0) ? (bx % 8) * (F.G / 8) + bx / 8 : bx; }
    F.ws = args.ws;
    volatile LAS unsigned* MISC = (volatile LAS unsigned*)(F.lds + MISC_OFF);
    if (F.tid < 64) MISC[F.tid] = 0u;
    __syncthreads();
    const int lo = args.ph_lo, hi = args.ph_hi;
    const bool multi = (hi - lo) > 1;
    XcdBarrier bar; bar.bar = (unsigned*)(args.ws + WS_CTL) + CW_BAR; bar.x = 0; bar.st = MISC + 8;
    if (multi) bar = xcd_barrier_post((unsigned*)(args.ws + WS_CTL) + CW_BAR, MISC + 8);
#ifndef MK_REP_P0
#define MK_REP_P0 1
#endif
#ifndef MK_REP_EV
#define MK_REP_EV 1
#endif
#ifndef MK_REP_S5
#define MK_REP_S5 1
#endif
#ifndef MK_REP_MOE
#define MK_REP_MOE 1
#endif
#ifndef MK_MOE_DRY
#define MK_MOE_DRY 0
#endif
#ifndef MK_REP_RT
#define MK_REP_RT 1
#endif
#ifndef MK_REP_G
#define MK_REP_G 1
#endif
#ifndef MK_MASK
#define MK_MASK 0xffffffffu
#endif
#define ON(b) ((MK_MASK >> (b)) & 1u)
#define IN(k) (lo <= (k) && (k) < hi)
#define SEAM(k) do { if (multi && (k) + 1 < hi) xcd_barrier(bar, F.wave == 0 && lane_now() == 0); } while (0)
    LAS unsigned char* ring = F.lds;
#define PHASE_ENTER KArgs& args = *opaque_k((KArgs*)__builtin_amdgcn_kernarg_segment_ptr()); Frame P = F; P.vcu = opaque_s(F.vcu); P.G = opaque_s(F.G); const int PBX = opaque_s((int)blockIdx.x); (void)PBX; P.tid = opaque_v(F.wave * 64 + lane_now()); P.lane = P.tid & 63; P.wave = __builtin_amdgcn_readfirstlane(P.tid >> 6); P.ws = opaque_p(F.ws); unsigned char* ws = P.ws; (void)ws;

    if (ON(0) && IN(0)) { for (int rep = 0; rep < MK_REP_P0; ++rep) { PHASE_ENTER p0_prologue(P, args); SEAM(0); } }
    if (multi && lo == 0) {
        if (F.tid == 0) { unsigned base = 0; for (unsigned j = 0; j < 16; ++j) { const unsigned cj = xb_ld(&bar.bar[XB_XCNT(j)]); base += (j < bar.x) ? cj : 0u; } MISC[11] = base + MISC[10]; }
        __syncthreads();
        F.vcu = __builtin_amdgcn_readfirstlane((int)MISC[11]);
    }
    if (ON(1) && IN(1)) {
        PHASE_ENTER
        pg8::PPOrder S; S.init(T, D, 256, P.G, PBX, (size_t)T * 256 * 2, SZ_PLEP);
        pg8::EpiStoreBf16Split E{(bf16*)(ws + WS_PP), D, (size_t)T * D, nullptr};
        pg8::gemm_phase<pg8::EpiStoreBf16Split, pg8::PPOrder, false>(P.tid, ring, (const char*)(ws + WS_PB), (const char*)(ws + WS_PLEP), 256, S, E);
        SEAM(1);
    }
    for (int l = 0; l < DEPTH; ++l) {
        const int pb = PH_LAYER0 + l * PH_PER_LAYER, eo = l >> 1;
        const size_t xcur = WS_XRES + (size_t)(l & 1) * T * D * 2, xnxt = WS_XRES + (size_t)((l + 1) & 1) * T * D * 2;
        if (ON(2) && l > 0 && IN(pb + 0)) {
            PHASE_ENTER
            const int gw = P.vcu * NWAVES + P.wave, NGW = P.G * NWAVES;
            for (int m = gw; m < T; m += NGW) norm_row<true, false, false, 0>((const bf16*)(ws + xcur) + (size_t)m * D, nullptr, nullptr, nullptr, nullptr, nullptr, nullptr, (float*)(ws + WS_RS) + m, P.lane);
            SEAM(pb + 0);
        }
        if ((l & 1) == 0) {
            if (ON(3) && IN(pb + 1)) for (int rep = 0; rep < MK_REP_G; ++rep) {
                PHASE_ENTER
                pg8::StaticOrder S; S.init(T, ZW, D, P.G, PBX);
                pg8::EpiStoreBf16 E{(bf16*)(ws + WS_Z), ZW, (const float*)(ws + WS_RS)};
                pg8::gemm_phase<pg8::EpiStoreBf16, pg8::StaticOrder, false>(P.tid, ring, (const char*)(ws + xcur), (const char*)(ws + WS_WIN) + (size_t)eo * SZ_WIN, D, S, E);
                SEAM(pb + 1);
            }
            if (IN(pb + 2)) for (int rep = 0; rep < MK_REP_EV; ++rep) {
                if (ON(4)) { PHASE_ENTER for (int u = P.vcu; u < 256; u += P.G) lru_unit(P, args, eo, u); }
                if (ON(17)) { PHASE_ENTER for (int u = P.vcu; u < 512; u += P.G) gla_ds_unit(P, args, eo, u); }
                SEAM(pb + 2);
            }
            if (ON(5) && IN(pb + 3)) for (int rep = 0; rep < MK_REP_EV; ++rep) { PHASE_ENTER gla_state_phase(P); SEAM(pb + 3); }
            if (ON(6) && IN(pb + 4)) for (int rep = 0; rep < MK_REP_EV; ++rep) { PHASE_ENTER for (int u = P.vcu; u < 512; u += P.G) gla_out_unit(P, args, eo, u); SEAM(pb + 4); }
            if (ON(7) && IN(pb + 5)) {
                PHASE_ENTER
                pg8::StaticOrder S; S.init(T, D, D, P.G, PBX);
                pg8::EpiResid E{(bf16*)(ws + xcur)};
                pg8::gemm_phase<pg8::EpiResid, pg8::StaticOrder, false>(P.tid, ring, (const char*)(ws + WS_YCAT), (const char*)(ws + WS_WOUT) + (size_t)eo * SZ_DD, D, S, E);
                SEAM(pb + 5);
            }
        } else {
            if (ON(8) && IN(pb + 1)) for (int rep = 0; rep < MK_REP_G; ++rep) {
                PHASE_ENTER
                pg8::SplitK2Order S; S.init(T, 1024, D, P.G, PBX);
                pg8::EpiStoreBf16Split E{(bf16*)(ws + WS_U), 1024, (size_t)T * 1024, (const float*)(ws + WS_RS)};
                pg8::gemm_phase<pg8::EpiStoreBf16Split, pg8::SplitK2Order, false>(P.tid, ring, (const char*)(ws + xcur), (const char*)(ws + WS_ODWIN) + (size_t)eo * SZ_ODWIN, D, S, E, D / 128);
                SEAM(pb + 1);
            }
            if (ON(9) && IN(pb + 2)) for (int rep = 0; rep < MK_REP_S5; ++rep) { PHASE_ENTER for (int u = P.vcu; u < 256; u += P.G) s5_unit(P, args, eo, u); SEAM(pb + 2); }
            if (ON(10) && IN(pb + 3)) {
                PHASE_ENTER
                pg8::StaticOrder S; S.init(T, 4096, 1024, P.G, PBX);
                pg8::EpiGlu E{(bf16*)(ws + xcur)};
                pg8::gemm_phase<pg8::EpiGlu, pg8::StaticOrder, false>(P.tid, ring, (const char*)(ws + WS_YS5), (const char*)(ws + WS_WGLU) + (size_t)eo * SZ_WGLU, 1024, S, E);
                SEAM(pb + 3);
            }
        }
        if (ON(11) && IN(pb + 6)) for (int rep = 0; rep < MK_REP_RT; ++rep) { PHASE_ENTER for (int u = P.vcu; u < 256; u += P.G) router_unit(P, args, l, u, rep + 1 < MK_REP_RT, (const bf16*)(ws + xcur)); SEAM(pb + 6); }
        if (ON(12) && IN(pb + 7)) {
            PHASE_ENTER
            unsigned* flags = (unsigned*)(ws + WS_CTL) + CW_FLAG + l * 32 * 32 * 16;
            {
                fg::Tables tb; moe_prepare2(P, l, 4, tb, false);
                const int nu2 = __builtin_amdgcn_readfirstlane(tb.utab[3 * fg::MAXU]);
#pragma unroll 1
                for (int ui = 0; ui < nu2; ++ui) {
                    fg::fgemm_phase<0>(opaque_v(P.tid), ring, tb, (const char*)(ws + WS_XN), args.in[32] + (size_t)l * 32 * D * 512, args.in[33] + (size_t)l * 32 * D * 512, (bf16*)(ws + WS_H), ui, ui + 1);
                    if (P.tid == 0) { __builtin_amdgcn_fence(__ATOMIC_RELEASE, "agent"); asm volatile("s_waitcnt vmcnt(0)" ::: "memory");
                        __hip_atomic_fetch_add(flags + (tb.utab[3 * ui] * 32 + tb.utab[3 * ui + 1]) * 16, 1u, __ATOMIC_RELAXED, __HIP_MEMORY_SCOPE_AGENT); }
                }
            }
            {
                Frame Q = P; Q.tid = opaque_v(P.tid);
                fg::Tables tb; moe_prepare2(Q, l, 8, tb, true);
                const int nu3 = __builtin_amdgcn_readfirstlane(tb.utab[3 * fg::MAXU]);
                fg::fgemm_phase<1>(Q.tid, ring, tb, (const char*)(ws + WS_H), args.in[34] + (size_t)l * 32 * 512 * D, nullptr, (bf16*)(ws + WS_Y), 0, nu3);
            }
            SEAM(pb + 8);
        }
        if (ON(14) && IN(pb + 9)) {
            PHASE_ENTER
            const int gw = P.vcu * NWAVES + P.wave, NGW = P.G * NWAVES;
            for (int m = gw; m < T; m += NGW) { bf16* xr = (bf16*)(ws + xcur) + (size_t)m * D;
                norm_row<true, true, true, 0>(xr, (const bf16*)(ws + WS_Y) + (size_t)m * D, (const bf16*)(ws + WS_Y) + (size_t)(T + m) * D, xr, nullptr, nullptr, nullptr, (float*)(ws + WS_RS) + m, P.lane); }
            SEAM(pb + 9);
        }
        if (ON(15) && IN(pb + 10)) {
            PHASE_ENTER
            pg8::StaticOrder S; S.init(T, D, D, P.G, PBX);
            pg8::EpiPle E{(const bf16*)(ws + xcur), (bf16*)(ws + xnxt), (const bf16*)(ws + WS_PP) + (size_t)l * T * D, args.in[36] + (size_t)l * D, (const float*)(ws + WS_RS)};
            pg8::gemm_phase<pg8::EpiPle, pg8::StaticOrder, false>(P.tid, ring, (const char*)(ws + xcur), (const char*)(ws + WS_PLEG) + (size_t)l * SZ_DD, D, S, E);
            SEAM(pb + 10);
        }
    }
    if (ON(16) && IN(PH_FINAL)) {
        PHASE_ENTER
        const int gw = P.vcu * NWAVES + P.wave, NGW = P.G * NWAVES;
        for (int m = gw; m < T; m += NGW) norm_row<true, false, false, 2>((const bf16*)(ws + WS_XRES + (size_t)(DEPTH & 1) * T * D * 2) + (size_t)m * D, nullptr, nullptr, nullptr, args.in[5], nullptr, args.out + (size_t)m * D, nullptr, P.lane);
    }
#undef IN
#undef ON
#undef SEAM
#undef PHASE_ENTER
}

static bool phase_exists(int k) {
    if (k < PH_LAYER0 || k >= PH_FINAL) return true;
    const int l = (k - PH_LAYER0) / PH_PER_LAYER, r = (k - PH_LAYER0) % PH_PER_LAYER;
    if (r == 0) return l > 0;
    if (r == 11) return false;
    if (l & 1) return !(r == 4 || r == 5);
    return true;
}
extern "C" void kernel_launch(void* const* d_in, const int* in_sizes, int n_in, void* d_out, int out_size, void* d_ws, size_t ws_size, hipStream_t stream) {
    static int grid = 0;
    if (grid == 0) {
        if (n_in != 38 || out_size != T * D || ws_size < WS_END) { fprintf(stderr, "kernel_launch: unexpected problem (n_in %d, out %d, ws %zu < %zu)\n", n_in, out_size, ws_size, (size_t)WS_END); grid = -1; return; }
        int dev = 0, cus = 0, per_cu = 0;
        if (hipGetDevice(&dev) != hipSuccess || hipDeviceGetAttribute(&cus, hipDeviceAttributeMultiprocessorCount, dev) != hipSuccess) { grid = -1; return; }
        if (hipFuncSetAttribute((const void*)mk_fwd, hipFuncAttributeMaxDynamicSharedMemorySize, LDS_BYTES) != hipSuccess) { fprintf(stderr, "kernel_launch: hipFuncSetAttribute failed\n"); grid = -1; return; }
        if (hipOccupancyMaxActiveBlocksPerMultiprocessor(&per_cu, (const void*)mk_fwd, NTHR, LDS_BYTES) != hipSuccess || per_cu < 1) fprintf(stderr, "kernel_launch: occupancy query says %d\n", per_cu);
        (void)hipGetLastError();
        grid = cus;
    }
    if (grid < 0) return;
    (void)hipMemsetAsync((char*)d_ws + WS_CTL, 0, CTL_BYTES, stream);
    Args a{};
    for (int i = 0; i < 38; ++i) a.in[i] = (const float*)d_in[i];
    a.out = (float*)d_out; a.ws = (unsigned char*)d_ws;
#if MK_PER_PHASE
    for (int k = 0; k < PH_END; ++k) { if (!phase_exists(k)) continue; a.ph_lo = k; a.ph_hi = k + 1; hipLaunchKernelGGL(mk_fwd, dim3(grid), dim3(NTHR), LDS_BYTES, stream, a); }
#else
    (void)phase_exists;
    a.ph_lo = 0; a.ph_hi = PH_END;
    hipLaunchKernelGGL(mk_fwd, dim3(grid), dim3(NTHR), LDS_BYTES, stream, a);
#endif
    const hipError_t le = hipPeekAtLastError();
    if (le != hipSuccess) fprintf(stderr, "kernel_launch: launch failed: %s\n", hipGetErrorName(le));
}
```

```cpp
#include <hip/hip_runtime.h>
#include <cstdio>
#include <cstdint>

#ifndef MK_PER_PHASE
#define MK_PER_PHASE 0
#endif

#define GAS __attribute__((address_space(1)))
#define LAS __attribute__((address_space(3)))
typedef unsigned short bf16;
typedef short bf16x8 __attribute__((ext_vector_type(8)));
typedef float f32x4 __attribute__((ext_vector_type(4)));
typedef float f32x2 __attribute__((ext_vector_type(2)));
typedef unsigned u32x4 __attribute__((ext_vector_type(4)));
typedef unsigned u32x2 __attribute__((ext_vector_type(2)));

constexpr int T = 8192, D = 2048, SEQ = 2048, NB = 4, DEPTH = 4;
constexpr int ZW = 5632;
constexpr int EV_IN = 5136;
constexpr float EPS = 1e-6f;
constexpr int NWAVES = 8, NTHR = 512;

constexpr size_t MiB = 1u << 20;
constexpr size_t WS_CTL = 0, CTL_BYTES = 1 * MiB;
constexpr size_t WS_WIN = 1 * MiB;
constexpr size_t SZ_WIN = (size_t)ZW * D * 2;
constexpr size_t WS_WOUT = WS_WIN + 2 * SZ_WIN;
constexpr size_t SZ_DD = (size_t)D * D * 2;
constexpr size_t WS_ODWIN = WS_WOUT + 2 * SZ_DD;
constexpr size_t SZ_ODWIN = (size_t)1024 * D * 2;
constexpr size_t WS_WGLU = WS_ODWIN + 2 * SZ_ODWIN;
constexpr size_t SZ_WGLU = (size_t)4096 * 1024 * 2;
constexpr size_t WS_PLEG = WS_WGLU + 2 * SZ_WGLU;
constexpr size_t WS_PLEP = WS_PLEG + 4 * SZ_DD;
constexpr size_t SZ_PLEP = (size_t)D * 256 * 2;
constexpr size_t WS_W13 = WS_PLEP + 4 * SZ_PLEP;
constexpr size_t WS_RTW = WS_W13;
constexpr int RTW_IMG = 2 * 4 * 48 * 40;
constexpr size_t SZ_W13 = (size_t)1024 * D * 2;
constexpr size_t WS_W2 = WS_W13 + 128 * SZ_W13;
constexpr size_t SZ_W2 = (size_t)D * 512 * 2;
constexpr size_t WS_XRES = WS_W2 + 128 * SZ_W2;
constexpr size_t WS_XN = WS_XRES + (size_t)T * D * 4;
constexpr size_t WS_Z = WS_XN + (size_t)T * D * 2;
constexpr size_t WS_YCAT = WS_Z + (size_t)T * ZW * 2;
constexpr size_t WS_DS = WS_YCAT + (size_t)T * D * 2;
constexpr size_t SZ_DS = (size_t)16 * 32 * 128 * 256 * 4;
constexpr size_t WS_SPREV = WS_DS + SZ_DS;
constexpr size_t WS_DECAY = WS_SPREV + SZ_DS;
constexpr size_t WS_U = WS_DECAY + (size_t)16 * 32 * 128 * 4;
constexpr size_t WS_YS5 = WS_U + (size_t)2 * T * 1024 * 2;
constexpr size_t WS_PB = WS_YS5 + (size_t)T * 1024 * 2;
constexpr size_t WS_PP = WS_PB + (size_t)4 * T * 256 * 2;
constexpr size_t WS_H = WS_PP + (size_t)4 * T * D * 2;
constexpr size_t WS_Y = WS_H + (size_t)2 * T * 512 * 2;
constexpr size_t WS_LIST = WS_Y + (size_t)2 * T * D * 2;
constexpr size_t WS_COMB = WS_LIST + (size_t)32 * 8192 * 4;
constexpr size_t WS_RS = WS_COMB + (size_t)2 * T * 4;
constexpr size_t WS_END = WS_RS + (size_t)T * 4;
constexpr int CW_BAR = 4096;
constexpr int CW_FLAG = 32768;
constexpr int CW_CNT = 16384;

constexpr int LDS_BYTES = 163840;
constexpr int EXTRA_OFF = 147456;
constexpr int MISC_OFF = LDS_BYTES - 256;

__device__ __forceinline__ float bf2f(unsigned b) { return __uint_as_float(b << 16); }
__device__ __forceinline__ unsigned f2bf(float f) { unsigned u = __float_as_uint(f); return (u + 0x7fffu + ((u >> 16) & 1u)) >> 16; }
typedef __bf16 bf16x2_t __attribute__((ext_vector_type(2)));
__device__ __forceinline__ unsigned pk2(float lo, float hi) { const bf16x2_t r = __builtin_convertvector((f32x2){lo, hi}, bf16x2_t); return __builtin_bit_cast(unsigned, r); }
__device__ __forceinline__ float lo16(unsigned w) { return __uint_as_float(w << 16); }
__device__ __forceinline__ float hi16(unsigned w) { return __uint_as_float(w & 0xffff0000u); }
__device__ __forceinline__ f32x4 up4(u32x2 w) { return (f32x4){lo16(w.x), hi16(w.x), lo16(w.y), hi16(w.y)}; }
__device__ __forceinline__ u32x2 dn4(f32x4 v) { u32x2 w; w.x = pk2(v[0], v[1]); w.y = pk2(v[2], v[3]); return w; }
__device__ __forceinline__ float sigmoidf_(float x) { return __builtin_amdgcn_rcpf(1.0f + __expf(-x)); }
__device__ __forceinline__ float one_minus_exp(float t) { const float ser = -t * (1.0f + 0.5f * t * (1.0f + (1.0f / 3.0f) * t * (1.0f + 0.25f * t))); return t > -0.03125f ? ser : 1.0f - __expf(t); }
__device__ __forceinline__ float siluf_(float x) { return x * sigmoidf_(x); }
__device__ __forceinline__ float gelu_tanh(float x) { return x * sigmoidf_(1.5957691216f * (x + 0.044715f * x * x * x)); }
__device__ __forceinline__ float softplusf_(float x) { return fmaxf(x, 0.f) + log1pf(__expf(-fabsf(x))); }
__device__ __forceinline__ float logsigmoidf_(float x) { return fminf(x, 0.f) - __logf(1.0f + __expf(-fabsf(x))); }
__device__ __forceinline__ float dpp_f(float v, const int ctrl_sel) {
    const int i = __builtin_bit_cast(int, v);
    int r;
    if (ctrl_sel == 0) r = __builtin_amdgcn_update_dpp(0, i, 0xB1, 0xF, 0xF, false);
    else if (ctrl_sel == 1) r = __builtin_amdgcn_update_dpp(0, i, 0x4E, 0xF, 0xF, false);
    else if (ctrl_sel == 2) r = __builtin_amdgcn_update_dpp(0, i, 0x141, 0xF, 0xF, false);
    else r = __builtin_amdgcn_update_dpp(0, i, 0x140, 0xF, 0xF, false);
    return __builtin_bit_cast(float, r);
}
__device__ __forceinline__ float shx(float v, int mask, int lane) { return __builtin_bit_cast(float, __builtin_amdgcn_ds_bpermute((lane ^ mask) << 2, __builtin_bit_cast(int, v))); }
__device__ __forceinline__ float wave_sum(float v) {
    v += dpp_f(v, 0); v += dpp_f(v, 1); v += dpp_f(v, 2); v += dpp_f(v, 3);
    const int i = __builtin_bit_cast(int, v);
    const float r0 = __builtin_bit_cast(float, __builtin_amdgcn_readlane(i, 0)), r1 = __builtin_bit_cast(float, __builtin_amdgcn_readlane(i, 16));
    const float r2 = __builtin_bit_cast(float, __builtin_amdgcn_readlane(i, 32)), r3 = __builtin_bit_cast(float, __builtin_amdgcn_readlane(i, 48));
    return (r0 + r1) + (r2 + r3);
}
#define LDS_WAIT() asm volatile("s_waitcnt lgkmcnt(0)" ::: "memory")
#define LDS_BARRIER() do { asm volatile("s_waitcnt lgkmcnt(0)" ::: "memory"); __builtin_amdgcn_s_barrier(); asm volatile("" ::: "memory"); } while (0)
__device__ __forceinline__ int opaque_v(int v) { asm volatile("" : "+v"(v)); return v; }
__device__ __forceinline__ int lane_now() { int z = 0; asm volatile("" : "+s"(z)); return (int)__builtin_amdgcn_mbcnt_hi(~0u, __builtin_amdgcn_mbcnt_lo(~0u, (unsigned)z)); }
__device__ __forceinline__ int opaque_s(int v) { v = __builtin_amdgcn_readfirstlane(v); asm volatile("" : "+s"(v)); return v; }
__device__ __forceinline__ unsigned char* opaque_p(unsigned char* p) { __attribute__((address_space(1))) unsigned char* g = (__attribute__((address_space(1))) unsigned char*)p; asm volatile("" : "+s"(g)); return (unsigned char*)g; }

#define XB_TMO      128
#define XB_XCNT(j)  (256  + 64 * (j))
#define XB_XSUB(j)  (1280 + 64 * (j))
#define XB_XGEN(j)  (2304 + 64 * (j))
#define XB_TOP      3328
#define XB_TOPGEN   3392
#define XCD_BAR_WORDS 3456
#define XB_SPIN_CAP (1u << 18)
__device__ __forceinline__ unsigned xb_ld(unsigned* p)              { return __hip_atomic_load(p, __ATOMIC_RELAXED, __HIP_MEMORY_SCOPE_AGENT); }
__device__ __forceinline__ unsigned xb_add(unsigned* p, unsigned v) { return __hip_atomic_fetch_add(p, v, __ATOMIC_RELAXED, __HIP_MEMORY_SCOPE_AGENT); }
__device__ __forceinline__ unsigned xb_xcc_id() { return (unsigned)__builtin_amdgcn_s_getreg((3 << 11) | 20) & 0xFu; }
#define XB_SPIN(cond, bar) do { unsigned _sp = 0; while (cond) { __builtin_amdgcn_s_sleep(1); \
    if ((++_sp & 255u) == 0u) { if (xb_ld(&(bar)[XB_TMO])) break; if (_sp > XB_SPIN_CAP) { atomicAdd(&(bar)[XB_TMO], 1u); break; } } } } while (0)
struct XcdBarrier { unsigned* bar; unsigned x; volatile LAS unsigned* st; };
__device__ __forceinline__ XcdBarrier xcd_barrier_post(unsigned* bar, volatile LAS unsigned* st) {
    XcdBarrier b; b.bar = bar; b.x = xb_xcc_id(); b.st = st;
    if (threadIdx.x == 0) st[2] = xb_add(&bar[XB_XCNT(b.x)], 1u);
    return b;
}
__device__ __forceinline__ unsigned long long xcd_barrier_complete(unsigned* bar, unsigned x) {
    const unsigned G = gridDim.x * gridDim.y * gridDim.z;
    unsigned sum, cnt, mine, sp = 0u;
    for (;;) {
        sum = 0u; cnt = 0u; mine = 0u;
#pragma unroll 1
        for (unsigned j = 0; j < 16; ++j) { const unsigned c = xb_ld(&bar[XB_XCNT(j)]); sum += c; cnt += (c > 0u) ? 1u : 0u; mine = (j == x) ? c : mine; }
        if (sum == G) break;
        __builtin_amdgcn_s_sleep(1);
        if ((++sp & 255u) == 0u) { if (xb_ld(&bar[XB_TMO])) break; if (sp > XB_SPIN_CAP) { atomicAdd(&bar[XB_TMO], 1u); break; } }
    }
    const unsigned nloc = mine > 0u ? mine : 1u, nx = cnt > 0u ? cnt : 1u;
    return ((unsigned long long)nx << 32) | nloc;
}
__device__ __forceinline__ void xcd_barrier_leader(unsigned* bar, unsigned x, volatile LAS unsigned* st) {
    __builtin_amdgcn_s_waitcnt(0);
    unsigned nloc = st[0], nx = st[1];
    if (nloc == 0u) { const unsigned long long r = xcd_barrier_complete(bar, x); nloc = (unsigned)r; nx = (unsigned)(r >> 32); st[0] = nloc; st[1] = nx; }
    const unsigned old = xb_add(&bar[XB_XSUB(x)], 1u);
    const unsigned gen = old / nloc;
    if (old + 1u == (gen + 1u) * nloc) {
        __builtin_amdgcn_fence(__ATOMIC_RELEASE, "agent");
        asm volatile("s_waitcnt vmcnt(0)" ::: "memory");
        const unsigned og = xb_add(&bar[XB_TOP], 1u);
        const unsigned tg = og / nx;
        if (og + 1u == (tg + 1u) * nx) xb_add(&bar[XB_TOPGEN], 1u);
        else XB_SPIN(xb_ld(&bar[XB_TOPGEN]) == tg, bar);
        __builtin_amdgcn_fence(__ATOMIC_ACQUIRE, "agent");
        xb_add(&bar[XB_XGEN(x)], 1u);
        asm volatile("s_waitcnt vmcnt(0)" ::: "memory");
    } else {
        XB_SPIN(xb_ld(&bar[XB_XGEN(x)]) == gen, bar);
        __builtin_amdgcn_fence(__ATOMIC_ACQUIRE, "agent");
        asm volatile("s_waitcnt vmcnt(0)" ::: "memory");
    }
}
__device__ __forceinline__ void xcd_barrier(const XcdBarrier& b, const bool leader) {
    asm volatile("s_waitcnt vmcnt(0)" ::: "memory");
    __syncthreads();
    if (leader) xcd_barrier_leader(b.bar, b.x, b.st);
    __syncthreads();
}

struct Args { const float* in[38]; float* out; unsigned char* ws; int ph_lo, ph_hi; };
typedef const Args __attribute__((address_space(4))) KArgs;
__device__ __forceinline__ KArgs* opaque_k(KArgs* p) { asm volatile("" : "+s"(p)); return p; }
struct Frame {
    LAS unsigned char* lds;
    int tid, lane, wave, vcu, G;
    unsigned char* ws;
};

namespace pg8 {
constexpr int BM = 256, BK = 64, HALF = 128, HTB = HALF * BK * 2, STAGE_BYTES = 8 * HTB, NXCD = 8, WGM = 8;
__device__ __forceinline__ int lds_byte(int r, int c) { const int st = (r >> 4) * 2 + (c >> 5), rr = r & 15, cc = c & 31, ob = rr * 64 + cc * 2; return st * 1024 + (ob ^ (((ob >> 9) & 1) << 5)); }
__device__ __forceinline__ void stage_rc(int b, int& R, int& C) { const int st = b / 1024, sb = b % 1024, swz = sb ^ (((sb >> 9) & 1) << 5); R = (st >> 1) * 16 + swz / 64; C = (st & 1) * 32 + (swz % 64) / 2; }

struct Unit { int pm, pn; size_t a_off, b_off; int ui, e, nrows; };

struct StaticOrder {
    int nM, nN, nwg, G, c, K;
    __device__ void init(int M, int N, int K_, int G_, int c_) { nM = M / BM; nN = N / BM; nwg = nM * nN; G = G_; c = c_; K = K_; }
    __device__ __forceinline__ bool next(int i, Unit& u) const {
        const long L = (long)i * G + c; if (L >= nwg) return false;
        int wgid = (int)L; { const int q = nwg / NXCD, r = nwg % NXCD, xcd = wgid % NXCD, off = wgid / NXCD; wgid = (xcd < r ? xcd * (q + 1) : r * (q + 1) + (xcd - r) * q) + off; }
        const int nig = WGM * nN, gid = wgid / nig, fm = gid * WGM, gsz = (nM - fm) < WGM ? (nM - fm) : WGM;
        u.pm = fm + ((wgid % nig) % gsz); u.pn = (wgid % nig) / gsz;
        u.a_off = (size_t)u.pm * BM * K * 2; u.b_off = (size_t)u.pn * BM * K * 2; u.ui = i; u.e = 0; u.nrows = BM;
        return true;
    }
    __device__ __forceinline__ unsigned row_off(const Unit&, int) const { return 0u; }
};

struct SplitK2Order {
    StaticOrder base;
    __device__ void init(int M, int N, int K_, int G_, int c_) { base.init(M, N, K_, G_, c_); }
    __device__ __forceinline__ bool next(int i, Unit& u) const {
        const long L = (long)i * base.G + base.c; if (L >= 2 * base.nwg) return false;
        StaticOrder b2 = base; b2.G = 1; b2.c = 0;
        const int kh = (int)(L & 1); if (!b2.next((int)(L >> 1), u)) return false;
        u.a_off += (size_t)kh * base.K; u.b_off += (size_t)kh * base.K; u.ui = i; u.e = kh; return true;
    }
    __device__ __forceinline__ unsigned row_off(const Unit&, int) const { return 0u; }
};
struct PPOrder {
    StaticOrder base; size_t a_layer, b_layer;
    __device__ void init(int M, int N, int K_, int G_, int c_, size_t a_layer_, size_t b_layer_) { base.init(M, N, K_, G_, c_); a_layer = a_layer_; b_layer = b_layer_; }
    __device__ __forceinline__ bool next(int i, Unit& u) const {
        const long L = (long)i * base.G + base.c; if (L >= 4L * base.nwg) return false;
        const int ll = (int)(L / base.nwg); StaticOrder b2 = base; b2.G = 1; b2.c = 0;
        if (!b2.next((int)(L - (long)ll * base.nwg), u)) return false;
        u.a_off += (size_t)ll * a_layer; u.b_off += (size_t)ll * b_layer; u.ui = i; u.e = ll; return true;
    }
    __device__ __forceinline__ unsigned row_off(const Unit&, int) const { return 0u; }
};
constexpr int MOE_MAXU = 4;
struct MoeOrder {
    const LAS int* pre;
    const LAS int* cnt;
    const LAS int* ptab;
    int nct, G, c, K, brows;
    unsigned rshift_mask;
    unsigned rbytes;
    __device__ __forceinline__ bool decode(int i, int& e, int& rt, int& ct) const {
        if (i >= MOE_MAXU) return false;
        const int L = i * G + c, total = pre[32] * nct; if (L >= total) return false;
        const int rtg = L / nct; ct = L - rtg * nct; e = 0;
        for (int j = 1; j < 32; ++j) e = (pre[j] <= rtg) ? j : e;
        rt = rtg - pre[e]; return true;
    }
    __device__ __forceinline__ bool next(int i, Unit& u) const {
        int e, rt, ct; if (!decode(i, e, rt, ct)) return false;
        u.pm = rt; u.pn = ct; u.a_off = 0; u.b_off = ((size_t)e * brows + (size_t)ct * BM) * K * 2; u.ui = i; u.e = e;
        const int left = cnt[e] - rt * BM; u.nrows = left < BM ? left : BM; return true;
    }
    __device__ __forceinline__ unsigned row_off(const Unit& u, int r) const { const int p = ptab[u.ui * 256 + r]; return p < 0 ? 0u : ((unsigned)p & rshift_mask) * rbytes; }
};

template <class Epi, class Sched, bool GATHER>
__device__ __forceinline__ void gemm_phase(const int tid, LAS unsigned char* lds, const char* Abase, const char* Bbase, const int K, const Sched& S, const Epi& E, const int ntl = 0) {
    const int wid = __builtin_amdgcn_readfirstlane(tid >> 6), lane = tid & 63, wr = wid >> 2, wc = wid & 3, fr = lane & 15, fq = lane >> 4;
    const int nt = ntl ? ntl : K / BK;
    unsigned voff[2]; int RR[2]; unsigned CC2[2];
#pragma unroll
    for (int i = 0; i < 2; ++i) { int R, C; stage_rc(tid * 16 + i * 8192, R, C); voff[i] = (unsigned)(R * K + C) * 2u; RR[i] = R; CC2[i] = (unsigned)C * 2u; }
    const size_t kstep = (size_t)(BK * 2);
    const size_t hstep = (size_t)HALF * K * 2;
    const unsigned ldsw = (unsigned)wid * 1024u;
    const int aoff = lds_byte(wr * 64 + fr, fq * 8), boff = lds_byte(wc * 32 + fr, fq * 8);
#define PG8_SA(b, h) (((b) * 2 + (h)) * HTB)
#define PG8_SB(b, h) ((4 + (b) * 2 + (h)) * HTB)
#define PG8_STAGE_B(bufoff, gbase) do { _Pragma("unroll") for (int _i = 0; _i < 2; ++_i) \
        __builtin_amdgcn_global_load_lds((const unsigned*)((const char*)(gbase) + voff[_i]), (LAS unsigned*)(lds + (bufoff) + ldsw + _i * 8192), 16, 0, 0); } while (0)
#define PG8_STAGE_A(bufoff, gbase, ro, kb) do { _Pragma("unroll") for (int _i = 0; _i < 2; ++_i) { \
        if constexpr (GATHER) __builtin_amdgcn_global_load_lds((const unsigned*)(Abase + ((ro)[_i] + (unsigned)(kb))), (LAS unsigned*)(lds + (bufoff) + ldsw + _i * 8192), 16, 0, 0); \
        else __builtin_amdgcn_global_load_lds((const unsigned*)((const char*)(gbase) + voff[_i]), (LAS unsigned*)(lds + (bufoff) + ldsw + _i * 8192), 16, 0, 0); } } while (0)
#define PG8_LDA(dst, b, h) do { _Pragma("unroll") for (int m = 0; m < 4; ++m) _Pragma("unroll") for (int k = 0; k < 2; ++k) dst[m][k] = *(const LAS bf16x8*)(lds + PG8_SA(b, h) + aoff + m * 2048 + k * 1024); } while (0)
#define PG8_LDB(dst, b, h) do { _Pragma("unroll") for (int n = 0; n < 2; ++n) _Pragma("unroll") for (int k = 0; k < 2; ++k) dst[n][k] = *(const LAS bf16x8*)(lds + PG8_SB(b, h) + boff + n * 2048 + k * 1024); } while (0)
#define PG8_MMA(ai, bj, At, Bt) do { __builtin_amdgcn_s_setprio(1); _Pragma("unroll") for (int m = 0; m < 4; ++m) _Pragma("unroll") for (int n = 0; n < 2; ++n) _Pragma("unroll") for (int k = 0; k < 2; ++k) \
        acc[ai][bj][m][n] = __builtin_amdgcn_mfma_f32_16x16x32_bf16(Bt[n][k], At[m][k], acc[ai][bj][m][n], 0, 0, 0); __builtin_amdgcn_s_setprio(0); } while (0)
#define PG8_WAIT_V(n) asm volatile("s_waitcnt vmcnt(" #n ")" ::: "memory")
#define PG8_WAIT_L(n) asm volatile("s_waitcnt lgkmcnt(" #n ")" ::: "memory")
#define PG8_BAR __builtin_amdgcn_s_barrier()
#define PG8_SCHED __builtin_amdgcn_sched_barrier(0)
    Unit cur, nxt; int ui = 0;
    if (!S.next(0, cur)) return;
    f32x4 acc[2][2][4][2];
#pragma unroll
    for (int a = 0; a < 2; ++a)
#pragma unroll
        for (int b = 0; b < 2; ++b)
#pragma unroll
            for (int m = 0; m < 4; ++m)
#pragma unroll
                for (int n = 0; n < 2; ++n) acc[a][b][m][n] = (f32x4){0.f, 0.f, 0.f, 0.f};
    bf16x8 At[4][2], B0[2][2], B1[2][2];
    const char* cA = Abase + cur.a_off; const char* cB = Bbase + cur.b_off;
    unsigned cro0[2] = {0u, 0u}, cro1[2] = {0u, 0u}, nro0[2] = {0u, 0u}, nro1[2] = {0u, 0u};
    if constexpr (GATHER) {
#pragma unroll
        for (int i = 0; i < 2; ++i) { cro0[i] = S.row_off(cur, RR[i]) + CC2[i]; cro1[i] = S.row_off(cur, 128 + RR[i]) + CC2[i]; }
    }
    PG8_STAGE_B(PG8_SB(0, 0), cB); PG8_STAGE_A(PG8_SA(0, 0), cA, cro0, 0); PG8_STAGE_B(PG8_SB(0, 1), cB + hstep); PG8_STAGE_A(PG8_SA(0, 1), cA + hstep, cro1, 0);
    if (wr == 1) PG8_BAR;
    PG8_WAIT_V(4); PG8_BAR;
    PG8_STAGE_B(PG8_SB(1, 0), cB + kstep); PG8_STAGE_A(PG8_SA(1, 0), cA + kstep, cro0, kstep); PG8_STAGE_B(PG8_SB(1, 1), cB + hstep + kstep);
    PG8_WAIT_V(6); PG8_BAR;
    for (;;) {
        const bool has_next = S.next(ui + 1, nxt);
        const char* nA = has_next ? Abase + nxt.a_off : cA; const char* nB = has_next ? Bbase + nxt.b_off : cB;
        if constexpr (GATHER) {
#pragma unroll
            for (int i = 0; i < 2; ++i) { nro0[i] = has_next ? S.row_off(nxt, RR[i]) + CC2[i] : cro0[i]; nro1[i] = has_next ? S.row_off(nxt, 128 + RR[i]) + CC2[i] : cro1[i]; }
        }
        for (int t = 0; t < nt; t += 2) {
            const bool last = (t == nt - 2);
            const char* a1 = cA + (size_t)(t + 1) * kstep;
            const char* a2 = last ? nA : cA + (size_t)(t + 2) * kstep; const char* b2 = last ? nB : cB + (size_t)(t + 2) * kstep;
            const char* a3 = a2 + kstep; const char* b3 = b2 + kstep;
            unsigned r20[2], r21[2]; unsigned k1 = 0, k2 = 0, k3 = 0;
            if constexpr (GATHER) {
#pragma unroll
                for (int i = 0; i < 2; ++i) { r20[i] = last ? nro0[i] : cro0[i]; r21[i] = last ? nro1[i] : cro1[i]; }
                k1 = (unsigned)(t + 1) * 128u; k2 = last ? 0u : (unsigned)(t + 2) * 128u; k3 = k2 + 128u;
            } else { r20[0] = r20[1] = r21[0] = r21[1] = 0u; }
            PG8_LDB(B0, 0, 0); PG8_SCHED; PG8_LDA(At, 0, 0); PG8_STAGE_A(PG8_SA(1, 1), a1 + hstep, cro1, k1);
            PG8_WAIT_L(8); PG8_BAR; PG8_WAIT_L(0); PG8_MMA(0, 0, At, B0); PG8_BAR; PG8_SCHED;
            PG8_LDB(B1, 0, 1); PG8_STAGE_B(PG8_SB(0, 0), b2);
            PG8_BAR; PG8_WAIT_L(0); PG8_MMA(0, 1, At, B1); PG8_BAR;
            PG8_LDA(At, 0, 1); PG8_STAGE_A(PG8_SA(0, 0), a2, r20, k2);
            PG8_BAR; PG8_WAIT_L(0); PG8_MMA(1, 0, At, B0); PG8_BAR; PG8_SCHED;
            PG8_STAGE_B(PG8_SB(0, 1), b2 + hstep);
            PG8_WAIT_V(6); PG8_BAR; PG8_MMA(1, 1, At, B1); PG8_BAR;
            PG8_LDB(B0, 1, 0); PG8_SCHED; PG8_LDA(At, 1, 0); PG8_STAGE_A(PG8_SA(0, 1), a2 + hstep, r21, k2);
            PG8_WAIT_L(8); PG8_BAR; PG8_WAIT_L(0); PG8_MMA(0, 0, At, B0); PG8_BAR; PG8_SCHED;
            PG8_LDB(B1, 1, 1); PG8_STAGE_B(PG8_SB(1, 0), b3);
            PG8_BAR; PG8_WAIT_L(0); PG8_MMA(0, 1, At, B1); PG8_BAR;
            PG8_LDA(At, 1, 1); PG8_STAGE_A(PG8_SA(1, 0), a3, r20, k3);
            PG8_BAR; PG8_WAIT_L(0); PG8_MMA(1, 0, At, B0); PG8_BAR; PG8_SCHED;
            PG8_STAGE_B(PG8_SB(1, 1), b3 + hstep);
            PG8_WAIT_V(6); PG8_BAR; PG8_MMA(1, 1, At, B1); PG8_BAR;
        }
        E(acc, cur, wr, wc, fr, fq);
        if (!has_next) break;
#pragma unroll
        for (int a = 0; a < 2; ++a)
#pragma unroll
            for (int b = 0; b < 2; ++b)
#pragma unroll
                for (int m = 0; m < 4; ++m)
#pragma unroll
                    for (int n = 0; n < 2; ++n) acc[a][b][m][n] = (f32x4){0.f, 0.f, 0.f, 0.f};
        cur = nxt; cA = nA; cB = nB; ++ui;
        if constexpr (GATHER) {
#pragma unroll
            for (int i = 0; i < 2; ++i) { cro0[i] = nro0[i]; cro1[i] = nro1[i]; }
        }
    }
    PG8_WAIT_V(0);
    if (wr == 0) PG8_BAR;
    PG8_BAR;
#undef PG8_SA
#undef PG8_SB
#undef PG8_STAGE_A
#undef PG8_STAGE_B
#undef PG8_LDA
#undef PG8_LDB
#undef PG8_MMA
#undef PG8_WAIT_V
#undef PG8_WAIT_L
#undef PG8_BAR
#undef PG8_SCHED
}

#define EPI_ROWS_BEGIN _Pragma("unroll") for (int ai = 0; ai < 2; ++ai) _Pragma("unroll") for (int m = 0; m < 4; ++m) { const int rl = ai * HALF + wr * 64 + m * 16 + fr;
#define EPI_ROWS_END }
struct EpiStoreBf16 {
    bf16* O; int ldc; const float* rs;
    __device__ __forceinline__ void operator()(const f32x4 (&acc)[2][2][4][2], const Unit& u, int wr, int wc, int fr, int fq) const {
        EPI_ROWS_BEGIN bf16* rowp = O + (size_t)(u.pm * BM + rl) * ldc + u.pn * BM + wc * 32 + 8 * fq; const float sc = rs ? rs[u.pm * BM + rl] : 1.0f;
#pragma unroll
            for (int bj = 0; bj < 2; ++bj) { const f32x4 v0 = acc[ai][bj][m][0] * sc, v1 = acc[ai][bj][m][1] * sc;
                *(u32x4*)(rowp + bj * HALF) = (u32x4){pk2(v0[0], v0[1]), pk2(v0[2], v0[3]), pk2(v1[0], v1[1]), pk2(v1[2], v1[3])}; } EPI_ROWS_END
    }
};
struct EpiStoreBf16Split {
    bf16* O; int ldc; size_t half_stride; const float* rs;
    __device__ __forceinline__ void operator()(const f32x4 (&acc)[2][2][4][2], const Unit& u, int wr, int wc, int fr, int fq) const {
        EPI_ROWS_BEGIN bf16* rowp = O + (size_t)u.e * half_stride + (size_t)(u.pm * BM + rl) * ldc + u.pn * BM + wc * 32 + 8 * fq; const float sc = rs ? rs[u.pm * BM + rl] : 1.0f;
#pragma unroll
            for (int bj = 0; bj < 2; ++bj) { const f32x4 v0 = acc[ai][bj][m][0] * sc, v1 = acc[ai][bj][m][1] * sc;
                *(u32x4*)(rowp + bj * HALF) = (u32x4){pk2(v0[0], v0[1]), pk2(v0[2], v0[3]), pk2(v1[0], v1[1]), pk2(v1[2], v1[3])}; } EPI_ROWS_END
    }
};
struct EpiResid {
    bf16* X;
    __device__ __forceinline__ void operator()(const f32x4 (&acc)[2][2][4][2], const Unit& u, int wr, int wc, int fr, int fq) const {
#pragma unroll
        for (int ai = 0; ai < 2; ++ai) { bf16* base = X + (size_t)(u.pm * BM + ai * HALF + wr * 64 + fr) * D + u.pn * BM + wc * 32 + 8 * fq; u32x4 xv[4][2];
#pragma unroll
            for (int m = 0; m < 4; ++m)
#pragma unroll
                for (int bj = 0; bj < 2; ++bj) xv[m][bj] = *(const u32x4*)(base + (size_t)m * 16 * D + bj * HALF);
#pragma unroll
            for (int m = 0; m < 4; ++m)
#pragma unroll
                for (int bj = 0; bj < 2; ++bj) { const u32x2 lo = dn4(up4((u32x2){xv[m][bj].x, xv[m][bj].y}) + acc[ai][bj][m][0]), hi = dn4(up4((u32x2){xv[m][bj].z, xv[m][bj].w}) + acc[ai][bj][m][1]);
                    *(u32x4*)(base + (size_t)m * 16 * D + bj * HALF) = (u32x4){lo.x, lo.y, hi.x, hi.y}; }
            asm volatile("" ::: "memory"); }
    }
};
struct EpiGlu {
    bf16* X;
    __device__ __forceinline__ void operator()(const f32x4 (&acc)[2][2][4][2], const Unit& u, int wr, int wc, int fr, int fq) const {
#pragma unroll
        for (int ai = 0; ai < 2; ++ai) { u32x2 xv[4][2];
#pragma unroll
            for (int m = 0; m < 4; ++m)
#pragma unroll
                for (int bj = 0; bj < 2; ++bj) xv[m][bj] = *(const u32x2*)(X + (size_t)(u.pm * BM + ai * HALF + wr * 64 + m * 16 + fr) * D + 4 * fq + 16 * (8 * u.pn + 4 * bj + wc));
#pragma unroll
            for (int m = 0; m < 4; ++m)
#pragma unroll
                for (int bj = 0; bj < 2; ++bj) { const f32x4 a = acc[ai][bj][m][0], g = acc[ai][bj][m][1]; f32x4 x = up4(xv[m][bj]);
#pragma unroll
                    for (int j = 0; j < 4; ++j) x[j] += a[j] * sigmoidf_(g[j]);
                    *(u32x2*)(X + (size_t)(u.pm * BM + ai * HALF + wr * 64 + m * 16 + fr) * D + 4 * fq + 16 * (8 * u.pn + 4 * bj + wc)) = dn4(x); }
            asm volatile("" ::: "memory"); }
    }
};
struct EpiPle {
    const bf16* X; bf16* Xo; const bf16* PP; const float* bias; const float* rs;
    __device__ __forceinline__ void operator()(const f32x4 (&acc)[2][2][4][2], const Unit& u, int wr, int wc, int fr, int fq) const {
        const int col0 = u.pn * BM + wc * 32 + 8 * fq;
        f32x4 bv[2][2];
#pragma unroll
        for (int bj = 0; bj < 2; ++bj)
#pragma unroll
            for (int n = 0; n < 2; ++n) bv[bj][n] = *(const f32x4*)(bias + col0 + bj * HALF + n * 4);
#pragma unroll
        for (int ai = 0; ai < 2; ++ai) { const size_t ro = (size_t)(u.pm * BM + ai * HALF + wr * 64 + fr) * D + col0; u32x4 xv[4][2], pw[4][2]; float sc[4];
#pragma unroll
            for (int m = 0; m < 4; ++m) sc[m] = rs[u.pm * BM + ai * HALF + wr * 64 + m * 16 + fr];
#pragma unroll
            for (int m = 0; m < 4; ++m)
#pragma unroll
                for (int bj = 0; bj < 2; ++bj) { const size_t o = ro + (size_t)m * 16 * D + bj * HALF; xv[m][bj] = *(const u32x4*)(X + o); pw[m][bj] = *(const u32x4*)(PP + o); }
#pragma unroll
            for (int m = 0; m < 4; ++m)
#pragma unroll
                for (int bj = 0; bj < 2; ++bj) { const size_t o = ro + (size_t)m * 16 * D + bj * HALF; u32x2 outw[2];
#pragma unroll
                    for (int n = 0; n < 2; ++n) { const f32x4 v = acc[ai][bj][m][n] * sc[m] + bv[bj][n];
                        f32x4 x = up4(n ? (u32x2){xv[m][bj].z, xv[m][bj].w} : (u32x2){xv[m][bj].x, xv[m][bj].y}); const f32x4 pq = up4(n ? (u32x2){pw[m][bj].z, pw[m][bj].w} : (u32x2){pw[m][bj].x, pw[m][bj].y});
#pragma unroll
                        for (int j = 0; j < 4; ++j) x[j] += sigmoidf_(v[j]) * pq[j];
                        outw[n] = dn4(x); }
                    *(u32x4*)(Xo + o) = (u32x4){outw[0].x, outw[0].y, outw[1].x, outw[1].y}; }
            asm volatile("" ::: "memory"); }
    }
};
struct EpiMoeH {
    bf16* H; const float* comb; const LAS int* ptab;
    __device__ __forceinline__ void operator()(const f32x4 (&acc)[2][2][4][2], const Unit& u, int wr, int wc, int fr, int fq) const {
        EPI_ROWS_BEGIN const int pair = ptab[u.ui * 256 + rl];
            if (pair >= 0) { const float cb = comb[pair]; bf16* rowp = H + (size_t)pair * 512 + 4 * fq;
#pragma unroll
                for (int bj = 0; bj < 2; ++bj) { const f32x4 g = acc[ai][bj][m][0], up = acc[ai][bj][m][1]; u32x2 w;
                    w.x = pk2(siluf_(g[0]) * up[0] * cb, siluf_(g[1]) * up[1] * cb); w.y = pk2(siluf_(g[2]) * up[2] * cb, siluf_(g[3]) * up[3] * cb);
                    *(u32x2*)(rowp + 16 * (8 * u.pn + 4 * bj + wc)) = w; } } EPI_ROWS_END
    }
};
struct EpiMoeY {
    bf16* Y; const LAS int* ptab;
    __device__ __forceinline__ void operator()(const f32x4 (&acc)[2][2][4][2], const Unit& u, int wr, int wc, int fr, int fq) const {
        EPI_ROWS_BEGIN const int pair = ptab[u.ui * 256 + rl];
            if (pair >= 0) { bf16* rowp = Y + (size_t)pair * D + u.pn * BM + wc * 32 + 4 * fq;
#pragma unroll
                for (int bj = 0; bj < 2; ++bj)
#pragma unroll
                    for (int n = 0; n < 2; ++n) { const f32x4 v = acc[ai][bj][m][n]; u32x2 w; w.x = pk2(v[0], v[1]); w.y = pk2(v[2], v[3]); *(u32x2*)(rowp + bj * HALF + n * 16) = w; } } EPI_ROWS_END
    }
};
}

namespace fg {
constexpr int TM = 256, TN = 256, BK = 32, STG = 49152, NSTG = 3, MAXU = 6;
struct Tables { const LAS int* cnt; const LAS int* preU; const LAS int* ptab; const LAS int* utab; const LAS float* ctab; unsigned* flags; int stride, c0; };
__device__ __forceinline__ bool decode(const Tables& tb, int i, int& e, int& rt, int& ct) {
    if (i >= MAXU || tb.c0 < 0) return false;
    const int L = i * tb.stride + tb.c0; if (L >= tb.preU[32]) return false;
    e = 0;
    for (int j = 1; j < 32; ++j) e = (tb.preU[j] <= L) ? j : e;
    const int nrt = (tb.cnt[e] + 255) >> 8, r = L - tb.preU[e]; ct = r / nrt; rt = r - ct * nrt; return true;
}
template <int MODE, int DRY = 0>
__device__ __forceinline__ void fgemm_phase(const int tid, LAS unsigned char* lds, const Tables& tb, const char* Abase, const float* W1l, const float* W3l, bf16* Out, const int ub, const int ue) {
    constexpr int K = MODE == 0 ? 2048 : 512, NT = K / BK, LDN = MODE == 0 ? 512 : 2048;
    constexpr unsigned RBYTES = MODE == 0 ? 4096u : 1024u;
    const int wid = __builtin_amdgcn_readfirstlane(tid >> 6), lane = tid & 63, wr = wid >> 2, wc = wid & 3, fr = lane & 15, fq = lane >> 4;
    const unsigned ldsw = (unsigned)wid * 1024u;
    const int bc0 = 4 * lane, bc1 = (4 * lane) ^ 16;
    const int aoff = wr * 8192 + ((fr * 64 + fq * 16) ^ (((fr >> 3) & 1) << 5));
    const int bfo = 16384 + ((8 * fq) * 256 + ((wc * 64 + 2 * fr) ^ ((fq & 1) << 4))) * 4;
    const int nunits = ue;
    if (ue <= ub) return;
    const int total = (ue - ub) * NT;
    f32x4 acc[8][4];
#pragma unroll
    for (int m = 0; m < 8; ++m)
#pragma unroll
        for (int n = 0; n < 4; ++n) acc[m][n] = (f32x4){0.f, 0.f, 0.f, 0.f};
    int su = ub, skt = 0, ns = 0, sb3 = 0; unsigned s_aro[2]; const float* s_b0; const float* s_b1;
#define FG_BSRC(bc_, e_, ct_) (MODE == 0 ? ((((bc_) >> 5) & 1) ? W3l : W1l) + (size_t)(e_) * 2048 * 512 + (size_t)wid * 512 + (ct_) * 128 + 32 * ((bc_) >> 6) + ((bc_) & 31) \
                                         : W1l + (size_t)(e_) * 512 * 2048 + (size_t)wid * 2048 + (ct_) * 256 + (bc_))
#define FG_LOAD_UNIT(u_) do { const int e_ = tb.utab[3 * (u_)], ct_ = tb.utab[3 * (u_) + 2]; \
        if (MODE == 1 && tb.flags) {     \
            unsigned* fl_ = tb.flags + (e_ * 32 + tb.utab[3 * (u_) + 1]) * 16; unsigned sp_ = 0; \
            while (__hip_atomic_load(fl_, __ATOMIC_RELAXED, __HIP_MEMORY_SCOPE_AGENT) < 4u) { __builtin_amdgcn_s_sleep(4); if (++sp_ > (1u << 22)) break; } \
            __builtin_amdgcn_fence(__ATOMIC_ACQUIRE, "agent"); } \
        _Pragma("unroll") for (int i_ = 0; i_ < 2; ++i_) { const int b_ = i_ * 8192 + tid * 16, st_ = b_ >> 10, sb_ = b_ & 1023, swz_ = sb_ ^ (((sb_ >> 9) & 1) << 5); \
            const int p_ = tb.ptab[(u_) * 256 + st_ * 16 + swz_ / 64]; \
            s_aro[i_] = (p_ < 0 ? 0u : (MODE == 0 ? ((unsigned)p_ & 8191u) : (unsigned)p_) * RBYTES) + (unsigned)(swz_ % 64); } \
        s_b0 = FG_BSRC(bc0, e_, ct_); s_b1 = FG_BSRC(bc1, e_, ct_); } while (0)
#define FG_STAGE() do { LAS unsigned char* st_ = lds + sb3 * STG; \
        _Pragma("unroll") for (int i_ = 0; i_ < 2; ++i_) \
            __builtin_amdgcn_global_load_lds((const unsigned*)(Abase + (s_aro[i_] + (unsigned)skt * 64u)), (LAS unsigned*)(st_ + ldsw + i_ * 8192), 16, 0, 0); \
        _Pragma("unroll") for (int r_ = 0; r_ < 4; ++r_) __builtin_amdgcn_global_load_lds((const unsigned*)(((r_ & 1) ? s_b1 : s_b0) + (size_t)(skt * 32 + r_ * 8) * LDN), (LAS unsigned*)(st_ + 16384 + r_ * 8192 + ldsw), 16, 0, 0); \
        ++ns; sb3 = (sb3 == NSTG - 1) ? 0 : sb3 + 1; if (++skt == NT) { skt = 0; ++su; if (su < nunits) FG_LOAD_UNIT(su); } } while (0)
    FG_LOAD_UNIT(ub);
    FG_STAGE(); if (ns < total) FG_STAGE();
    int s = 0, cb3 = 0;
    for (int u = ub; u < nunits; ++u) {
#pragma unroll 1
        for (int kt = 0; kt < NT; ++kt, ++s) {
            if (ns - 1 - s >= 1) asm volatile("s_waitcnt vmcnt(6)" ::: "memory"); else asm volatile("s_waitcnt vmcnt(0)" ::: "memory");
            __builtin_amdgcn_s_barrier(); asm volatile("" ::: "memory");
            const LAS unsigned char* st = lds + cb3 * STG; cb3 = (cb3 == NSTG - 1) ? 0 : cb3 + 1;
            if (DRY == 2) { if (ns < total) FG_STAGE(); continue; }
            bf16x8 Af[8], Bf[4];
            f32x2 vb[2][8];
#pragma unroll
            for (int p2 = 0; p2 < 2; ++p2) { const LAS float* bp = (const LAS float*)(st + bfo) + p2 * 32;
#pragma unroll
                for (int j = 0; j < 8; ++j) vb[p2][j] = *(const LAS f32x2*)(bp + j * 256); }
#pragma unroll
            for (int m = 0; m < 8; ++m) Af[m] = *(const LAS bf16x8*)(st + aoff + m * 1024);
            if (ns < total) FG_STAGE();
#pragma unroll
            for (int p2 = 0; p2 < 2; ++p2) { const f32x2* v = vb[p2];
                u32x4 w0, w1; w0.x = pk2(v[0].x, v[1].x); w0.y = pk2(v[2].x, v[3].x); w0.z = pk2(v[4].x, v[5].x); w0.w = pk2(v[6].x, v[7].x);
                w1.x = pk2(v[0].y, v[1].y); w1.y = pk2(v[2].y, v[3].y); w1.z = pk2(v[4].y, v[5].y); w1.w = pk2(v[6].y, v[7].y);
                Bf[2 * p2] = __builtin_bit_cast(bf16x8, w0); Bf[2 * p2 + 1] = __builtin_bit_cast(bf16x8, w1); }
            if (DRY == 1) {
#pragma unroll
                for (int m = 0; m < 8; ++m) asm volatile("" :: "v"(Af[m]));
#pragma unroll
                for (int n = 0; n < 4; ++n) asm volatile("" :: "v"(Bf[n]));
                continue; }
            __builtin_amdgcn_s_setprio(1);
#pragma unroll
            for (int m = 0; m < 8; ++m)
#pragma unroll
                for (int n = 0; n < 4; ++n) acc[m][n] = __builtin_amdgcn_mfma_f32_16x16x32_bf16(Bf[n], Af[m], acc[m][n], 0, 0, 0);
            __builtin_amdgcn_s_setprio(0);
        }
        if (DRY == 0) {
            const int ct = tb.utab[3 * u + 2];
#pragma unroll
            for (int m = 0; m < 8; ++m) { const int ri = u * 256 + wr * 128 + m * 16 + fr; const int pair = tb.ptab[ri];
                if (pair >= 0) {
                    if (MODE == 0) { const float cb = tb.ctab[ri]; bf16* rowp = Out + (size_t)pair * 512 + ct * 128 + wc * 32 + 8 * fq;
                        const f32x4 g0 = acc[m][0], g1 = acc[m][1], u0 = acc[m][2], u1 = acc[m][3]; u32x4 w;
                        w.x = pk2(siluf_(g0[0]) * u0[0] * cb, siluf_(g1[0]) * u1[0] * cb); w.y = pk2(siluf_(g0[1]) * u0[1] * cb, siluf_(g1[1]) * u1[1] * cb);
                        w.z = pk2(siluf_(g0[2]) * u0[2] * cb, siluf_(g1[2]) * u1[2] * cb); w.w = pk2(siluf_(g0[3]) * u0[3] * cb, siluf_(g1[3]) * u1[3] * cb);
                        *(u32x4*)rowp = w; }
                    else { bf16* rowp = Out + (size_t)pair * D + ct * 256 + wc * 64 + 8 * fq;
#pragma unroll
                        for (int p2 = 0; p2 < 2; ++p2) { const f32x4 a = acc[m][2 * p2], b = acc[m][2 * p2 + 1]; u32x4 w;
                            w.x = pk2(a[0], b[0]); w.y = pk2(a[1], b[1]); w.z = pk2(a[2], b[2]); w.w = pk2(a[3], b[3]); *(u32x4*)(rowp + 32 * p2) = w; } } } }
#pragma unroll
            for (int m = 0; m < 8; ++m)
#pragma unroll
                for (int n = 0; n < 4; ++n) acc[m][n] = (f32x4){0.f, 0.f, 0.f, 0.f};
        }
    }
    asm volatile("s_waitcnt vmcnt(0)" ::: "memory");
    __syncthreads();
#undef FG_LOAD_UNIT
#undef FG_STAGE
#undef FG_BSRC
}
}

__device__ __forceinline__ void tr_item(const float* W, int ld, int K, int N, int col0, bf16* WT, int mode, int row_off, int item, int lane, const float* gk = nullptr) {
    const int nblk = N / 32, kb = item / nblk, nb = item - kb * nblk, k0 = 64 * kb, n0 = 32 * nb;
    const int kg = lane >> 3, c4 = lane & 7;
    const float* src = W + (size_t)(k0 + 8 * kg) * ld + col0 + n0 + 4 * c4;
    f32x4 v[8];
#pragma unroll
    for (int q = 0; q < 8; ++q) v[q] = *(const f32x4*)(src + (size_t)q * ld);
    if (gk) {
#pragma unroll
        for (int q = 0; q < 8; ++q) v[q] = v[q] * gk[k0 + 8 * kg + q]; }
#pragma unroll
    for (int i = 0; i < 4; ++i) { const int n = n0 + 4 * c4 + i; const int row = mode == 1 ? (32 * (n >> 4) + (n & 15) + row_off) : mode == 2 ? ((n & ~31) + 16 * ((n >> 2) & 1) + 4 * ((n & 31) >> 3) + (n & 3) + row_off) : (n + row_off);
        u32x4 o; o.x = pk2(v[0][i], v[1][i]); o.y = pk2(v[2][i], v[3][i]); o.z = pk2(v[4][i], v[5][i]); o.w = pk2(v[6][i], v[7][i]);
        *(u32x4*)(WT + (size_t)row * K + k0 + 8 * kg) = o; }
}
__device__ __forceinline__ void wcomb_item(const float* win, const float* wg, bf16* WT, int item, int lane, const float* gk) {
    const int jb = item & 7, kb = item >> 3, j = jb * 64 + lane, k0 = kb * 8;
    float g[16];
#pragma unroll
    for (int r = 0; r < 16; ++r) g[r] = wg[r * 512 + j];
    float o[8];
#pragma unroll
    for (int q = 0; q < 8; ++q) { const float* wr_ = win + (size_t)(k0 + q) * EV_IN + 5120; float s = 0.f;
#pragma unroll
        for (int r = 0; r < 16; ++r) s += wr_[r] * g[r];
        o[q] = s * gk[k0 + q]; }
    u32x4 w; w.x = pk2(o[0], o[1]); w.y = pk2(o[2], o[3]); w.z = pk2(o[4], o[5]); w.w = pk2(o[6], o[7]);
    *(u32x4*)(WT + (size_t)(5120 + (j & ~31) + 16 * ((j >> 2) & 1) + 4 * ((j & 31) >> 3) + (j & 3)) * D + k0) = w;
}
template <bool SRC_BF16, bool ADDY, bool WRITE_RES, int OUT>
__device__ __forceinline__ void norm_row(const void* src, const bf16* y0, const bf16* y1, bf16* res, const float* g, bf16* xn, float* of32, float* rs_out, int lane) {
    f32x4 va[4], vb[4]; float ss = 0.f;
#pragma unroll
    for (int j = 0; j < 4; ++j) { const int col = 8 * lane + 512 * j;
        if (SRC_BF16) { const u32x4 w = *(const u32x4*)((const bf16*)src + col); va[j] = up4((u32x2){w.x, w.y}); vb[j] = up4((u32x2){w.z, w.w}); }
        else { va[j] = *(const f32x4*)((const float*)src + col); vb[j] = *(const f32x4*)((const float*)src + col + 4); }
        if (ADDY) { const u32x4 a = *(const u32x4*)(y0 + col), b = *(const u32x4*)(y1 + col);
            va[j] = va[j] + up4((u32x2){a.x, a.y}) + up4((u32x2){b.x, b.y}); vb[j] = vb[j] + up4((u32x2){a.z, a.w}) + up4((u32x2){b.z, b.w}); }
        if (WRITE_RES) { const u32x2 wl = dn4(va[j]), wh = dn4(vb[j]); *(u32x4*)(res + col) = (u32x4){wl.x, wl.y, wh.x, wh.y}; va[j] = up4(wl); vb[j] = up4(wh); }
        ss += ((va[j][0] * va[j][0] + va[j][1] * va[j][1]) + (va[j][2] * va[j][2] + va[j][3] * va[j][3])) + ((vb[j][0] * vb[j][0] + vb[j][1] * vb[j][1]) + (vb[j][2] * vb[j][2] + vb[j][3] * vb[j][3])); }
    const float rs = rsqrtf(wave_sum(ss) * (1.0f / D) + EPS);
    if (rs_out && lane == 0) *rs_out = rs;
    if (OUT != 0) {
#pragma unroll
        for (int j = 0; j < 4; ++j) { const int col = 8 * lane + 512 * j; const f32x4 oa = va[j] * rs * *(const f32x4*)(g + col), ob = vb[j] * rs * *(const f32x4*)(g + col + 4);
            if (OUT == 1) { const u32x2 wl = dn4(oa), wh = dn4(ob); *(u32x4*)(xn + col) = (u32x4){wl.x, wl.y, wh.x, wh.y}; } else { *(f32x4*)(of32 + col) = oa; *(f32x4*)(of32 + col + 4) = ob; } } }
}

__device__ __forceinline__ void p0_prologue(Frame& F, KArgs& A) {
    const int gw = F.vcu * NWAVES + F.wave, NGW = F.G * NWAVES, lane = F.lane;
    unsigned char* ws = F.ws;
    constexpr int I_WIN = (D / 32) * (5120 / 64);
    constexpr int I_WC = (D / 8) * 8;
    constexpr int I_WOUT = (D / 32) * (D / 64);
    constexpr int I_ODW = (D / 32) * (1024 / 64);
    constexpr int I_GLU = (1024 / 32) * (2048 / 64);
    constexpr int I_PLEG = I_WOUT;
    constexpr int I_PLEP = (256 / 32) * (D / 64);
    constexpr int I_W1 = (D / 32) * (512 / 64);
    constexpr int I_W2 = (512 / 32) * (D / 64);
    constexpr int N_DENSE = 2 * (I_WIN + I_WC + I_WOUT + I_ODW + 2 * I_GLU) + 4 * (I_PLEG + I_PLEP);
    for (int it = gw; it < N_DENSE; it += NGW) {
        int r = it;
        if (r < 2 * I_WIN) { const int e = r / I_WIN; tr_item(A.in[6] + (size_t)e * D * EV_IN, EV_IN, D, 5120, 0, (bf16*)(ws + WS_WIN + e * SZ_WIN), 2, 0, r % I_WIN, lane, A.in[2] + (size_t)(2 * e) * D); continue; } r -= 2 * I_WIN;
        if (r < 2 * I_WC) { const int e = r / I_WC; wcomb_item(A.in[6] + (size_t)e * D * EV_IN, A.in[14] + (size_t)e * 16 * 512, (bf16*)(ws + WS_WIN + e * SZ_WIN), r % I_WC, lane, A.in[2] + (size_t)(2 * e) * D); continue; } r -= 2 * I_WC;
        if (r < 2 * I_WOUT) { const int e = r / I_WOUT; tr_item(A.in[17] + (size_t)e * D * D, D, D, D, 0, (bf16*)(ws + WS_WOUT + e * SZ_DD), 2, 0, r % I_WOUT, lane); continue; } r -= 2 * I_WOUT;
        if (r < 2 * I_ODW) { const int o = r / I_ODW; tr_item(A.in[18] + (size_t)o * D * 1024, 1024, D, 1024, 0, (bf16*)(ws + WS_ODWIN + o * SZ_ODWIN), 2, 0, r % I_ODW, lane, A.in[2] + (size_t)(2 * o + 1) * D); continue; } r -= 2 * I_ODW;
        if (r < 4 * I_GLU) { const int o = r / (2 * I_GLU), hf = (r / I_GLU) & 1; tr_item(A.in[27] + (size_t)o * 1024 * 4096, 4096, 1024, 2048, hf * 2048, (bf16*)(ws + WS_WGLU + o * SZ_WGLU), 1, hf * 16, r % I_GLU, lane); continue; } r -= 4 * I_GLU;
        if (r < 4 * I_PLEG) { const int l = r / I_PLEG; tr_item(A.in[35] + (size_t)l * D * D, D, D, D, 0, (bf16*)(ws + WS_PLEG + l * SZ_DD), 2, 0, r % I_PLEG, lane, A.in[4] + (size_t)l * D); continue; } r -= 4 * I_PLEG;
        { const int l = r / I_PLEP; tr_item(A.in[37] + (size_t)l * 256 * D, D, 256, D, 0, (bf16*)(ws + WS_PLEP + l * SZ_PLEP), 2, 0, r % I_PLEP, lane); }
    }
    for (int i = gw * 64 + lane; i < 4 * 16 * 4 * 48 * 40; i += NGW * 64) {
        const int k = i % 40, o = (i / 40) % 48, q = (i / (40 * 48)) & 3, t = (i / (40 * 48 * 4)) & 15, l = i / (40 * 48 * 64);
        unsigned hb = 0u, lb = 0u;
        if (o < 36 && k < 32) { const int kk = 512 * q + 32 * t + k;
            const float wv = o < 4 ? A.in[28][((size_t)l * D + kk) * 4 + o] : A.in[30][((size_t)l * D + kk) * 32 + (o - 4)];
            const float wf = wv * A.in[3][(size_t)l * D + kk]; hb = f2bf(wf); lb = f2bf(wf - bf2f(hb)); }
        bf16* img = (bf16*)(ws + WS_RTW) + (size_t)(l * 16 + t) * RTW_IMG + (q * 48 + o) * 40 + k;
        img[0] = (bf16)hb; img[4 * 48 * 40] = (bf16)lb;
    }
    { const float* p = A.in[1]; bf16* pb = (bf16*)(ws + WS_PB); const size_t n8 = (size_t)4 * T * 256 / 8;
        for (size_t i = (size_t)gw * 64 + lane; i < n8; i += (size_t)NGW * 64) { const f32x4 a = *(const f32x4*)(p + i * 8), b = *(const f32x4*)(p + i * 8 + 4);
            u32x4 w; w.x = pk2(a[0], a[1]); w.y = pk2(a[2], a[3]); w.z = pk2(b[0], b[1]); w.w = pk2(b[2], b[3]); *(u32x4*)(pb + i * 8) = w; } }
    for (int m = gw; m < T; m += NGW)
        norm_row<false, false, true, 0>(A.in[0] + (size_t)m * D, nullptr, nullptr, (bf16*)(ws + WS_XRES) + (size_t)m * D, nullptr, nullptr, nullptr, (float*)(ws + WS_RS) + m, lane);
}

__device__ __forceinline__ void lru_unit(Frame& F, KArgs& A, int e, int unit) {
    const int tid = F.tid, lane = F.lane, w = F.wave, b = unit >> 6, h = (unit >> 2) & 15, jq = unit & 3, n16 = lane & 15, kq = lane >> 4;
    LAS bf16* ZT = (LAS bf16*)F.lds;
    LAS bf16* XCB = ZT + 259 * 72;
    LAS float* aa = (LAS float*)(XCB + 256 * 72);
    LAS float* uu = aa + 4096;
    LAS bf16* GT = (LAS bf16*)(uu + 4096);
    LAS bf16* YT = GT + 4096;
    LAS float* sA = (LAS float*)(YT + 4096);
    LAS float* sH = sA + 512;
    LAS float* cin = sH + 512;
    LAS float* carry = cin + 512;
    LAS float* cw = carry + 16;
    const bf16* z = (const bf16*)(F.ws + WS_Z);
    bf16* ycat = (bf16*)(F.ws + WS_YCAT);
    float cwr[5][8];
    { const int c8 = tid & 7;
#pragma unroll
        for (int k = 0; k < 4; ++k) { const float* src = A.in[7] + ((size_t)e * 4 + k) * 1024 + h * 64 + c8 * 8; const f32x4 a = *(const f32x4*)src, b4 = *(const f32x4*)(src + 4);
            cwr[k][0] = a[0]; cwr[k][1] = a[1]; cwr[k][2] = a[2]; cwr[k][3] = a[3]; cwr[k][4] = b4[0]; cwr[k][5] = b4[1]; cwr[k][6] = b4[2]; cwr[k][7] = b4[3]; }
        const float* sb = A.in[8] + (size_t)e * 1024 + h * 64 + c8 * 8; const f32x4 a = *(const f32x4*)sb, b4 = *(const f32x4*)(sb + 4);
        cwr[4][0] = a[0]; cwr[4][1] = a[1]; cwr[4][2] = a[2]; cwr[4][3] = a[3]; cwr[4][4] = b4[0]; cwr[4][5] = b4[1]; cwr[4][6] = b4[2]; cwr[4][7] = b4[3]; }
    bf16x8 WAf[2], WXf[2];
    { const float* w_a = A.in[9] + ((size_t)(e * 16 + h) * 64) * 64 + jq * 16 + n16; const float* w_x = A.in[11] + ((size_t)(e * 16 + h) * 64) * 64 + jq * 16 + n16;
#pragma unroll
        for (int ks = 0; ks < 2; ++ks) { float va[8], vx[8];
#pragma unroll
            for (int j = 0; j < 8; ++j) { va[j] = w_a[(size_t)(32 * ks + 8 * kq + j) * 64]; vx[j] = w_x[(size_t)(32 * ks + 8 * kq + j) * 64]; }
            WAf[ks] = __builtin_bit_cast(bf16x8, (u32x4){pk2(va[0], va[1]), pk2(va[2], va[3]), pk2(va[4], va[5]), pk2(va[6], va[7])});
            WXf[ks] = __builtin_bit_cast(bf16x8, (u32x4){pk2(vx[0], vx[1]), pk2(vx[2], vx[3]), pk2(vx[4], vx[5]), pk2(vx[6], vx[7])}); } }
    float ba[4], bx[4], sp[4];
#pragma unroll
    for (int r = 0; r < 4; ++r) { const int ch = h * 64 + jq * 16 + 4 * kq + r; ba[r] = A.in[10][e * 1024 + ch]; bx[r] = A.in[12][e * 1024 + ch]; sp[r] = -8.0f * softplusf_(-A.in[13][e * 1024 + ch]); }
    u32x4 pz[4], pg;
#define LRU_PREFETCH(s0_) do { _Pragma("unroll") for (int r_ = 0; r_ < 4; ++r_) { const int piece = r_ * 512 + tid; pz[r_] = *(const u32x4*)(z + (size_t)(b * SEQ + (s0_) + (piece >> 3)) * ZW + h * 64 + (piece & 7) * 8); } \
        pg = *(const u32x4*)(z + (size_t)(b * SEQ + (s0_) + (tid >> 1)) * ZW + 1024 + h * 64 + jq * 16 + (tid & 1) * 8); } while (0)
    LRU_PREFETCH(0);
    const int tl = tid >> 1, half = tid & 1;
#pragma unroll 1
    for (int tb = 0; tb < 8; ++tb) {
        const int s0 = tb * 256;
        u32x4 halo = (u32x4){0u, 0u, 0u, 0u};
        if (tb > 0 && tid < 24) halo = *(const LAS u32x4*)(ZT + (256 + (tid >> 3)) * 72 + (tid & 7) * 8);
        LDS_BARRIER();
        if (tid < 24) *(LAS u32x4*)(ZT + (tid >> 3) * 72 + (tid & 7) * 8) = halo;
#pragma unroll
        for (int r = 0; r < 4; ++r) { const int piece = r * 512 + tid; *(LAS u32x4*)(ZT + (3 + (piece >> 3)) * 72 + (piece & 7) * 8) = pz[r]; }
        *(LAS u32x4*)(GT + (tid >> 1) * 16 + (tid & 1) * 8) = pg;
        if (tb < 7) LRU_PREFETCH(s0 + 256);
        LDS_BARRIER();
        { const int tg4 = tid >> 3, c8 = tid & 7; float xr[7][8];
#pragma unroll
            for (int r = 0; r < 7; ++r) { const u32x4 wv = *(const LAS u32x4*)(ZT + (4 * tg4 + r) * 72 + c8 * 8);
                xr[r][0] = lo16(wv.x); xr[r][1] = hi16(wv.x); xr[r][2] = lo16(wv.y); xr[r][3] = hi16(wv.y); xr[r][4] = lo16(wv.z); xr[r][5] = hi16(wv.z); xr[r][6] = lo16(wv.w); xr[r][7] = hi16(wv.w); }
#pragma unroll
            for (int i = 0; i < 4; ++i) { float accv[8];
#pragma unroll
                for (int q = 0; q < 8; ++q) { accv[q] = cwr[4][q];
#pragma unroll
                    for (int k = 0; k < 4; ++k) accv[q] += cwr[k][q] * xr[i + k][q]; }
                *(LAS u32x4*)(XCB + (4 * tg4 + i) * 72 + c8 * 8) = (u32x4){pk2(accv[0], accv[1]), pk2(accv[2], accv[3]), pk2(accv[4], accv[5]), pk2(accv[6], accv[7])}; } }
        LDS_BARRIER();
#pragma unroll
        for (int tt2 = 0; tt2 < 2; ++tt2) { const int tok = (2 * w + tt2) * 16 + n16; f32x4 da = (f32x4){0.f, 0.f, 0.f, 0.f}, dx = da;
#pragma unroll
            for (int ks = 0; ks < 2; ++ks) { const bf16x8 xf = *(const LAS bf16x8*)(XCB + tok * 72 + 32 * ks + 8 * kq);
                da = __builtin_amdgcn_mfma_f32_16x16x32_bf16(WAf[ks], xf, da, 0, 0, 0); dx = __builtin_amdgcn_mfma_f32_16x16x32_bf16(WXf[ks], xf, dx, 0, 0, 0); }
            const u32x2 xw = *(const LAS u32x2*)(XCB + tok * 72 + jq * 16 + 4 * kq); const float xo[4] = {lo16(xw.x), hi16(xw.x), lo16(xw.y), hi16(xw.y)};
            f32x4 av, uv;
#pragma unroll
            for (int r = 0; r < 4; ++r) { const float rg = sigmoidf_(da[r] + ba[r]), ig = sigmoidf_(dx[r] + bx[r]); const float la = rg * sp[r];
                av[r] = __expf(la); uv[r] = __builtin_amdgcn_sqrtf(fmaxf(one_minus_exp(2.0f * la), 0.f)) * ig * xo[r]; }
            *(LAS f32x4*)(aa + tok * 16 + 4 * kq) = av; *(LAS f32x4*)(uu + tok * 16 + 4 * kq) = uv; }
        LDS_BARRIER();
        const int ch = tid & 15, seg = tid >> 4;
        { float Ac = 1.f, Hh = 0.f;
#pragma unroll
            for (int q = 0; q < 8; ++q) { const float a = aa[(seg * 8 + q) * 16 + ch], u = uu[(seg * 8 + q) * 16 + ch]; Hh = a * Hh + u; Ac *= a; }
            sA[seg * 16 + ch] = Ac; sH[seg * 16 + ch] = Hh; }
        LDS_BARRIER();
        if (tid < 16) { float c = (tb == 0) ? 0.f : carry[tid];
#pragma unroll 4
            for (int sg = 0; sg < 32; ++sg) { cin[sg * 16 + tid] = c; c = sA[sg * 16 + tid] * c + sH[sg * 16 + tid]; }
            carry[tid] = c; }
        LDS_BARRIER();
        { float hh = cin[seg * 16 + ch];
#pragma unroll
            for (int q = 0; q < 8; ++q) { const int tq = seg * 8 + q; hh = aa[tq * 16 + ch] * hh + uu[tq * 16 + ch];
                YT[tq * 16 + ch] = (bf16)f2bf(hh * gelu_tanh(bf2f(GT[tq * 16 + ch]))); } }
        LDS_BARRIER();
        *(u32x4*)(ycat + (size_t)(b * SEQ + s0 + (tid >> 1)) * D + h * 64 + jq * 16 + (tid & 1) * 8) = *(const LAS u32x4*)(YT + (tid >> 1) * 16 + (tid & 1) * 8);
    }
#undef LRU_PREFETCH
    LDS_BARRIER();
}

__device__ __forceinline__ void gla_bcum(Frame& F, KArgs& A, int e, int h, size_t t0, LAS float* buf, int stride, LAS float* bl, LAS float* seg4) {
    const int tid = F.tid; const bf16* z = (const bf16*)(F.ws + WS_Z);
    { const int t = tid >> 3, d0 = (tid & 7) * 16; const bf16* zr = z + (t0 + t) * ZW + 5120 + h * 128 + d0; const float* bg = A.in[15] + e * 512 + h * 128 + d0;
#pragma unroll
        for (int c8 = 0; c8 < 2; ++c8) { const u32x4 w = *(const u32x4*)(zr + c8 * 8); LAS float* o = buf + t * stride + d0 + c8 * 8; const float* bb = bg + c8 * 8;
            o[0] = logsigmoidf_(lo16(w.x) + bb[0]) * 0.0625f; o[1] = logsigmoidf_(hi16(w.x) + bb[1]) * 0.0625f; o[2] = logsigmoidf_(lo16(w.y) + bb[2]) * 0.0625f; o[3] = logsigmoidf_(hi16(w.y) + bb[3]) * 0.0625f;
            o[4] = logsigmoidf_(lo16(w.z) + bb[4]) * 0.0625f; o[5] = logsigmoidf_(hi16(w.z) + bb[5]) * 0.0625f; o[6] = logsigmoidf_(lo16(w.w) + bb[6]) * 0.0625f; o[7] = logsigmoidf_(hi16(w.w) + bb[7]) * 0.0625f; } }
    __syncthreads();
    const int d = tid & 127, sg = tid >> 7; float v[16];
    { float run = 0.f;
#pragma unroll
        for (int j = 0; j < 16; ++j) { run += buf[(sg * 16 + j) * stride + d]; v[j] = run; }
        seg4[sg * 128 + d] = run; }
    __syncthreads();
    { float off = 0.f;
#pragma unroll
        for (int q = 0; q < 3; ++q) off += (q < sg) ? seg4[q * 128 + d] : 0.f;
#pragma unroll
        for (int j = 0; j < 16; ++j) buf[(sg * 16 + j) * stride + d] = v[j] + off;
        if (sg == 3) bl[d] = v[15] + off; }
    __syncthreads();
}
typedef short s16x4 __attribute__((ext_vector_type(4)));
__device__ __forceinline__ bf16x8 tr_frag(const LAS bf16* tile, int rs  , int row0, int col0, int lane) {
    const int g = lane >> 4, q = (lane & 15) >> 2, p = lane & 3;
    const LAS bf16* a0 = tile + (row0 + 8 * g + q) * rs + col0 + 4 * p;
    const s16x4 lo = __builtin_amdgcn_ds_read_tr16_b64_v4i16((LAS s16x4*)a0), hi = __builtin_amdgcn_ds_read_tr16_b64_v4i16((LAS s16x4*)(a0 + 4 * rs));
    return (bf16x8){lo[0], lo[1], lo[2], lo[3], hi[0], hi[1], hi[2], hi[3]};
}
__device__ __forceinline__ void gla_ds_unit(Frame& F, KArgs& A, int e, int unit) {
    const int tid = F.tid, lane = F.lane, w = F.wave, b = unit >> 7, h = (unit >> 5) & 3, c = unit & 31, bh = b * 4 + h; const size_t t0 = (size_t)b * SEQ + c * 64;
    const int n16 = lane & 15, kq = lane >> 4;
    LAS float* BC = (LAS float*)F.lds;
    LAS bf16* KE = (LAS bf16*)(F.lds + 33792);
    LAS bf16* VT = KE + 64 * 136;
    LAS float* BL = (LAS float*)(VT + 64 * 272);
    LAS float* SEG = BL + 128;
    const bf16* z = (const bf16*)(F.ws + WS_Z);
    gla_bcum(F, A, e, h, t0, BC, 132, BL, SEG);
    { const int t = tid >> 3, d0 = (tid & 7) * 16; const bf16* zr = z + (t0 + t) * ZW + 2560 + h * 128 + d0;
#pragma unroll
        for (int c8 = 0; c8 < 2; ++c8) { const u32x4 kw = *(const u32x4*)(zr + c8 * 8); const LAS float* bc = BC + t * 132 + d0 + c8 * 8; const LAS float* bl = BL + d0 + c8 * 8;
            const float kv[8] = {lo16(kw.x), hi16(kw.x), lo16(kw.y), hi16(kw.y), lo16(kw.z), hi16(kw.z), lo16(kw.w), hi16(kw.w)}; float ko[8];
#pragma unroll
            for (int j = 0; j < 8; ++j) ko[j] = kv[j] * __expf(bl[j] - bc[j]);
            *(LAS u32x4*)(KE + t * 136 + d0 + c8 * 8) = (u32x4){pk2(ko[0], ko[1]), pk2(ko[2], ko[3]), pk2(ko[4], ko[5]), pk2(ko[6], ko[7])}; }
        const int v0 = (tid & 7) * 32; const bf16* vr = z + (t0 + t) * ZW + 3072 + h * 256 + v0;
#pragma unroll
        for (int c8 = 0; c8 < 4; ++c8) *(LAS u32x4*)(VT + t * 272 + v0 + c8 * 8) = *(const u32x4*)(vr + c8 * 8); }
    if (tid < 128) ((float*)(F.ws + WS_DECAY))[(size_t)(bh * 32 + c) * 128 + tid] = __expf(BL[tid]);
    __syncthreads();
    f32x4 acc[2][8];
#pragma unroll
    for (int vb = 0; vb < 2; ++vb)
#pragma unroll
        for (int db = 0; db < 8; ++db) acc[vb][db] = (f32x4){0.f, 0.f, 0.f, 0.f};
#pragma unroll
    for (int ks = 0; ks < 2; ++ks) { bf16x8 af[2];
#pragma unroll
        for (int vb = 0; vb < 2; ++vb) af[vb] = tr_frag(VT, 272, 32 * ks, (2 * w + vb) * 16, lane);
#pragma unroll
        for (int db = 0; db < 8; ++db) { const bf16x8 bfr = tr_frag(KE, 136, 32 * ks, db * 16, lane);
#pragma unroll
            for (int vb = 0; vb < 2; ++vb) acc[vb][db] = __builtin_amdgcn_mfma_f32_16x16x32_bf16(af[vb], bfr, acc[vb][db], 0, 0, 0); } }
    bf16* ds = (bf16*)(F.ws + WS_DS) + (size_t)(bh * 32 + c) * 128 * 256;
#pragma unroll
    for (int db = 0; db < 8; ++db)
#pragma unroll
        for (int vb = 0; vb < 2; ++vb) *(u32x2*)(ds + (size_t)(db * 16 + n16) * 256 + (2 * w + vb) * 16 + 4 * kq) = dn4(acc[vb][db]);
    LDS_BARRIER();
}
__device__ __forceinline__ void gla_state_phase(Frame& F) {
    const bf16* ds = (const bf16*)(F.ws + WS_DS); bf16* sp = (bf16*)(F.ws + WS_SPREV); const float* dec = (const float*)(F.ws + WS_DECAY);
    if (F.tid < NTHR / 2) for (int it = F.vcu * (NTHR / 2) + F.tid; it < 16 * 128 * 32; it += F.G * (NTHR / 2)) {
        const int bh = it >> 12, d = (it >> 5) & 127, v8 = it & 31; f32x4 sa = (f32x4){0.f, 0.f, 0.f, 0.f}, sb = sa;
#pragma unroll 1
        for (int c0 = 0; c0 < 32; c0 += 8) { u32x4 dv[8]; float dc[8];
#pragma unroll
            for (int j = 0; j < 8; ++j) { const size_t idx = ((size_t)(bh * 32 + c0 + j) * 128 + d) * 256 + v8 * 8; dv[j] = *(const u32x4*)(ds + idx); dc[j] = dec[(size_t)(bh * 32 + c0 + j) * 128 + d]; }
#pragma unroll
            for (int j = 0; j < 8; ++j) { const size_t idx = ((size_t)(bh * 32 + c0 + j) * 128 + d) * 256 + v8 * 8;
                *(u32x4*)(sp + idx) = (u32x4){pk2(sa[0], sa[1]), pk2(sa[2], sa[3]), pk2(sb[0], sb[1]), pk2(sb[2], sb[3])};
                sa = sa * dc[j] + up4((u32x2){dv[j].x, dv[j].y}); sb = sb * dc[j] + up4((u32x2){dv[j].z, dv[j].w}); } }
    }
}
__device__ __forceinline__ void gla_out_unit(Frame& F, KArgs& A, int e, int unit) {
    const int tid = F.tid, lane = F.lane, w = F.wave, b = unit >> 7, h = (unit >> 5) & 3, c = unit & 31, bh = b * 4 + h; const size_t t0 = (size_t)b * SEQ + c * 64;
    const int n16 = lane & 15, kq = lane >> 4;
    LAS float* BC = (LAS float*)F.lds;
    LAS bf16* ATT = (LAS bf16*)F.lds;
    LAS bf16* QS = (LAS bf16*)(F.lds + 33792);
    LAS bf16* KS = QS + 64 * 136;
    LAS bf16* VT = KS + 64 * 136;
    LAS bf16* SB = VT + 64 * 272;
    LAS float* RSS = (LAS float*)(SB + 64 * 272);
    LAS float* BL = RSS + 512;
    LAS float* SEG = BL + 128;
    const bf16* z = (const bf16*)(F.ws + WS_Z);
    const bf16* spg = (const bf16*)(F.ws + WS_SPREV) + (size_t)(bh * 32 + c) * 128 * 256;
    gla_bcum(F, A, e, h, t0, BC, 132, BL, SEG);
    u32x4 sb2[4];
    { const int t = tid >> 3, d0 = (tid & 7) * 16; const bf16* qr = z + (t0 + t) * ZW + 2048 + h * 128 + d0; const bf16* kr = z + (t0 + t) * ZW + 2560 + h * 128 + d0;
#pragma unroll
        for (int c8 = 0; c8 < 2; ++c8) { const u32x4 qw = *(const u32x4*)(qr + c8 * 8), kw = *(const u32x4*)(kr + c8 * 8); const LAS float* bc = BC + t * 132 + d0 + c8 * 8;
            const float qv[8] = {lo16(qw.x), hi16(qw.x), lo16(qw.y), hi16(qw.y), lo16(qw.z), hi16(qw.z), lo16(qw.w), hi16(qw.w)};
            const float kv[8] = {lo16(kw.x), hi16(kw.x), lo16(kw.y), hi16(kw.y), lo16(kw.z), hi16(kw.z), lo16(kw.w), hi16(kw.w)};
            float qo[8], ko[8];
#pragma unroll
            for (int j = 0; j < 8; ++j) { const float bcv = bc[j]; qo[j] = qv[j] * 0.08838834764831845f * __expf(bcv); ko[j] = kv[j] * __expf(-bcv); }
            *(LAS u32x4*)(QS + t * 136 + d0 + c8 * 8) = (u32x4){pk2(qo[0], qo[1]), pk2(qo[2], qo[3]), pk2(qo[4], qo[5]), pk2(qo[6], qo[7])};
            *(LAS u32x4*)(KS + t * 136 + d0 + c8 * 8) = (u32x4){pk2(ko[0], ko[1]), pk2(ko[2], ko[3]), pk2(ko[4], ko[5]), pk2(ko[6], ko[7])}; }
        const int v0 = (tid & 7) * 32; const bf16* vr = z + (t0 + t) * ZW + 3072 + h * 256 + v0; const bf16* sr = spg + (size_t)t * 256 + v0;
#pragma unroll
        for (int c8 = 0; c8 < 4; ++c8) { *(LAS u32x4*)(VT + t * 272 + v0 + c8 * 8) = *(const u32x4*)(vr + c8 * 8); *(LAS u32x4*)(SB + t * 272 + v0 + c8 * 8) = *(const u32x4*)(sr + c8 * 8); }
#pragma unroll
        for (int c8 = 0; c8 < 4; ++c8) sb2[c8] = *(const u32x4*)(sr + (size_t)64 * 256 + c8 * 8); }
    LDS_BARRIER();
    { const int ib = w >> 1;
#pragma unroll
        for (int jj = 0; jj < 2; ++jj) { const int jb = (w & 1) * 2 + jj; f32x4 d = (f32x4){0.f, 0.f, 0.f, 0.f};
            if (jb <= ib) {
#pragma unroll
                for (int ks = 0; ks < 4; ++ks) { const bf16x8 kf = *(const LAS bf16x8*)(KS + (16 * jb + n16) * 136 + 32 * ks + 8 * kq), qf = *(const LAS bf16x8*)(QS + (16 * ib + n16) * 136 + 32 * ks + 8 * kq);
                    d = __builtin_amdgcn_mfma_f32_16x16x32_bf16(kf, qf, d, 0, 0, 0); }
#pragma unroll
                for (int r = 0; r < 4; ++r) if (16 * jb + 4 * kq + r > 16 * ib + n16) d[r] = 0.f; }
            *(LAS u32x2*)(ATT + (16 * ib + n16) * 72 + 16 * jb + 4 * kq) = (u32x2){pk2(d[0], d[1]), pk2(d[2], d[3])}; } }
    __syncthreads();
    f32x4 acc[2][4];
#pragma unroll
    for (int vb = 0; vb < 2; ++vb)
#pragma unroll
        for (int ib = 0; ib < 4; ++ib) acc[vb][ib] = (f32x4){0.f, 0.f, 0.f, 0.f};
#pragma unroll
    for (int ks = 0; ks < 2; ++ks) { bf16x8 af[2];
#pragma unroll
        for (int vb = 0; vb < 2; ++vb) af[vb] = tr_frag(VT, 272, 32 * ks, (2 * w + vb) * 16, lane);
#pragma unroll
        for (int ib = 0; ib < 4; ++ib) if (32 * ks <= 16 * ib + 15) { const bf16x8 bfr = *(const LAS bf16x8*)(ATT + (16 * ib + n16) * 72 + 32 * ks + 8 * kq);
#pragma unroll
            for (int vb = 0; vb < 2; ++vb) acc[vb][ib] = __builtin_amdgcn_mfma_f32_16x16x32_bf16(af[vb], bfr, acc[vb][ib], 0, 0, 0); } }
#pragma unroll
    for (int half = 0; half < 2; ++half) {
        if (half == 1) { LDS_BARRIER();
            const int t = tid >> 3, v0 = (tid & 7) * 32;
#pragma unroll
            for (int c8 = 0; c8 < 4; ++c8) *(LAS u32x4*)(SB + t * 272 + v0 + c8 * 8) = sb2[c8];
            LDS_BARRIER(); }
#pragma unroll
        for (int ks = 0; ks < 2; ++ks) { bf16x8 af[2];
#pragma unroll
            for (int vb = 0; vb < 2; ++vb) af[vb] = tr_frag(SB, 272, 32 * ks, (2 * w + vb) * 16, lane);
#pragma unroll
            for (int ib = 0; ib < 4; ++ib) { const bf16x8 bfr = *(const LAS bf16x8*)(QS + (16 * ib + n16) * 136 + 64 * half + 32 * ks + 8 * kq);
#pragma unroll
                for (int vb = 0; vb < 2; ++vb) acc[vb][ib] = __builtin_amdgcn_mfma_f32_16x16x32_bf16(af[vb], bfr, acc[vb][ib], 0, 0, 0); } } }
#pragma unroll
    for (int ib = 0; ib < 4; ++ib) { float ss = 0.f;
#pragma unroll
        for (int vb = 0; vb < 2; ++vb)
#pragma unroll
            for (int r = 0; r < 4; ++r) ss += acc[vb][ib][r] * acc[vb][ib][r];
        ss += shx(ss, 16, lane); ss += shx(ss, 32, lane);
        if (kq == 0) RSS[w * 64 + 16 * ib + n16] = ss; }
    u32x2 gwv[4][2]; f32x4 hnv[2];
#pragma unroll
    for (int vb = 0; vb < 2; ++vb) { const int v = (2 * w + vb) * 16 + 4 * kq; hnv[vb] = *(const f32x4*)(A.in[16] + e * 1024 + h * 256 + v);
#pragma unroll
        for (int ib = 0; ib < 4; ++ib) gwv[ib][vb] = *(const u32x2*)(z + (t0 + 16 * ib + n16) * ZW + 4096 + h * 256 + v); }
    LDS_BARRIER();
#pragma unroll
    for (int ib = 0; ib < 4; ++ib) { float tot = 0.f;
#pragma unroll
        for (int ww = 0; ww < 8; ++ww) tot += RSS[ww * 64 + 16 * ib + n16];
        const float rs = rsqrtf(tot * (1.0f / 256.0f) + EPS); const size_t t = t0 + 16 * ib + n16;
#pragma unroll
        for (int vb = 0; vb < 2; ++vb) { const int v = (2 * w + vb) * 16 + 4 * kq; const f32x4 hn = hnv[vb]; const u32x2 gw = gwv[ib][vb];
            const f32x4 o = acc[vb][ib];
            const float y0 = o[0] * rs * hn[0] * siluf_(lo16(gw.x)), y1 = o[1] * rs * hn[1] * siluf_(hi16(gw.x)), y2 = o[2] * rs * hn[2] * siluf_(lo16(gw.y)), y3 = o[3] * rs * hn[3] * siluf_(hi16(gw.y));
            *(u32x2*)((bf16*)(F.ws + WS_YCAT) + t * D + 1024 + h * 256 + v) = (u32x2){pk2(y0, y1), pk2(y2, y3)}; } }
    LDS_BARRIER();
}

__device__ __forceinline__ void s5_unit(Frame& F, KArgs& A, int o, int unit) {
    const int tid = F.tid, lane = F.lane, w = F.wave, b = unit >> 6, g = unit & 63;
    LAS unsigned* U = (LAS unsigned*)F.lds;
    LAS float* XBall = (LAS float*)(F.lds + 65536);
    LAS float* EE = XBall + 8 * 2560;
    const bf16* u = (const bf16*)(F.ws + WS_U);
#pragma unroll
    for (int r = 0; r < 8; ++r) { const int piece = r * 512 + tid, tok = piece >> 1, hf = piece & 1; const size_t o_ = (size_t)(b * SEQ + tok) * 1024 + g * 16 + hf * 8;
        const u32x4 p0 = *(const u32x4*)(u + o_), p1 = *(const u32x4*)(u + (size_t)T * 1024 + o_);
        *(LAS u32x4*)(U + tok * 8 + hf * 4) = (u32x4){pk2(lo16(p0.x) + lo16(p1.x), hi16(p0.x) + hi16(p1.x)), pk2(lo16(p0.y) + lo16(p1.y), hi16(p0.y) + hi16(p1.y)),
                                                     pk2(lo16(p0.z) + lo16(p1.z), hi16(p0.z) + hi16(p1.z)), pk2(lo16(p0.w) + lo16(p1.w), hi16(p0.w) + hi16(p1.w))}; }
    const int n16 = lane & 15, kq = lane >> 4;
    const size_t gbase = (size_t)(o * 64 + g) * 64;
    const float dt = expf(A.in[21][o * 64 + g]);
    float ab_re, ab_im;
    { const float lr = fminf(A.in[19][gbase + lane], -1e-4f), li = A.in[20][gbase + lane]; const float mag = expf(lr * dt); ab_re = mag * cosf(li * dt); ab_im = mag * sinf(li * dt); }
    bf16x8 Bb[8];
#pragma unroll
    for (int f = 0; f < 4; ++f) { const int p = 16 * f + n16; const float lr = fminf(A.in[19][gbase + p], -1e-4f), li = A.in[20][gbase + p];
        const float mag = expf(lr * dt), are = mag * cosf(li * dt), aim = mag * sinf(li * dt), den = lr * lr + li * li;
        const float cre = ((are - 1.0f) * lr + aim * li) / den, cim = (aim * lr - (are - 1.0f) * li) / den;
        u32x4 wr_ = (u32x4){0u, 0u, 0u, 0u}, wi_ = (u32x4){0u, 0u, 0u, 0u};
        if (kq < 2) { const float* br = A.in[22] + (gbase + p) * 16 + kq * 8; const float* bi = A.in[23] + (gbase + p) * 16 + kq * 8; float vr[8], vi[8];
#pragma unroll
            for (int j = 0; j < 8; ++j) { vr[j] = cre * br[j] - cim * bi[j]; vi[j] = cre * bi[j] + cim * br[j]; }
            wr_ = (u32x4){pk2(vr[0], vr[1]), pk2(vr[2], vr[3]), pk2(vr[4], vr[5]), pk2(vr[6], vr[7])}; wi_ = (u32x4){pk2(vi[0], vi[1]), pk2(vi[2], vi[3]), pk2(vi[4], vi[5]), pk2(vi[6], vi[7])}; }
        Bb[f] = __builtin_bit_cast(bf16x8, wr_); Bb[4 + f] = __builtin_bit_cast(bf16x8, wi_); }
    bf16x8 Ct[4];
#pragma unroll
    for (int ks = 0; ks < 4; ++ks) { const int k0 = 32 * ks + 8 * kq; const float* src = (k0 < 64 ? A.in[24] : A.in[25]) + (gbase / 64 * 16 + n16) * 64 + (k0 & 63); const float sg = k0 < 64 ? 1.0f : -1.0f;
        const u32x4 wv = (u32x4){pk2(sg * src[0], sg * src[1]), pk2(sg * src[2], sg * src[3]), pk2(sg * src[4], sg * src[5]), pk2(sg * src[6], sg * src[7])}; Ct[ks] = __builtin_bit_cast(bf16x8, wv); }
    const f32x4 dsk = *(const f32x4*)(A.in[26] + o * 1024 + g * 16 + kq * 4);
    __syncthreads();
    LAS float* xb = XBall + w * 2560;
    const f32x4 z4 = (f32x4){0.f, 0.f, 0.f, 0.f};
#define S5_BU(tok0) { bf16x8 Uf = (bf16x8){0, 0, 0, 0, 0, 0, 0, 0}; if (kq < 2) Uf = __builtin_bit_cast(bf16x8, *(const LAS u32x4*)(U + ((tok0) + n16) * 8 + kq * 4)); \
        _Pragma("unroll") for (int f = 0; f < 8; ++f) { const f32x4 d = __builtin_amdgcn_mfma_f32_16x16x32_bf16(Uf, Bb[f], z4, 0, 0, 0); \
            *(LAS f32x4*)(xb + (16 * f + n16) * 20 + 4 * kq) = d; } }
#define S5_READ_BU() f32x4 br4[4], bi4[4]; _Pragma("unroll") for (int j = 0; j < 4; ++j) { br4[j] = *(const LAS f32x4*)(xb + lane * 20 + 4 * j); bi4[j] = *(const LAS f32x4*)(xb + (64 + lane) * 20 + 4 * j); }
    float hr = 0.f, hi = 0.f;
    for (int sub = 0; sub < 16; ++sub) { const int tok0 = w * 256 + sub * 16;
        S5_BU(tok0)
        S5_READ_BU()
#pragma unroll
        for (int t = 0; t < 16; ++t) { const float br = br4[t >> 2][t & 3], bi = bi4[t >> 2][t & 3]; const float nr = ab_re * hr - ab_im * hi + br, ni = ab_re * hi + ab_im * hr + bi; hr = nr; hi = ni; } }
    EE[(w * 64 + lane) * 2] = hr; EE[(w * 64 + lane) * 2 + 1] = hi;
    float pr = ab_re, pi = ab_im;
#pragma unroll
    for (int sq = 0; sq < 8; ++sq) { const float nr = pr * pr - pi * pi, ni = 2.0f * pr * pi; pr = nr; pi = ni; }
    __syncthreads();
    hr = 0.f; hi = 0.f;
    for (int sg = 0; sg < w; ++sg) { const float er = EE[(sg * 64 + lane) * 2], ei = EE[(sg * 64 + lane) * 2 + 1]; const float nr = pr * hr - pi * hi + er, ni = pr * hi + pi * hr + ei; hr = nr; hi = ni; }
    for (int sub = 0; sub < 16; ++sub) { const int tok0 = w * 256 + sub * 16;
        S5_BU(tok0)
        S5_READ_BU()
        asm volatile("s_waitcnt lgkmcnt(0)" ::: "memory");
#pragma unroll
        for (int t = 0; t < 16; ++t) { const float br = br4[t >> 2][t & 3], bi = bi4[t >> 2][t & 3]; const float nr = ab_re * hr - ab_im * hi + br, ni = ab_re * hi + ab_im * hr + bi; hr = nr; hi = ni;
            xb[t * 132 + lane] = hr; xb[t * 132 + 64 + lane] = hi; }
        f32x4 y = z4;
#pragma unroll
        for (int ks = 0; ks < 4; ++ks) { const f32x4 h0 = *(const LAS f32x4*)(xb + n16 * 132 + 32 * ks + 8 * kq), h1 = *(const LAS f32x4*)(xb + n16 * 132 + 32 * ks + 8 * kq + 4);
            const u32x4 hw = (u32x4){pk2(h0[0], h0[1]), pk2(h0[2], h0[3]), pk2(h1[0], h1[1]), pk2(h1[2], h1[3])};
            y = __builtin_amdgcn_mfma_f32_16x16x32_bf16(Ct[ks], __builtin_bit_cast(bf16x8, hw), y, 0, 0, 0); }
        const int tok = tok0 + n16; const u32x2 uw = *(const LAS u32x2*)(U + tok * 8 + kq * 2);
        const float y0 = y[0] + dsk[0] * lo16(uw.x), y1 = y[1] + dsk[1] * hi16(uw.x), y2 = y[2] + dsk[2] * lo16(uw.y), y3 = y[3] + dsk[3] * hi16(uw.y);
        u32x2 ow; ow.x = pk2(gelu_tanh(y0), gelu_tanh(y1)); ow.y = pk2(gelu_tanh(y2), gelu_tanh(y3));
        *(u32x2*)((bf16*)(F.ws + WS_YS5) + (size_t)(b * SEQ + tok) * 1024 + g * 16 + kq * 4) = ow; }
#undef S5_BU
#undef S5_READ_BU
    LDS_BARRIER();
}

__device__ __forceinline__ void router_unit(Frame& F, KArgs& A, int l, int unit, const bool dry, const bf16* xres) {
    const int tid = F.tid, lane = F.lane, w = F.wave, tok0 = unit * 32, tg = w >> 2, kc = w & 3, n16 = lane & 15, kq = lane >> 4;
    LAS float* RED = (LAS float*)F.lds;
    LAS float* SSQ = (LAS float*)(F.lds + 5 * RTW_IMG * 2);
    LAS float* RS = SSQ + 128;
    const float* gn = A.in[3] + (size_t)l * D;
    const char* rimg = (const char*)(F.ws + WS_RTW) + (size_t)l * 16 * RTW_IMG * 2;
    f32x4 acc[3]; float ssq = 0.f;
#pragma unroll
    for (int nf = 0; nf < 3; ++nf) acc[nf] = (f32x4){0.f, 0.f, 0.f, 0.f};
    const bf16* xrow = xres + (size_t)(tok0 + tg * 16 + n16) * D + kc * 512 + 8 * kq;
    u32x4 xv[16];
#pragma unroll
    for (int s16 = 0; s16 < 16; ++s16) xv[s16] = *(const u32x4*)(xrow + 32 * s16);
#define RT_DMA(s_) do { const char* src_ = rimg + (size_t)(s_) * (RTW_IMG * 2) + lane * 16; LAS unsigned char* dst_ = F.lds + ((s_) % 5) * (RTW_IMG * 2); \
        _Pragma("unroll") for (int r_ = 0; r_ < 4; ++r_) { int pc_ = r_ * 8 + w; pc_ = pc_ < 30 ? pc_ : 29; \
            __builtin_amdgcn_global_load_lds((const unsigned*)(src_ + pc_ * 1024), (LAS unsigned*)(dst_ + pc_ * 1024), 16, 0, 0); } } while (0)
#define RT_DMA2(s_, b_) do { const char* src_ = rimg + (size_t)(s_) * (RTW_IMG * 2) + lane * 16; LAS unsigned char* dst_ = F.lds + (b_) * (RTW_IMG * 2); \
        _Pragma("unroll") for (int r_ = 0; r_ < 4; ++r_) { int pc_ = r_ * 8 + w; pc_ = pc_ < 30 ? pc_ : 29; \
            __builtin_amdgcn_global_load_lds((const unsigned*)(src_ + pc_ * 1024), (LAS unsigned*)(dst_ + pc_ * 1024), 16, 0, 0); } } while (0)
    RT_DMA(0); RT_DMA(1); RT_DMA(2); RT_DMA(3);
    int rb = 0;
#pragma unroll 1
    for (int so = 0; so < 4; ++so) {
#pragma unroll
        for (int sj = 0; sj < 4; ++sj) { const int s16 = 4 * so + sj;
            if (so < 3 || sj == 0) asm volatile("s_waitcnt vmcnt(12)" ::: "memory"); else if (sj == 1) asm volatile("s_waitcnt vmcnt(8)" ::: "memory");
            else if (sj == 2) asm volatile("s_waitcnt vmcnt(4)" ::: "memory"); else asm volatile("s_waitcnt vmcnt(0)" ::: "memory");
            __builtin_amdgcn_s_barrier(); asm volatile("" ::: "memory");
            if (so < 3) RT_DMA2(s16 + 4, rb == 0 ? 4 : rb - 1);
            const LAS bf16* WH = (const LAS bf16*)(F.lds + rb * (RTW_IMG * 2)); const LAS bf16* WL = WH + 4 * 48 * 40;
            rb = rb == 4 ? 0 : rb + 1;
            const u32x4 xw = xv[sj];
            { const float x0 = lo16(xw.x), x1 = hi16(xw.x), x2 = lo16(xw.y), x3 = hi16(xw.y), x4 = lo16(xw.z), x5 = hi16(xw.z), x6 = lo16(xw.w), x7 = hi16(xw.w);
              ssq += ((x0 * x0 + x1 * x1) + (x2 * x2 + x3 * x3)) + ((x4 * x4 + x5 * x5) + (x6 * x6 + x7 * x7)); }
            const bf16x8 xf = __builtin_bit_cast(bf16x8, xw);
#pragma unroll
            for (int nf = 0; nf < 3; ++nf) { const bf16x8 wh = *(const LAS bf16x8*)(WH + (kc * 48 + nf * 16 + n16) * 40 + 8 * kq), wl = *(const LAS bf16x8*)(WL + (kc * 48 + nf * 16 + n16) * 40 + 8 * kq);
                acc[nf] = __builtin_amdgcn_mfma_f32_16x16x32_bf16(wh, xf, acc[nf], 0, 0, 0); acc[nf] = __builtin_amdgcn_mfma_f32_16x16x32_bf16(wl, xf, acc[nf], 0, 0, 0); }
            asm volatile("s_waitcnt lgkmcnt(0)" ::: "memory");
        }
#pragma unroll
        for (int i = 0; i < 12; ++i) xv[i] = xv[i + 4];
    }
#undef RT_DMA2
#undef RT_DMA
    __syncthreads();
    ssq += shx(ssq, 16, tid & 63); ssq += shx(ssq, 32, tid & 63);
#pragma unroll
    for (int nf = 0; nf < 3; ++nf)
#pragma unroll
        for (int r = 0; r < 4; ++r) RED[((tg * 4 + kc) * 48 + nf * 16 + 4 * kq + r) * 16 + n16] = acc[nf][r];
    if (kq == 0) SSQ[(tg * 4 + kc) * 16 + n16] = ssq;
    __syncthreads();
    if (tid < 32) {
        const int tg2 = tid >> 4, tk = tid & 15, token = tok0 + tid;
        float lgt[36];
#pragma unroll
        for (int o = 0; o < 36; ++o) lgt[o] = (RED[((tg2 * 4 + 0) * 48 + o) * 16 + tk] + RED[((tg2 * 4 + 1) * 48 + o) * 16 + tk]) + (RED[((tg2 * 4 + 2) * 48 + o) * 16 + tk] + RED[((tg2 * 4 + 3) * 48 + o) * 16 + tk]);
        const float sq = (SSQ[(tg2 * 4 + 0) * 16 + tk] + SSQ[(tg2 * 4 + 1) * 16 + tk]) + (SSQ[(tg2 * 4 + 2) * 16 + tk] + SSQ[(tg2 * 4 + 3) * 16 + tk]);
        const float rs = rsqrtf(sq * (1.0f / D) + EPS); RS[tid] = rs;
        const float* brg = A.in[29] + l * 4; const float* bre = A.in[31] + l * 32;
        float lg[4];
#pragma unroll
        for (int j = 0; j < 4; ++j) lg[j] = lgt[j] * rs + brg[j];
        int gs = 0; float mx = lg[0];
#pragma unroll
        for (int j = 1; j < 4; ++j) if (lg[j] > mx) { mx = lg[j]; gs = j; }
        float sum = 0.f;
#pragma unroll
        for (int j = 0; j < 4; ++j) sum += expf(lg[j] - mx);
        const float gate_g = 1.0f / sum;
        float le[8];
#pragma unroll
        for (int j = 0; j < 8; ++j) { const float a = gs == 0 ? lgt[4 + j] : gs == 1 ? lgt[12 + j] : gs == 2 ? lgt[20 + j] : lgt[28 + j]; le[j] = a * rs + bre[gs * 8 + j]; }
        int i1 = 0; float m1 = le[0];
#pragma unroll
        for (int j = 1; j < 8; ++j) if (le[j] > m1) { m1 = le[j]; i1 = j; }
        int i2 = (i1 == 0) ? 1 : 0; float m2 = le[i2];
#pragma unroll
        for (int j = 0; j < 8; ++j) if (j != i1 && le[j] > m2) { m2 = le[j]; i2 = j; }
        const float e2 = expf(m2 - m1), w1 = 1.0f / (1.0f + e2), w2 = e2 / (1.0f + e2);
        float* comb = (float*)(F.ws + (dry ? WS_DS : WS_COMB)); int* list = (int*)(F.ws + (dry ? WS_DS + 4 * MiB : WS_LIST)); unsigned* cnt = dry ? (unsigned*)(F.ws + WS_DS + 8 * MiB) : (unsigned*)(F.ws + WS_CTL) + CW_CNT + l * 32 * 16;
        const int ea = gs * 8 + i1, eb = gs * 8 + i2;
        comb[token] = gate_g * w1; comb[T + token] = gate_g * w2;
        LAS unsigned* HIST = (LAS unsigned*)(RS + 32); LAS unsigned* BASE = HIST + 32;
        HIST[tid] = 0u; asm volatile("s_waitcnt lgkmcnt(0)" ::: "memory");
        const unsigned ra = atomicAdd((unsigned*)(HIST + ea), 1u), rb = atomicAdd((unsigned*)(HIST + eb), 1u);
        asm volatile("s_waitcnt lgkmcnt(0)" ::: "memory");
        { const unsigned n = HIST[tid]; BASE[tid] = n ? atomicAdd(cnt + tid * 16, n) : 0u; }
        asm volatile("s_waitcnt vmcnt(0) lgkmcnt(0)" ::: "memory");
        unsigned pa = BASE[ea] + ra, pb = BASE[eb] + rb;
        if (dry) { pa &= 8191u; pb &= 8191u; }
        list[ea * 8192 + pa] = token; list[eb * 8192 + pb] = T + token;
    }
    __syncthreads();
    { u32x4 raw[4][4];
#pragma unroll
        for (int rr = 0; rr < 4; ++rr)
#pragma unroll
            for (int j = 0; j < 4; ++j) raw[rr][j] = *(const u32x4*)(xres + (size_t)(tok0 + w * 4 + rr) * D + 8 * lane + 512 * j);
#pragma unroll
        for (int rr = 0; rr < 4; ++rr) { const int row = w * 4 + rr; const float rs = RS[row]; const size_t t = (size_t)(tok0 + row);
#pragma unroll
            for (int j = 0; j < 4; ++j) { const int col = 8 * lane + 512 * j; const u32x4 r4 = raw[rr][j];
                const f32x4 oa = up4((u32x2){r4.x, r4.y}) * rs * *(const f32x4*)(gn + col), ob = up4((u32x2){r4.z, r4.w}) * rs * *(const f32x4*)(gn + col + 4);
                const u32x2 wl = dn4(oa), wh = dn4(ob);
                *(u32x4*)((bf16*)(F.ws + (dry ? WS_DS + 16 * MiB : WS_XN)) + t * D + col) = (u32x4){wl.x, wl.y, wh.x, wh.y}; } } }
    __syncthreads();
}

__device__ __forceinline__ void moe_prepare(Frame& F, int l, int nct, pg8::MoeOrder& S) {
    LAS int* cntl = (LAS int*)(F.lds + EXTRA_OFF); LAS int* pre = cntl + 64; LAS int* ptab = cntl + 128;
    const unsigned* cnt = (const unsigned*)(F.ws + WS_CTL) + CW_CNT + l * 32 * 16; const int* list = (const int*)(F.ws + WS_LIST);
    if (F.tid < 32) { const unsigned c = __hip_atomic_load(cnt + F.tid * 16, __ATOMIC_RELAXED, __HIP_MEMORY_SCOPE_AGENT); cntl[F.tid] = (int)(c > 8192u ? 8192u : c); }
    __syncthreads();
    if (F.tid == 0) { int s = 0; for (int e = 0; e < 32; ++e) { pre[e] = s; s += (cntl[e] + 255) >> 8; } pre[32] = s; }
    __syncthreads();
    S.pre = pre; S.cnt = cntl; S.ptab = ptab; S.nct = nct; S.G = F.G; S.c = F.vcu;
    for (int ui = 0; ui < pg8::MOE_MAXU; ++ui) { int e, rt, ct;
        if (S.decode(ui, e, rt, ct) && F.tid < 256) { const int pos = rt * 256 + F.tid; ptab[ui * 256 + F.tid] = pos < cntl[e] ? list[e * 8192 + pos] : -1; } }
    __syncthreads();
}

__device__ __forceinline__ void moe_prepare2(Frame& F, int l, int nct, fg::Tables& tb, const bool merged) {
    LAS int* cntl = (LAS int*)(F.lds + EXTRA_OFF); LAS int* pre = cntl + 64; LAS int* utab = cntl + 100; LAS int* ptab = cntl + 128; LAS float* ctab = (LAS float*)(ptab + fg::MAXU * 256);
    const unsigned* cnt = (const unsigned*)(F.ws + WS_CTL) + CW_CNT + l * 32 * 16; const int* list = (const int*)(F.ws + WS_LIST); const float* comb = (const float*)(F.ws + WS_COMB);
    __syncthreads();
    if (F.tid < 32) { const unsigned c = __hip_atomic_load(cnt + F.tid * 16, __ATOMIC_RELAXED, __HIP_MEMORY_SCOPE_AGENT); cntl[F.tid] = (int)(c > 8192u ? 8192u : c); }
    __syncthreads();
    if (F.tid == 0) { int s = 0; for (int e = 0; e < 32; ++e) { pre[e] = s; s += ((cntl[e] + 255) >> 8) * nct; } pre[32] = s; }
    __syncthreads();
    tb.cnt = cntl; tb.preU = pre; tb.ptab = ptab; tb.utab = utab; tb.ctab = ctab;
    tb.flags = merged ? (unsigned*)(F.ws + WS_CTL) + CW_FLAG + l * 32 * 32 * 16 : nullptr;
    const int ucu = (F.G == 256) ? ((F.vcu & 7) * 32 + (F.vcu >> 3)) : F.vcu;
    tb.stride = F.G; tb.c0 = ucu;
    if (merged) { const int n2 = pre[32] >> 1; const int h = n2 > F.G ? (n2 - F.G < F.G / 2 ? n2 - F.G : F.G / 2) : 0; tb.stride = F.G - h; tb.c0 = ucu - h; }
    int nu = 0;
    for (int ui = 0; ui < fg::MAXU; ++ui) { int e, rt, ct;
        if (fg::decode(tb, ui, e, rt, ct)) { ++nu;
            if (F.tid < 256) { const int pos = rt * 256 + F.tid; const int pr = pos < cntl[e] ? list[e * 8192 + pos] : -1; ptab[ui * 256 + F.tid] = pr; ctab[ui * 256 + F.tid] = pr >= 0 ? comb[pr] : 0.f; }
            if (F.tid == 0) { utab[3 * ui] = e; utab[3 * ui + 1] = rt; utab[3 * ui + 2] = ct; } } }
    if (F.tid == 0) utab[3 * fg::MAXU] = nu;
    __syncthreads();
}

constexpr int PH_LAYER0 = 2, PH_PER_LAYER = 12, PH_FINAL = PH_LAYER0 + DEPTH * PH_PER_LAYER, PH_END = PH_FINAL + 1;

__global__ void __launch_bounds__(NTHR, 2) mk_fwd(Args args) {
    extern __shared__ __attribute__((aligned(16))) unsigned char lds_raw[];
    Frame F;
    F.lds = (LAS unsigned char*)lds_raw;
    F.tid = threadIdx.x; F.lane = F.tid & 63; F.wave = __builtin_amdgcn_readfirstlane(F.tid >> 6);
    F.G = gridDim.x; { const int bx = blockIdx.x; F.vcu = (F.G % 8 == 0) ? (bx % 8) * (F.G / 8) + bx / 8 : bx; }
    F.ws = args.ws;
    volatile LAS unsigned* MISC = (volatile LAS unsigned*)(F.lds + MISC_OFF);
    if (F.tid < 64) MISC[F.tid] = 0u;
    __syncthreads();
    const int lo = args.ph_lo, hi = args.ph_hi;
    const bool multi = (hi - lo) > 1;
    XcdBarrier bar; bar.bar = (unsigned*)(args.ws + WS_CTL) + CW_BAR; bar.x = 0; bar.st = MISC + 8;
    if (multi) bar = xcd_barrier_post((unsigned*)(args.ws + WS_CTL) + CW_BAR, MISC + 8);
#ifndef MK_REP_P0
#define MK_REP_P0 1
#endif
#ifndef MK_REP_EV
#define MK_REP_EV 1
#endif
#ifndef MK_REP_S5
#define MK_REP_S5 1
#endif
#ifndef MK_REP_MOE
#define MK_REP_MOE 1
#endif
#ifndef MK_MOE_DRY
#define MK_MOE_DRY 0
#endif
#ifndef MK_REP_RT
#define MK_REP_RT 1
#endif
#ifndef MK_REP_G
#define MK_REP_G 1
#endif
#ifndef MK_MASK
#define MK_MASK 0xffffffffu
#endif
#define ON(b) ((MK_MASK >> (b)) & 1u)
#define IN(k) (lo <= (k) && (k) < hi)
#define SEAM(k) do { if (multi && (k) + 1 < hi) xcd_barrier(bar, F.wave == 0 && lane_now() == 0); } while (0)
    LAS unsigned char* ring = F.lds;
#define PHASE_ENTER KArgs& args = *opaque_k((KArgs*)__builtin_amdgcn_kernarg_segment_ptr()); Frame P = F; P.vcu = opaque_s(F.vcu); P.G = opaque_s(F.G); const int PBX = opaque_s((int)blockIdx.x); (void)PBX; P.tid = opaque_v(F.wave * 64 + lane_now()); P.lane = P.tid & 63; P.wave = __builtin_amdgcn_readfirstlane(P.tid >> 6); P.ws = opaque_p(F.ws); unsigned char* ws = P.ws; (void)ws;

    if (ON(0) && IN(0)) { for (int rep = 0; rep < MK_REP_P0; ++rep) { PHASE_ENTER p0_prologue(P, args); SEAM(0); } }
    if (multi && lo == 0) {
        if (F.tid == 0) { unsigned base = 0; for (unsigned j = 0; j < 16; ++j) { const unsigned cj = xb_ld(&bar.bar[XB_XCNT(j)]); base += (j < bar.x) ? cj : 0u; } MISC[11] = base + MISC[10]; }
        __syncthreads();
        F.vcu = __builtin_amdgcn_readfirstlane((int)MISC[11]);
    }
    if (ON(1) && IN(1)) {
        PHASE_ENTER
        pg8::PPOrder S; S.init(T, D, 256, P.G, PBX, (size_t)T * 256 * 2, SZ_PLEP);
        pg8::EpiStoreBf16Split E{(bf16*)(ws + WS_PP), D, (size_t)T * D, nullptr};
        pg8::gemm_phase<pg8::EpiStoreBf16Split, pg8::PPOrder, false>(P.tid, ring, (const char*)(ws + WS_PB), (const char*)(ws + WS_PLEP), 256, S, E);
        SEAM(1);
    }
    for (int l = 0; l < DEPTH; ++l) {
        const int pb = PH_LAYER0 + l * PH_PER_LAYER, eo = l >> 1;
        const size_t xcur = WS_XRES + (size_t)(l & 1) * T * D * 2, xnxt = WS_XRES + (size_t)((l + 1) & 1) * T * D * 2;
        if (ON(2) && l > 0 && IN(pb + 0)) {
            PHASE_ENTER
            const int gw = P.vcu * NWAVES + P.wave, NGW = P.G * NWAVES;
            for (int m = gw; m < T; m += NGW) norm_row<true, false, false, 0>((const bf16*)(ws + xcur) + (size_t)m * D, nullptr, nullptr, nullptr, nullptr, nullptr, nullptr, (float*)(ws + WS_RS) + m, P.lane);
            SEAM(pb + 0);
        }
        if ((l & 1) == 0) {
            if (ON(3) && IN(pb + 1)) for (int rep = 0; rep < MK_REP_G; ++rep) {
                PHASE_ENTER
                pg8::StaticOrder S; S.init(T, ZW, D, P.G, PBX);
                pg8::EpiStoreBf16 E{(bf16*)(ws + WS_Z), ZW, (const float*)(ws + WS_RS)};
                pg8::gemm_phase<pg8::EpiStoreBf16, pg8::StaticOrder, false>(P.tid, ring, (const char*)(ws + xcur), (const char*)(ws + WS_WIN) + (size_t)eo * SZ_WIN, D, S, E);
                SEAM(pb + 1);
            }
            if (IN(pb + 2)) for (int rep = 0; rep < MK_REP_EV; ++rep) {
                if (ON(4)) { PHASE_ENTER for (int u = P.vcu; u < 256; u += P.G) lru_unit(P, args, eo, u); }
                if (ON(17)) { PHASE_ENTER for (int u = P.vcu; u < 512; u += P.G) gla_ds_unit(P, args, eo, u); }
                SEAM(pb + 2);
            }
            if (ON(5) && IN(pb + 3)) for (int rep = 0; rep < MK_REP_EV; ++rep) { PHASE_ENTER gla_state_phase(P); SEAM(pb + 3); }
            if (ON(6) && IN(pb + 4)) for (int rep = 0; rep < MK_REP_EV; ++rep) { PHASE_ENTER for (int u = P.vcu; u < 512; u += P.G) gla_out_unit(P, args, eo, u); SEAM(pb + 4); }
            if (ON(7) && IN(pb + 5)) {
                PHASE_ENTER
                pg8::StaticOrder S; S.init(T, D, D, P.G, PBX);
                pg8::EpiResid E{(bf16*)(ws + xcur)};
                pg8::gemm_phase<pg8::EpiResid, pg8::StaticOrder, false>(P.tid, ring, (const char*)(ws + WS_YCAT), (const char*)(ws + WS_WOUT) + (size_t)eo * SZ_DD, D, S, E);
                SEAM(pb + 5);
            }
        } else {
            if (ON(8) && IN(pb + 1)) for (int rep = 0; rep < MK_REP_G; ++rep) {
                PHASE_ENTER
                pg8::SplitK2Order S; S.init(T, 1024, D, P.G, PBX);
                pg8::EpiStoreBf16Split E{(bf16*)(ws + WS_U), 1024, (size_t)T * 1024, (const float*)(ws + WS_RS)};
                pg8::gemm_phase<pg8::EpiStoreBf16Split, pg8::SplitK2Order, false>(P.tid, ring, (const char*)(ws + xcur), (const char*)(ws + WS_ODWIN) + (size_t)eo * SZ_ODWIN, D, S, E, D / 128);
                SEAM(pb + 1);
            }
            if (ON(9) && IN(pb + 2)) for (int rep = 0; rep < MK_REP_S5; ++rep) { PHASE_ENTER for (int u = P.vcu; u < 256; u += P.G) s5_unit(P, args, eo, u); SEAM(pb + 2); }
            if (ON(10) && IN(pb + 3)) {
                PHASE_ENTER
                pg8::StaticOrder S; S.init(T, 4096, 1024, P.G, PBX);
                pg8::EpiGlu E{(bf16*)(ws + xcur)};
                pg8::gemm_phase<pg8::EpiGlu, pg8::StaticOrder, false>(P.tid, ring, (const char*)(ws + WS_YS5), (const char*)(ws + WS_WGLU) + (size_t)eo * SZ_WGLU, 1024, S, E);
                SEAM(pb + 3);
            }
        }
        if (ON(11) && IN(pb + 6)) for (int rep = 0; rep < MK_REP_RT; ++rep) { PHASE_ENTER for (int u = P.vcu; u < 256; u += P.G) router_unit(P, args, l, u, rep + 1 < MK_REP_RT, (const bf16*)(ws + xcur)); SEAM(pb + 6); }
        if (ON(12) && IN(pb + 7)) {
            PHASE_ENTER
            unsigned* flags = (unsigned*)(ws + WS_CTL) + CW_FLAG + l * 32 * 32 * 16;
            {
                fg::Tables tb; moe_prepare2(P, l, 4, tb, false);
                const int nu2 = __builtin_amdgcn_readfirstlane(tb.utab[3 * fg::MAXU]);
#pragma unroll 1
                for (int ui = 0; ui < nu2; ++ui) {
                    fg::fgemm_phase<0>(opaque_v(P.tid), ring, tb, (const char*)(ws + WS_XN), args.in[32] + (size_t)l * 32 * D * 512, args.in[33] + (size_t)l * 32 * D * 512, (bf16*)(ws + WS_H), ui, ui + 1);
                    if (P.tid == 0) { __builtin_amdgcn_fence(__ATOMIC_RELEASE, "agent"); asm volatile("s_waitcnt vmcnt(0)" ::: "memory");
                        __hip_atomic_fetch_add(flags + (tb.utab[3 * ui] * 32 + tb.utab[3 * ui + 1]) * 16, 1u, __ATOMIC_RELAXED, __HIP_MEMORY_SCOPE_AGENT); }
                }
            }
            {
                Frame Q = P; Q.tid = opaque_v(P.tid);
                fg::Tables tb; moe_prepare2(Q, l, 8, tb, true);
                const int nu3 = __builtin_amdgcn_readfirstlane(tb.utab[3 * fg::MAXU]);
                fg::fgemm_phase<1>(Q.tid, ring, tb, (const char*)(ws + WS_H), args.in[34] + (size_t)l * 32 * 512 * D, nullptr, (bf16*)(ws + WS_Y), 0, nu3);
            }
            SEAM(pb + 8);
        }
        if (ON(14) && IN(pb + 9)) {
            PHASE_ENTER
            const int gw = P.vcu * NWAVES + P.wave, NGW = P.G * NWAVES;
            for (int m = gw; m < T; m += NGW) { bf16* xr = (bf16*)(ws + xcur) + (size_t)m * D;
                norm_row<true, true, true, 0>(xr, (const bf16*)(ws + WS_Y) + (size_t)m * D, (const bf16*)(ws + WS_Y) + (size_t)(T + m) * D, xr, nullptr, nullptr, nullptr, (float*)(ws + WS_RS) + m, P.lane); }
            SEAM(pb + 9);
        }
        if (ON(15) && IN(pb + 10)) {
            PHASE_ENTER
            pg8::StaticOrder S; S.init(T, D, D, P.G, PBX);
            pg8::EpiPle E{(const bf16*)(ws + xcur), (bf16*)(ws + xnxt), (const bf16*)(ws + WS_PP) + (size_t)l * T * D, args.in[36] + (size_t)l * D, (const float*)(ws + WS_RS)};
            pg8::gemm_phase<pg8::EpiPle, pg8::StaticOrder, false>(P.tid, ring, (const char*)(ws + xcur), (const char*)(ws + WS_PLEG) + (size_t)l * SZ_DD, D, S, E);
            SEAM(pb + 10);
        }
    }
    if (ON(16) && IN(PH_FINAL)) {
        PHASE_ENTER
        const int gw = P.vcu * NWAVES + P.wave, NGW = P.G * NWAVES;
        for (int m = gw; m < T; m += NGW) norm_row<true, false, false, 2>((const bf16*)(ws + WS_XRES + (size_t)(DEPTH & 1) * T * D * 2) + (size_t)m * D, nullptr, nullptr, nullptr, args.in[5], nullptr, args.out + (size_t)m * D, nullptr, P.lane);
    }
#undef IN
#undef ON
#undef SEAM
#undef PHASE_ENTER
}

static bool phase_exists(int k) {
    if (k < PH_LAYER0 || k >= PH_FINAL) return true;
    const int l = (k - PH_LAYER0) / PH_PER_LAYER, r = (k - PH_LAYER0) % PH_PER_LAYER;
    if (r == 0) return l > 0;
    if (r == 11) return false;
    if (l & 1) return !(r == 4 || r == 5);
    return true;
}
extern "C" void kernel_launch(void* const* d_in, const int* in_sizes, int n_in, void* d_out, int out_size, void* d_ws, size_t ws_size, hipStream_t stream) {
    static int grid = 0;
    if (grid == 0) {
        if (n_in != 38 || out_size != T * D || ws_size < WS_END) { fprintf(stderr, "kernel_launch: unexpected problem (n_in %d, out %d, ws %zu < %zu)\n", n_in, out_size, ws_size, (size_t)WS_END); grid = -1; return; }
        int dev = 0, cus = 0, per_cu = 0;
        if (hipGetDevice(&dev) != hipSuccess || hipDeviceGetAttribute(&cus, hipDeviceAttributeMultiprocessorCount, dev) != hipSuccess) { grid = -1; return; }
        if (hipFuncSetAttribute((const void*)mk_fwd, hipFuncAttributeMaxDynamicSharedMemorySize, LDS_BYTES) != hipSuccess) { fprintf(stderr, "kernel_launch: hipFuncSetAttribute failed\n"); grid = -1; return; }
        if (hipOccupancyMaxActiveBlocksPerMultiprocessor(&per_cu, (const void*)mk_fwd, NTHR, LDS_BYTES) != hipSuccess || per_cu < 1) fprintf(stderr, "kernel_launch: occupancy query says %d\n", per_cu);
        (void)hipGetLastError();
        grid = cus;
    }
    if (grid < 0) return;
    (void)hipMemsetAsync((char*)d_ws + WS_CTL, 0, CTL_BYTES, stream);
    Args a{};
    for (int i = 0; i < 38; ++i) a.in[i] = (const float*)d_in[i];
    a.out = (float*)d_out; a.ws = (unsigned char*)d_ws;
#if MK_PER_PHASE
    for (int k = 0; k < PH_END; ++k) { if (!phase_exists(k)) continue; a.ph_lo = k; a.ph_hi = k + 1; hipLaunchKernelGGL(mk_fwd, dim3(grid), dim3(NTHR), LDS_BYTES, stream, a); }
#else
    (void)phase_exists;
    a.ph_lo = 0; a.ph_hi = PH_END;
    hipLaunchKernelGGL(mk_fwd, dim3(grid), dim3(NTHR), LDS_BYTES, stream, a);
#endif
    const hipError_t le = hipPeekAtLastError();
    if (le != hipSuccess) fprintf(stderr, "kernel_launch: launch failed: %s\n", hipGetErrorName(le));
}
```
